# Optimizing an MI355X kernel written in HIP

```python
import math
import jax, jax.numpy as jnp
from jax import lax
import numpy as np

D_MODEL = 1024
BATCH = 8
SEQ = 4096
DEPTH = 4

CHUNK = 64
D_MIX = D_MODEL
D_POOL = D_MIX // 2
POOL_WINDOWS = (2, 4, 8, 16)
N_POOL_GROUPS = len(POOL_WINDOWS)
POOL_GROUP = D_POOL // N_POOL_GROUPS
D_MLSTM = D_MIX - D_POOL
N_MLSTM_HEADS = 4
MLSTM_HEAD_DIM = D_MLSTM // N_MLSTM_HEADS
CONV_WIDTH = 4
D_IN = D_POOL + 4 * D_MLSTM + 2 * N_MLSTM_HEADS
D_FF_DENSE = ((8 * D_MODEL // 3 + 127) // 128) * 128
N_EXPERTS = 8
TOP_K = 2
D_FF_EXPERT = 7 * D_MODEL // 2
N_DENSE_LAYERS = (DEPTH + 1) // 2
N_MOE_LAYERS = DEPTH // 2
ALPHA = (2 * DEPTH) ** 0.25
BETA = (8 * DEPTH) ** -0.25
LN_EPS = 1e-5

kernel_name = "hybrid_pool_mlstm_moe_deepnorm"


def layer_norm(x, g, b):
    xf = x.astype(jnp.float32)
    mu = jnp.mean(xf, axis=-1, keepdims=True)
    xc = xf - mu
    var = jnp.mean(xc * xc, axis=-1, keepdims=True)
    return (xc * lax.rsqrt(var + LN_EPS) * g.astype(jnp.float32) + b.astype(jnp.float32)).astype(x.dtype)


def pool_mixer(u, w_maps, scale):
    bsz, s, _ = u.shape
    uf = u.astype(jnp.float32)
    P = jnp.concatenate([jnp.zeros_like(uf[:, :1]), jnp.cumsum(uf, axis=1)], axis=1)
    t = jnp.arange(s)
    outs = []
    for g, w in enumerate(POOL_WINDOWS):
        sl = slice(g * POOL_GROUP, (g + 1) * POOL_GROUP)
        Pg = P[:, :, sl]
        lead = jnp.pad(Pg[:, : s + 1 - w], ((0, 0), (w - 1, 0), (0, 0)))
        count = jnp.minimum(t + 1, w).astype(jnp.float32)[None, :, None]
        outs.append((Pg[:, 1:] - lead) / count - uf[:, :, sl])
    d = jnp.stack(outs, axis=2)
    y = jnp.einsum('bsgc,gcd->bsgd', d, w_maps.astype(jnp.float32)).reshape(bsz, s, D_POOL)
    return (y * scale.astype(jnp.float32)).astype(u.dtype)


def causal_conv_silu(u, w, b):
    K = w.shape[0]
    s = u.shape[1]
    up = jnp.pad(u, ((0, 0), (K - 1, 0), (0, 0)))
    y = up[:, 0:s] * w[0]
    for j in range(1, K):
        y = y + up[:, j:j + s] * w[j]
    return jax.nn.silu(y + b)


def mlstm_chunkwise(q, k, v, i_pre, f_pre):
    bsz, s, H, Dh = q.shape
    nc, L = s // CHUNK, CHUNK

    def chunks(a):
        return a.astype(jnp.float32).reshape(bsz, nc, L, H, Dh).transpose(0, 3, 1, 2, 4)

    def chunks_g(a):
        return a.astype(jnp.float32).reshape(bsz, nc, L, H).transpose(0, 3, 1, 2)

    qc = chunks(q)
    kc = chunks(k) * (Dh ** -0.5)
    vc = chunks(v)
    ig = chunks_g(i_pre)
    logf = jax.nn.log_sigmoid(chunks_g(f_pre))
    b = jnp.cumsum(logf, axis=-1)
    g = b[..., -1]

    a = g[..., None] - b + ig
    m_loc = jnp.max(a, axis=-1)
    wa = jnp.exp(a - m_loc[..., None])
    C_loc = jnp.einsum('bhclv,bhclk->bhcvk', wa[..., None] * vc, kc)
    n_loc = jnp.einsum('bhcl,bhclk->bhck', wa, kc)

    def step(carry, inp):
        C, n, m = carry
        g_c, m_l, C_l, n_l = inp
        m_new = jnp.maximum(g_c + m, m_l)
        s_old = jnp.exp(g_c + m - m_new)
        s_loc = jnp.exp(m_l - m_new)
        C_new = s_old[..., None, None] * C + s_loc[..., None, None] * C_l
        n_new = s_old[..., None] * n + s_loc[..., None] * n_l
        return (C_new, n_new, m_new), (C, n, m)

    init = (jnp.zeros((bsz, H, Dh, Dh), jnp.float32), jnp.zeros((bsz, H, Dh), jnp.float32),
            jnp.zeros((bsz, H), jnp.float32))
    xs = (jnp.moveaxis(g, 2, 0), jnp.moveaxis(m_loc, 2, 0), jnp.moveaxis(C_loc, 2, 0), jnp.moveaxis(n_loc, 2, 0))
    _, (C_prev, n_prev, m_prev) = lax.scan(step, init, xs)
    C_prev = jnp.moveaxis(C_prev, 0, 2)
    n_prev = jnp.moveaxis(n_prev, 0, 2)
    m_prev = jnp.moveaxis(m_prev, 0, 2)

    Dlog = b[..., :, None] - b[..., None, :] + ig[..., None, :]
    causal = jnp.tril(jnp.ones((L, L), dtype=bool))
    Dlog = jnp.where(causal, Dlog, -jnp.inf)
    inter = b + m_prev[..., None]
    m_t = jnp.maximum(jnp.max(Dlog, axis=-1), inter)
    W = jnp.exp(Dlog - m_t[..., None]) * jnp.einsum('bhctk,bhcsk->bhcts', qc, kc)
    s_inter = jnp.exp(inter - m_t)
    num = jnp.einsum('bhcts,bhcsv->bhctv', W, vc) + s_inter[..., None] * jnp.einsum('bhcvk,bhctk->bhctv', C_prev, qc)
    den = jnp.sum(W, axis=-1) + s_inter * jnp.einsum('bhck,bhctk->bhct', n_prev, qc)
    h = num / jnp.maximum(jnp.abs(den), jnp.exp(-m_t))[..., None]
    return h.transpose(0, 2, 3, 1, 4).reshape(bsz, s, H, Dh)


def hybrid_mixer(x, w_in, b_gates, conv_w, conv_b, pool_w, pool_scale, mlstm_g, w_out):
    bsz, s, _ = x.shape
    H, Dh = N_MLSTM_HEADS, MLSTM_HEAD_DIM
    z = x @ w_in
    o0 = D_POOL
    u_pool = z[..., :o0]
    qk = z[..., o0:o0 + 2 * D_MLSTM]
    v = z[..., o0 + 2 * D_MLSTM:o0 + 3 * D_MLSTM]
    o_pre = z[..., o0 + 3 * D_MLSTM:o0 + 4 * D_MLSTM]
    gates = z[..., o0 + 4 * D_MLSTM:] + b_gates

    y_pool = pool_mixer(u_pool, pool_w, pool_scale)

    qk = causal_conv_silu(qk, conv_w, conv_b)
    q = qk[..., :D_MLSTM].reshape(bsz, s, H, Dh)
    k = qk[..., D_MLSTM:].reshape(bsz, s, H, Dh)
    h = mlstm_chunkwise(q, k, v.reshape(bsz, s, H, Dh), gates[..., :H], gates[..., H:])
    mu = jnp.mean(h, axis=-1, keepdims=True)
    hc = h - mu
    h = hc * lax.rsqrt(jnp.mean(hc * hc, axis=-1, keepdims=True) + LN_EPS)
    h = h.reshape(bsz, s, D_MLSTM) * mlstm_g.astype(jnp.float32)
    y_m = (jax.nn.sigmoid(o_pre.astype(jnp.float32)) * h).astype(x.dtype)

    return jnp.concatenate([y_pool, y_m], axis=-1) @ w_out


def swiglu(x, wg, wu, wd):
    return (jax.nn.silu(x @ wg) * (x @ wu)) @ wd


def moe_swiglu(x, w_router, b_router, wg, wu, wd):
    logits = (x @ w_router).astype(jnp.float32) + b_router.astype(jnp.float32)
    top_v, top_i = lax.top_k(logits, TOP_K)
    top_w = jax.nn.softmax(top_v, axis=-1)
    combine = jnp.sum(jax.nn.one_hot(top_i, N_EXPERTS, dtype=jnp.float32) * top_w[..., None], axis=-2)
    combine = combine.astype(x.dtype)
    out = jnp.zeros_like(x)
    for e in range(N_EXPERTS):
        out = out + combine[..., e:e + 1] * swiglu(x, wg[e], wu[e], wd[e])
    return out


def setup_inputs(seed: int = 0) -> dict:
    key = jax.random.key(seed)
    ks = jax.random.split(key, 24)
    f32 = jnp.float32
    H = N_MLSTM_HEADS
    nrm = lambda k, shape, scale: jax.random.normal(k, shape, f32) * scale

    x = nrm(ks[0], (BATCH, SEQ, D_MODEL), 1.0)
    w_in = nrm(ks[1], (DEPTH, D_MODEL, D_IN), D_MODEL ** -0.5)
    gate_bias0 = jnp.concatenate([jnp.zeros((H,), f32), jnp.linspace(3.0, 6.0, H, dtype=f32)])
    b_gates = gate_bias0[None, :] + nrm(ks[2], (DEPTH, 2 * H), 0.1)
    conv_w = nrm(ks[3], (DEPTH, CONV_WIDTH, 2 * D_MLSTM), CONV_WIDTH ** -0.5)
    conv_b = nrm(ks[4], (DEPTH, 2 * D_MLSTM), 0.02)
    pool_w = nrm(ks[5], (DEPTH, N_POOL_GROUPS, POOL_GROUP, POOL_GROUP), POOL_GROUP ** -0.5)
    pool_scale = 1.0 + nrm(ks[6], (DEPTH, D_POOL), 0.1)
    mlstm_g = 1.0 + nrm(ks[7], (DEPTH, D_MLSTM), 0.1)
    w_out = nrm(ks[8], (DEPTH, D_MIX, D_MODEL), BETA * D_MIX ** -0.5)
    ln1_g = 1.0 + nrm(ks[9], (DEPTH, D_MODEL), 0.05)
    ln1_b = nrm(ks[10], (DEPTH, D_MODEL), 0.02)
    ln2_g = 1.0 + nrm(ks[11], (DEPTH, D_MODEL), 0.05)
    ln2_b = nrm(ks[12], (DEPTH, D_MODEL), 0.02)
    wg_dense = nrm(ks[13], (N_DENSE_LAYERS, D_MODEL, D_FF_DENSE), D_MODEL ** -0.5)
    wu_dense = nrm(ks[14], (N_DENSE_LAYERS, D_MODEL, D_FF_DENSE), D_MODEL ** -0.5)
    wd_dense = nrm(ks[15], (N_DENSE_LAYERS, D_FF_DENSE, D_MODEL), BETA * D_FF_DENSE ** -0.5)
    w_router = nrm(ks[16], (N_MOE_LAYERS, D_MODEL, N_EXPERTS), D_MODEL ** -0.5)
    b_router = nrm(ks[17], (N_MOE_LAYERS, N_EXPERTS), 0.01)
    wg_exp = nrm(ks[18], (N_MOE_LAYERS, N_EXPERTS, D_MODEL, D_FF_EXPERT), D_MODEL ** -0.5)
    wu_exp = nrm(ks[19], (N_MOE_LAYERS, N_EXPERTS, D_MODEL, D_FF_EXPERT), D_MODEL ** -0.5)
    wd_exp = nrm(ks[20], (N_MOE_LAYERS, N_EXPERTS, D_FF_EXPERT, D_MODEL), BETA * D_FF_EXPERT ** -0.5)
    return {"x": x, "w_in": w_in, "b_gates": b_gates, "conv_w": conv_w, "conv_b": conv_b,
            "pool_w": pool_w, "pool_scale": pool_scale, "mlstm_g": mlstm_g, "w_out": w_out,
            "ln1_g": ln1_g, "ln1_b": ln1_b, "ln2_g": ln2_g, "ln2_b": ln2_b,
            "wg_dense": wg_dense, "wu_dense": wu_dense, "wd_dense": wd_dense,
            "w_router": w_router, "b_router": b_router,
            "wg_exp": wg_exp, "wu_exp": wu_exp, "wd_exp": wd_exp}


def reference(x, w_in, b_gates, conv_w, conv_b, pool_w, pool_scale, mlstm_g, w_out,
              ln1_g, ln1_b, ln2_g, ln2_b, wg_dense, wu_dense, wd_dense,
              w_router, b_router, wg_exp, wu_exp, wd_exp):
    for l in range(DEPTH):
        mix = hybrid_mixer(x, w_in[l], b_gates[l], conv_w[l], conv_b[l], pool_w[l],
                           pool_scale[l], mlstm_g[l], w_out[l])
        h = layer_norm(ALPHA * x + mix, ln1_g[l], ln1_b[l])
        j = l // 2
        if l % 2 == 0:
            f = swiglu(h, wg_dense[j], wu_dense[j], wd_dense[j])
        else:
            f = moe_swiglu(h, w_router[j], b_router[j], wg_exp[j], wu_exp[j], wd_exp[j])
        x = layer_norm(ALPHA * h + f, ln2_g[l], ln2_b[l])
    return x
```

```cpp
#include <hip/hip_runtime.h>
#include <cstdio>
#include <cstdint>
#ifndef MK_ONE_LAUNCH
#define MK_ONE_LAUNCH 1
#endif
namespace pg8 {
#define PG8_LAS __attribute__((address_space(3)))
typedef unsigned short bf16_t;
typedef short bf16x8 __attribute__((ext_vector_type(8)));
typedef float f32x4 __attribute__((ext_vector_type(4)));
typedef unsigned u32x4 __attribute__((ext_vector_type(4)));
constexpr int BM = 256, BK = 64, HALF = 128, HTB = HALF * BK * 2  , STAGE_BYTES = 8 * HTB, NXCD = 8, WGM = 8;

__host__ __device__ __forceinline__ int lds_byte(int r, int c) { const int st = (r >> 4) * 2 + (c >> 5), rr = r & 15, cc = c & 31, ob = rr * 64 + cc * 2; return st * 1024 + (ob ^ (((ob >> 9) & 1) << 5)); }
__host__ __device__ __forceinline__ void stage_rc(int b, int& R, int& C) { const int st = b / 1024, sb = b % 1024, swz = sb ^ (((sb >> 9) & 1) << 5); R = (st >> 1) * 16 + swz / 64; C = (st & 1) * 32 + (swz % 64) / 2; }
__host__ __device__ __forceinline__ int perm32(int rho) { const int n = rho >> 4, i = rho & 15; return 8 * (i >> 2) + 4 * n + (i & 3); }

struct Unit { int pm, pn, pb; };
struct Gemm { const bf16_t* A; const bf16_t* Bt; int M, N, K; };

struct StaticOrder {
    int nM, nN, nwg, G, c;
    __host__ __device__ void init(int M, int N, int G_, int c_) { nM = M / BM; nN = N / BM; nwg = nM * nN; G = G_; c = c_; }
    __host__ __device__ bool next(int i, Unit& u) const {
        const long L = (long)i * G + c; if (L >= nwg) return false;
        int wgid = (int)L; { const int q = nwg / NXCD, r = nwg % NXCD, xcd = wgid % NXCD, off = wgid / NXCD; wgid = (xcd < r ? xcd * (q + 1) : r * (q + 1) + (xcd - r) * q) + off; }
        const int nig = WGM * nN, gid = wgid / nig, fm = gid * WGM, gsz = (nM - fm) < WGM ? (nM - fm) : WGM;
        u.pm = fm + ((wgid % nig) % gsz); u.pn = (wgid % nig) / gsz; u.pb = u.pn; return true;
    }
    __device__ __forceinline__ void a_ready(const Unit&) const {}
    __device__ __forceinline__ void done(const Unit&) const {}
};
struct GroupedOrder {
    StaticOrder so; int rt0; const int* tile_e;
    __device__ void init(int ntp, int N, int G_, int c_, int rt0_, const int* te) { so.init(ntp * BM, N, G_, c_); rt0 = rt0_; tile_e = te; }
    __device__ bool next(int i, Unit& u) const {
        if (!so.next(i, u)) return false;
        const int e = __builtin_amdgcn_readfirstlane(tile_e[rt0 + u.pm]); u.pb = e * so.nN + u.pn; return true;
    }
    __device__ __forceinline__ void a_ready(const Unit&) const {}
    __device__ __forceinline__ void done(const Unit&) const {}
};

#ifndef PG8_ST_AUX
#define PG8_ST_AUX 0
#endif
#define PG8_RSRC(p) __builtin_amdgcn_make_buffer_rsrc((void*)(p), 0, 0x7fffffff, 0x00020000)
#define PG8_ST128(w, rs, off) __builtin_amdgcn_raw_buffer_store_b128((w), (rs), (off), 0, PG8_ST_AUX)
#define PG8_ST64(w, rs, off) __builtin_amdgcn_raw_buffer_store_b64((w), (rs), (off), 0, PG8_ST_AUX)
__device__ __forceinline__ unsigned cvt_pk_bf16(float lo, float hi) { unsigned r; asm volatile("v_cvt_pk_bf16_f32 %0, %1, %2" : "=v"(r) : "v"(lo), "v"(hi)); return r; }

struct EpiBf16 {
    static constexpr bool PERM = true, AFTER_DRAIN = false;
    bf16_t* O; int ldc; int nostore = 0;
    __device__ __forceinline__ void operator()(const f32x4 (&acc)[2][2][4][2], const Unit& u, int wr, int wc, int fr, int fq) const {
        const int row0 = u.pm * BM + wr * 64 + fr; const int col0 = u.pn * BM + wc * 32 + 8 * fq; const auto rs = PG8_RSRC(O);
#pragma unroll
        for (int ai = 0; ai < 2; ++ai)
#pragma unroll
            for (int m = 0; m < 4; ++m) { const int off = ((row0 + ai * HALF + m * 16) * ldc + col0) * 2;
#pragma unroll
                for (int bj = 0; bj < 2; ++bj) { const f32x4 v0 = acc[ai][bj][m][0], v1 = acc[ai][bj][m][1];
                    u32x4 w; w.x = cvt_pk_bf16(v0[0], v0[1]); w.y = cvt_pk_bf16(v0[2], v0[3]); w.z = cvt_pk_bf16(v1[0], v1[1]); w.w = cvt_pk_bf16(v1[2], v1[3]);
                    if (!nostore || w.x == 0x12345678u) PG8_ST128(w, rs, off + bj * HALF * 2); } }
    }
};
__device__ __forceinline__ float silu_f(float g) { return g * __builtin_amdgcn_rcpf(1.0f + __expf(-g)); }
__device__ __forceinline__ unsigned cvt_fp8x4(float a, float b, float c, float d) {
    a = fminf(fmaxf(a, -448.f), 448.f); b = fminf(fmaxf(b, -448.f), 448.f); c = fminf(fmaxf(c, -448.f), 448.f); d = fminf(fmaxf(d, -448.f), 448.f);
    int r = __builtin_amdgcn_cvt_pk_fp8_f32(a, b, 0, false); r = __builtin_amdgcn_cvt_pk_fp8_f32(c, d, r, true); return (unsigned)r; }
template <bool OUT8> struct EpiSwiGLUT {
    static constexpr bool PERM = true, AFTER_DRAIN = false;
    bf16_t* O; int ldc; float insc = 1.0f; float outsc = 1.0f;
    __device__ __forceinline__ void operator()(const f32x4 (&acc)[2][2][4][2], const Unit& u, int wr, int wc, int fr, int fq) const {
        const int row0 = u.pm * BM + wr * 64 + fr; const int col0 = u.pn * HALF + wc * 32 + 8 * fq;
        const float c1 = -1.4426950408889634f * insc, c2 = insc * insc * outsc; const auto rs = PG8_RSRC(O);
#pragma unroll
        for (int ai = 0; ai < 2; ++ai)
#pragma unroll
            for (int m = 0; m < 4; ++m) {
                const f32x4 g0 = acc[ai][0][m][0], g1 = acc[ai][0][m][1], u0 = acc[ai][1][m][0], u1 = acc[ai][1][m][1];
                const f32x4 t0 = g0 * c1, t1 = g1 * c1; f32x4 d0, d1;
#pragma unroll
                for (int j = 0; j < 4; ++j) { d0[j] = __builtin_amdgcn_exp2f(t0[j]); d1[j] = __builtin_amdgcn_exp2f(t1[j]); }
                d0 = d0 + 1.0f; d1 = d1 + 1.0f;
#pragma unroll
                for (int j = 0; j < 4; ++j) { d0[j] = __builtin_amdgcn_rcpf(d0[j]); d1[j] = __builtin_amdgcn_rcpf(d1[j]); }
                const f32x4 h0 = (g0 * u0) * (d0 * c2), h1 = (g1 * u1) * (d1 * c2);
                if constexpr (OUT8) { typedef unsigned u32x2_ __attribute__((ext_vector_type(2)));
                    u32x2_ w; w.x = cvt_fp8x4(h0[0], h0[1], h0[2], h0[3]); w.y = cvt_fp8x4(h1[0], h1[1], h1[2], h1[3]);
                    PG8_ST64(w, rs, (row0 + ai * HALF + m * 16) * ldc + col0); }
                else {
                    u32x4 w; w.x = cvt_pk_bf16(h0[0], h0[1]); w.y = cvt_pk_bf16(h0[2], h0[3]); w.z = cvt_pk_bf16(h1[0], h1[1]); w.w = cvt_pk_bf16(h1[2], h1[3]);
                    PG8_ST128(w, rs, ((row0 + ai * HALF + m * 16) * ldc + col0) * 2); } }
    }
};
typedef EpiSwiGLUT<false> EpiSwiGLU; typedef EpiSwiGLUT<true> EpiSwiGLU8;
struct EpiBf16S {
    static constexpr bool PERM = true, AFTER_DRAIN = false;
    bf16_t* O; int ldc; float insc;
    __device__ __forceinline__ void operator()(const f32x4 (&acc)[2][2][4][2], const Unit& u, int wr, int wc, int fr, int fq) const {
        const int row0 = u.pm * BM + wr * 64 + fr; const int col0 = u.pn * BM + wc * 32 + 8 * fq; const auto rs = PG8_RSRC(O);
#pragma unroll
        for (int ai = 0; ai < 2; ++ai)
#pragma unroll
            for (int m = 0; m < 4; ++m) { const int off = ((row0 + ai * HALF + m * 16) * ldc + col0) * 2;
#pragma unroll
                for (int bj = 0; bj < 2; ++bj) { const f32x4 v0 = acc[ai][bj][m][0] * insc, v1 = acc[ai][bj][m][1] * insc;
                    u32x4 w; w.x = cvt_pk_bf16(v0[0], v0[1]); w.y = cvt_pk_bf16(v0[2], v0[3]); w.z = cvt_pk_bf16(v1[0], v1[1]); w.w = cvt_pk_bf16(v1[2], v1[3]);
                    PG8_ST128(w, rs, off + bj * HALF * 2); } }
    }
};

template <class Epi, class Sched, bool ALIGN_EPI = false, bool SP2 = false, int DT = 0>
__device__ __forceinline__ void gemm_phase(PG8_LAS unsigned char* lds, const Gemm g, const Sched& S, const Epi& E, int wave_s) {
    int lane_l; asm volatile("v_mbcnt_lo_u32_b32 %0, -1, 0\n\tv_mbcnt_hi_u32_b32 %0, -1, %0" : "=v"(lane_l));
    const int tid_l = wave_s * 64 + lane_l;
    const int tid = tid_l, wid = __builtin_amdgcn_readfirstlane(tid >> 6), lane = tid & 63, wr = wid >> 2, wc = wid & 3, fr = lane & 15, fq = lane >> 4;
    const int K = g.K, nt = K / BK;
    unsigned voffA[2], voffB[2];
#pragma unroll
    for (int i = 0; i < 2; ++i) { int R, C; stage_rc(tid * 16 + i * 8192, R, C); const int Rb = Epi::PERM ? ((R & ~31) + perm32(R & 31)) : R;
        voffA[i] = (unsigned)(R * K + C) * 2u; voffB[i] = (unsigned)(Rb * K + C) * 2u; }
    const size_t kstep = (size_t)(BK * 2);
    const size_t hstep = (size_t)HALF * K * 2;
    const size_t tstep = 2 * hstep;
    const unsigned ldsw = (unsigned)wid * 1024u;
    const int aoff = lds_byte(wr * 64 + fr, fq * 8), boff = lds_byte(wc * 32 + fr, fq * 8);
#define PG8_SA(b, h) (((b) * 2 + (h)) * HTB)
#define PG8_SB(b, h) ((4 + (b) * 2 + (h)) * HTB)
#define PG8_STAGE(bufoff, gbase, voff) do { _Pragma("unroll") for (int _i = 0; _i < 2; ++_i) \
        __builtin_amdgcn_global_load_lds((const unsigned*)((const char*)(gbase) + (voff)[_i]), (PG8_LAS unsigned*)(lds + (bufoff) + ldsw + _i * 8192), 16, 0, 0); } while (0)
#define PG8_LDA(dst, b, h) do { _Pragma("unroll") for (int m = 0; m < 4; ++m) { \
        if constexpr (DT == 1) { const pg8_i4 l0_ = *(const PG8_LAS pg8_i4*)(lds + PG8_SA(b, h) + aoff + m * 2048), l1_ = *(const PG8_LAS pg8_i4*)(lds + PG8_SA(b, h) + aoff + m * 2048 + 1024); dst##8[m] = __builtin_shufflevector(l0_, l1_, 0, 1, 2, 3, 4, 5, 6, 7); } \
        else { _Pragma("unroll") for (int k = 0; k < 2; ++k) dst[m][k] = *(const PG8_LAS bf16x8*)(lds + PG8_SA(b, h) + aoff + m * 2048 + k * 1024); } } } while (0)
#define PG8_LDB(dst, b, h) do { _Pragma("unroll") for (int n = 0; n < 2; ++n) { \
        if constexpr (DT == 1) { const pg8_i4 l0_ = *(const PG8_LAS pg8_i4*)(lds + PG8_SB(b, h) + boff + n * 2048), l1_ = *(const PG8_LAS pg8_i4*)(lds + PG8_SB(b, h) + boff + n * 2048 + 1024); dst##8[n] = __builtin_shufflevector(l0_, l1_, 0, 1, 2, 3, 4, 5, 6, 7); } \
        else { _Pragma("unroll") for (int k = 0; k < 2; ++k) dst[n][k] = *(const PG8_LAS bf16x8*)(lds + PG8_SB(b, h) + boff + n * 2048 + k * 1024); } } } while (0)
#define PG8_MMA(ai, bj, At, Bt) do { __builtin_amdgcn_s_setprio(1); \
        if constexpr (DT == 1) { asm volatile("s_nop 1" ::: ); _Pragma("unroll") for (int m = 0; m < 4; ++m) _Pragma("unroll") for (int n = 0; n < 2; ++n) \
            asm volatile("v_mfma_scale_f32_16x16x128_f8f6f4 %0, %1, %2, %0, %3, %3 op_sel_hi:[0,0,0]" : "+v"(acc[ai][bj][m][n]) : "v"(Bt##8[n]), "v"(At##8[m]), "v"(sc8_)); } \
        else { _Pragma("unroll") for (int m = 0; m < 4; ++m) _Pragma("unroll") for (int n = 0; n < 2; ++n) _Pragma("unroll") for (int k = 0; k < 2; ++k) \
            acc[ai][bj][m][n] = __builtin_amdgcn_mfma_f32_16x16x32_bf16(Bt[n][k], At[m][k], acc[ai][bj][m][n], 0, 0, 0); } \
        __builtin_amdgcn_s_setprio(0); } while (0)
#define PG8_WAIT_V(n) asm volatile("s_waitcnt vmcnt(" #n ")" ::: "memory")
#define PG8_WAIT_L(n) asm volatile("s_waitcnt lgkmcnt(" #n ")" ::: "memory")
#define PG8_BAR __builtin_amdgcn_s_barrier()
#define PG8_SCHED __builtin_amdgcn_sched_barrier(0)
    Unit cur, nxt; int ui = 0;
    if (!S.next(0, cur)) return;
    f32x4 acc[2][2][4][2];
    float zl_ = 0.f; asm volatile("" : "+v"(zl_));
#pragma unroll
    for (int a = 0; a < 2; ++a)
#pragma unroll
        for (int b = 0; b < 2; ++b)
#pragma unroll
            for (int m = 0; m < 4; ++m)
#pragma unroll
                for (int n = 0; n < 2; ++n) acc[a][b][m][n] = (f32x4){zl_, zl_, zl_, zl_};
    typedef int pg8_i4 __attribute__((ext_vector_type(4))); typedef int pg8_i8 __attribute__((ext_vector_type(8)));
    bf16x8 At[4][2], B0[2][2], B1[2][2]; pg8_i8 At8[4], B08[2], B18[2]; const int sc8_ = 0x7f7f7f7f;
    (void)At; (void)B0; (void)B1; (void)At8; (void)B08; (void)B18; (void)sc8_;
    const char* cA = (const char*)g.A + (size_t)cur.pm * tstep; const char* cB = (const char*)g.Bt + (size_t)cur.pb * tstep;
    S.a_ready(cur);
    if constexpr (SP2) {
        PG8_STAGE(PG8_SB(0, 0), cB, voffB); PG8_STAGE(PG8_SB(0, 1), cB + hstep, voffB); PG8_STAGE(PG8_SA(0, 0), cA, voffA); PG8_STAGE(PG8_SA(0, 1), cA + hstep, voffA);
        if (wr == 1) PG8_BAR;
        PG8_WAIT_V(2); PG8_BAR;
        PG8_STAGE(PG8_SB(1, 0), cB + kstep, voffB); PG8_STAGE(PG8_SA(1, 0), cA + kstep, voffA); PG8_STAGE(PG8_SB(1, 1), cB + hstep + kstep, voffB);
        PG8_WAIT_V(6); PG8_BAR;
    } else {
        PG8_STAGE(PG8_SB(0, 0), cB, voffB); PG8_STAGE(PG8_SA(0, 0), cA, voffA); PG8_STAGE(PG8_SB(0, 1), cB + hstep, voffB); PG8_STAGE(PG8_SA(0, 1), cA + hstep, voffA);
        if (wr == 1) PG8_BAR;
        PG8_WAIT_V(4); PG8_BAR;
        PG8_STAGE(PG8_SB(1, 0), cB + kstep, voffB); PG8_STAGE(PG8_SA(1, 0), cA + kstep, voffA); PG8_STAGE(PG8_SB(1, 1), cB + hstep + kstep, voffB);
        PG8_WAIT_V(6); PG8_BAR;
    }
    for (;;) {
        const bool has_next = S.next(ui + 1, nxt);
        const char* nA = has_next ? (const char*)g.A + (size_t)nxt.pm * tstep : cA; const char* nB = has_next ? (const char*)g.Bt + (size_t)nxt.pb * tstep : cB;
        for (int t = 0; t < nt; t += 2) {
            const bool last = (t == nt - 2);
            const char* a1 = cA + (size_t)(t + 1) * kstep;
            const char* a2 = last ? nA : cA + (size_t)(t + 2) * kstep; const char* b2 = last ? nB : cB + (size_t)(t + 2) * kstep;
            const char* a3 = a2 + kstep; const char* b3 = b2 + kstep;
            if (last && has_next) S.a_ready(nxt);
            if constexpr (SP2) {
            PG8_LDB(B0, 0, 0); PG8_LDB(B1, 0, 1); PG8_SCHED; PG8_LDA(At, 0, 0); PG8_STAGE(PG8_SA(1, 1), a1 + hstep, voffA);
            PG8_WAIT_V(8); PG8_WAIT_L(0); PG8_BAR; PG8_MMA(0, 0, At, B0); PG8_MMA(0, 1, At, B1); PG8_BAR; PG8_SCHED;
            PG8_LDA(At, 0, 1); PG8_STAGE(PG8_SB(0, 0), b2, voffB); PG8_STAGE(PG8_SB(0, 1), b2 + hstep, voffB); PG8_STAGE(PG8_SA(0, 0), a2, voffA);
            PG8_WAIT_V(8); PG8_WAIT_L(0); PG8_BAR; PG8_MMA(1, 0, At, B0); PG8_MMA(1, 1, At, B1); PG8_BAR; PG8_SCHED;
            PG8_LDB(B0, 1, 0); PG8_LDB(B1, 1, 1); PG8_SCHED; PG8_LDA(At, 1, 0); PG8_STAGE(PG8_SA(0, 1), a2 + hstep, voffA);
            PG8_WAIT_V(8); PG8_WAIT_L(0); PG8_BAR; PG8_MMA(0, 0, At, B0); PG8_MMA(0, 1, At, B1); PG8_BAR; PG8_SCHED;
            PG8_LDA(At, 1, 1); PG8_STAGE(PG8_SB(1, 0), b3, voffB); PG8_STAGE(PG8_SB(1, 1), b3 + hstep, voffB); PG8_STAGE(PG8_SA(1, 0), a3, voffA);
            PG8_WAIT_V(8); PG8_WAIT_L(0); PG8_BAR; PG8_MMA(1, 0, At, B0); PG8_MMA(1, 1, At, B1); PG8_BAR; PG8_SCHED;
            } else {
            PG8_LDB(B0, 0, 0); PG8_SCHED; PG8_LDA(At, 0, 0); PG8_STAGE(PG8_SA(1, 1), a1 + hstep, voffA);
            PG8_WAIT_L(8); PG8_BAR; PG8_WAIT_L(0); PG8_MMA(0, 0, At, B0); PG8_BAR; PG8_SCHED;
            PG8_LDB(B1, 0, 1); PG8_STAGE(PG8_SB(0, 0), b2, voffB);
            PG8_BAR; PG8_WAIT_L(0); PG8_MMA(0, 1, At, B1); PG8_BAR;
            PG8_LDA(At, 0, 1); PG8_STAGE(PG8_SA(0, 0), a2, voffA);
            PG8_BAR; PG8_WAIT_L(0); PG8_MMA(1, 0, At, B0); PG8_BAR; PG8_SCHED;
            PG8_STAGE(PG8_SB(0, 1), b2 + hstep, voffB);
            PG8_WAIT_V(6); PG8_BAR; PG8_MMA(1, 1, At, B1); PG8_BAR;
            PG8_LDB(B0, 1, 0); PG8_SCHED; PG8_LDA(At, 1, 0); PG8_STAGE(PG8_SA(0, 1), a2 + hstep, voffA);
            PG8_WAIT_L(8); PG8_BAR; PG8_WAIT_L(0); PG8_MMA(0, 0, At, B0); PG8_BAR; PG8_SCHED;
            PG8_LDB(B1, 1, 1); PG8_STAGE(PG8_SB(1, 0), b3, voffB);
            PG8_BAR; PG8_WAIT_L(0); PG8_MMA(0, 1, At, B1); PG8_BAR;
            PG8_LDA(At, 1, 1); PG8_STAGE(PG8_SA(1, 0), a3, voffA);
            PG8_BAR; PG8_WAIT_L(0); PG8_MMA(1, 0, At, B0); PG8_BAR; PG8_SCHED;
            PG8_STAGE(PG8_SB(1, 1), b3 + hstep, voffB);
            PG8_WAIT_V(6); PG8_BAR; PG8_MMA(1, 1, At, B1); PG8_BAR;
            }
        }
        if constexpr (DT == 1) asm volatile("s_nop 15\n\ts_nop 15" ::: );
        if constexpr (ALIGN_EPI) { if (wr == 0) PG8_BAR; }
        if constexpr (!Epi::AFTER_DRAIN) { E(acc, cur, wr, wc, fr, fq); S.done(cur); }
        if (!has_next) break;
        float zl2_ = 0.f; asm volatile("" : "+v"(zl2_));
#pragma unroll
        for (int a = 0; a < 2; ++a)
#pragma unroll
            for (int b = 0; b < 2; ++b)
#pragma unroll
                for (int m = 0; m < 4; ++m)
#pragma unroll
                    for (int n = 0; n < 2; ++n) acc[a][b][m][n] = (f32x4){zl2_, zl2_, zl2_, zl2_};
        cur = nxt; cA = nA; cB = nB; ++ui;
        if constexpr (ALIGN_EPI) { if (wr == 1) PG8_BAR; }
    }
    PG8_WAIT_V(0);
    if constexpr (!ALIGN_EPI) { if (wr == 0) PG8_BAR; }
    PG8_BAR;
    if constexpr (Epi::AFTER_DRAIN) { E.fused(acc, cur, wr, wc, fr, fq, lds, wid, lane); S.done(cur); }
#undef PG8_SA
#undef PG8_SB
#undef PG8_STAGE
#undef PG8_LDA
#undef PG8_LDB
#undef PG8_MMA
#undef PG8_WAIT_V
#undef PG8_WAIT_L
#undef PG8_BAR
#undef PG8_SCHED
}
}

constexpr int BATCH = 8, SEQ = 4096, D = 1024, M = BATCH * SEQ, DEPTH = 4;
constexpr int DPOOL = 512, NPG = 4, PGC = 128, DML = 512, NH = 4, DH = 128, CONVW = 4;
constexpr int DIN = 2568, NZ = 2560;
constexpr int ZQ = 512, ZK = 1024, ZV = 1536, ZO = 2048;
constexpr int FFD = 2816, NE = 8, FFE = 3584;
constexpr float ALPHA = 1.6817928305074290f;
constexpr float LN_EPS = 1e-5f;
constexpr float KSCALE = 0.08838834764831845f;
constexpr int NWAVES = 8, NTHR = 512;
constexpr float F8_WSC = 64.0f, F8_HSC = 8.0f, F8_DSC = 256.0f, F8_ASC = 8.0f;
constexpr int MAX_TILES = 2 * M / 256 + NE, PASS_TILES = MAX_TILES, NPASS = 1;
constexpr int NPH = 18, NPHASES = 1 + DEPTH * NPH;

constexpr size_t MiB = 1u << 20;
constexpr size_t WS_CTL = 0, CTL_ZERO_BYTES = 2 * MiB;
constexpr size_t WS_GATE = 2 * MiB;
constexpr size_t WS_PWT = 3 * MiB;
constexpr size_t WS_MOE = 4 * MiB;
constexpr size_t MOE_TOK_E = WS_MOE, MOE_TOK_POS = WS_MOE + 256 * 1024, MOE_TOK_W = WS_MOE + 512 * 1024, MOE_TOK_SLOT = WS_MOE + 768 * 1024,
                 MOE_BLK_CNT = WS_MOE + 1024 * 1024, MOE_TILE_E = MOE_BLK_CNT + 8192, MOE_META = MOE_TILE_E + 4096;
constexpr size_t WS_WIN = 8 * MiB, WS_WOUT = 28 * MiB, WS_WGU = 36 * MiB, WS_WD = 58 * MiB, WS_EGU = 70 * MiB, WS_ED = 182 * MiB;
constexpr size_t WS_T = 238 * MiB;
constexpr size_t WS_XB = 302 * MiB;
constexpr size_t WS_R2 = 366 * MiB;
constexpr size_t WS_R3 = 606 * MiB;
constexpr size_t WS_R4 = 738 * MiB;
constexpr size_t WS_END = 870 * MiB;
constexpr size_t IN_FLOATS = (size_t)M * D + (size_t)DEPTH * D * DIN + 32 + 16384 + 4096 + 262144 + 2048 + 2048 + (size_t)DEPTH * D * D + 4 * 4096 + 3 * (size_t)2 * D * FFD + 16384 + 16 + 3 * (size_t)2 * NE * D * FFE;
static_assert(WS_END <= IN_FLOATS * 4, "workspace map exceeds the guaranteed d_ws size");
static_assert(WS_WIN + (size_t)DEPTH * NZ * D * 2 <= WS_WOUT && WS_WOUT + (size_t)DEPTH * D * D * 2 <= WS_WGU && WS_WGU + (size_t)2 * 2 * FFD * D * 2 <= WS_WD && WS_WD + (size_t)2 * D * FFD * 2 <= WS_EGU, "ws map 1");
static_assert(WS_EGU + (size_t)NE * 2 * FFE * D * 2 <= WS_ED && WS_ED + (size_t)NE * D * FFE * 2 <= WS_T && WS_T + (size_t)M * D * 2 <= WS_XB && WS_XB + (size_t)M * D * 2 <= WS_R2, "ws map 2");
static_assert(WS_R2 + (size_t)M * FFD * 2 <= WS_R3 && WS_R2 + (size_t)M * NZ * 2 <= WS_R3 && WS_R2 + (size_t)MAX_TILES * 256 * FFE <= WS_R3, "ws map 3");
static_assert(WS_R3 + (size_t)(2 * M + NE * 256) * D * 2 <= WS_R4 && WS_R4 + (size_t)(2 * M + NE * 256) * D * 2 <= WS_END && (size_t)M * 1024 * 2 + (size_t)M * 512 * 4 <= WS_END - WS_R4, "ws map 4");
constexpr int CW_BAR = 4096;
constexpr int LDS_BYTES = 147456, RING_BYTES = 131072, MISC_OFF = LDS_BYTES - 256;

#define GAS __attribute__((address_space(1)))
#define LAS __attribute__((address_space(3)))
typedef unsigned short bf16;
typedef unsigned v4u __attribute__((ext_vector_type(4)));
typedef unsigned v2u __attribute__((ext_vector_type(2)));
typedef float f32x4 __attribute__((ext_vector_type(4)));
#define LDS_WAIT() asm volatile("s_waitcnt lgkmcnt(0)" ::: "memory")
__device__ __forceinline__ unsigned f2bf(float f) { unsigned u = __builtin_bit_cast(unsigned, f); return (u + 0x7fffu + ((u >> 16) & 1u)) >> 16; }
typedef __bf16 bf16x2_hw __attribute__((ext_vector_type(2)));
typedef float f32x2_hw __attribute__((ext_vector_type(2)));
__device__ __forceinline__ unsigned pk2(float lo, float hi) { const f32x2_hw v = {lo, hi}; return __builtin_bit_cast(unsigned, __builtin_convertvector(v, bf16x2_hw)); }
__device__ __forceinline__ unsigned f8x4(float a, float b, float c, float d) {
    a = fminf(fmaxf(a, -448.f), 448.f); b = fminf(fmaxf(b, -448.f), 448.f); c = fminf(fmaxf(c, -448.f), 448.f); d = fminf(fmaxf(d, -448.f), 448.f);
    int r = __builtin_amdgcn_cvt_pk_fp8_f32(a, b, 0, false); r = __builtin_amdgcn_cvt_pk_fp8_f32(c, d, r, true); return (unsigned)r; }
__device__ __forceinline__ float bf2f(unsigned short b) { return __builtin_bit_cast(float, (unsigned)b << 16); }
__device__ __forceinline__ float bflo(unsigned w) { return __builtin_bit_cast(float, w << 16); }
__device__ __forceinline__ float bfhi(unsigned w) { return __builtin_bit_cast(float, w & 0xffff0000u); }
__device__ __forceinline__ int lane_id_v() { int l; asm volatile("v_mbcnt_lo_u32_b32 %0, -1, 0\n\tv_mbcnt_hi_u32_b32 %0, -1, %0" : "=v"(l)); return l; }
__device__ __forceinline__ float my_shfl_xor(float v, int o) { const int l = lane_id_v(); return __builtin_bit_cast(float, __builtin_amdgcn_ds_bpermute((l ^ o) << 2, __builtin_bit_cast(int, v))); }
__device__ __forceinline__ float my_shfl_up(float v, int o) { const int l = lane_id_v(); const int s = (l - o) < 0 ? l : (l - o); return __builtin_bit_cast(float, __builtin_amdgcn_ds_bpermute(s << 2, __builtin_bit_cast(int, v))); }
__device__ __forceinline__ int my_shfl_up(int v, int o) { const int l = lane_id_v(); const int s = (l - o) < 0 ? l : (l - o); return __builtin_amdgcn_ds_bpermute(s << 2, v); }
#define __shfl_xor(v, o) my_shfl_xor((v), (o))
#define __shfl_up(v, o) my_shfl_up((v), (o))
__device__ __forceinline__ float wave_sum(float v) {
#pragma unroll
    for (int o = 1; o < 64; o <<= 1) v += __shfl_xor(v, o);
    return v;
}
__device__ __forceinline__ float sigmoid_f(float x) { return 1.0f / (1.0f + __expf(-x)); }
#define XB_TMO      128
#define XB_XCNT(j)  (256  + 64 * (j))
#define XB_XSUB(j)  (1280 + 64 * (j))
#define XB_XGEN(j)  (2304 + 64 * (j))
#define XB_TOP      3328
#define XB_TOPGEN   3392
#define XCD_BAR_WORDS 3456
#define XB_SPIN_CAP (1u << 18)

__device__ __forceinline__ unsigned xb_ld(unsigned* p)              { return __hip_atomic_load(p, __ATOMIC_RELAXED, __HIP_MEMORY_SCOPE_AGENT); }
__device__ __forceinline__ unsigned xb_add(unsigned* p, unsigned v) { return __hip_atomic_fetch_add(p, v, __ATOMIC_RELAXED, __HIP_MEMORY_SCOPE_AGENT); }
__device__ __forceinline__ unsigned xb_xcc_id() { return (unsigned)__builtin_amdgcn_s_getreg((3 << 11) | 20) & 0xFu; }
#define XB_SPIN(cond, bar) do { unsigned _sp = 0; while (cond) { __builtin_amdgcn_s_sleep(1); \
    if ((++_sp & 255u) == 0u) { if (xb_ld(&(bar)[XB_TMO])) break; if (_sp > XB_SPIN_CAP) { atomicAdd(&(bar)[XB_TMO], 1u); break; } } } } while (0)

struct XcdBarrier {
    unsigned* bar; unsigned x;
    volatile LAS unsigned* st;
};

__device__ __forceinline__ XcdBarrier xcd_barrier_post(unsigned* bar, volatile LAS unsigned* st) {
    XcdBarrier b; b.bar = bar; b.x = xb_xcc_id(); b.st = st;
    if (threadIdx.x == 0) (void)xb_add(&bar[XB_XCNT(b.x)], 1u);
    return b;
}
__device__ __forceinline__ void xcd_barrier_complete(unsigned* bar, unsigned x, unsigned& nloc, unsigned& nx) {
    const unsigned G = gridDim.x * gridDim.y * gridDim.z;
    unsigned sum, cnt, mine, sp = 0u;
    for (;;) {
        sum = 0u; cnt = 0u; mine = 0u;
#pragma unroll
        for (unsigned j = 0; j < 16; ++j) { const unsigned c = xb_ld(&bar[XB_XCNT(j)]); sum += c; cnt += (c > 0u) ? 1u : 0u; mine = (j == x) ? c : mine; }
        if (sum == G) break;
        __builtin_amdgcn_s_sleep(1);
        if ((++sp & 255u) == 0u) { if (xb_ld(&bar[XB_TMO])) break; if (sp > XB_SPIN_CAP) { atomicAdd(&bar[XB_TMO], 1u); break; } }
    }
    nloc = mine > 0u ? mine : 1u; nx = cnt > 0u ? cnt : 1u;
}

__device__ __forceinline__ void xcd_barrier(const XcdBarrier& b) {
    asm volatile("s_waitcnt vmcnt(0)" ::: "memory");
    __syncthreads();
    if (threadIdx.x == 0) {
        unsigned* bar = b.bar;
        __builtin_amdgcn_s_waitcnt(0);
        unsigned nloc = b.st[0], nx = b.st[1];
        if (nloc == 0u) { xcd_barrier_complete(bar, b.x, nloc, nx); b.st[0] = nloc; b.st[1] = nx; }
        const unsigned old = xb_add(&bar[XB_XSUB(b.x)], 1u);
        const unsigned gen = old / nloc;
        if (old + 1u == (gen + 1u) * nloc) {
            __builtin_amdgcn_fence(__ATOMIC_RELEASE, "agent");
            asm volatile("s_waitcnt vmcnt(0)" ::: "memory");
            const unsigned og = xb_add(&bar[XB_TOP], 1u);
            const unsigned tgt = (og / nx + 1u) * nx;
            if (og + 1u != tgt) XB_SPIN(xb_ld(&bar[XB_TOP]) < tgt, bar);
            xb_add(&bar[XB_XGEN(b.x)], 1u);
            __builtin_amdgcn_fence(__ATOMIC_ACQUIRE, "agent");
            asm volatile("s_waitcnt vmcnt(0)" ::: "memory");
        } else {
            XB_SPIN(xb_ld(&bar[XB_XGEN(b.x)]) == gen, bar);
            __builtin_amdgcn_fence(__ATOMIC_ACQUIRE, "agent");
            asm volatile("s_waitcnt vmcnt(0)" ::: "memory");
        }
    }
    __syncthreads();
}

struct Args { const float* in[21]; float* out; unsigned char* ws; int ph_lo, ph_hi, li, pad; };
static_assert(sizeof(Args) == 21 * 8 + 8 + 8 + 16, "Args has no padding");
typedef const __attribute__((address_space(4))) Args* ArgsP;
struct Ctx {
    LAS unsigned char* lds; int tid, lane, wave, G, bid;
    ArgsP Ap;
};
__device__ __forceinline__ Ctx make_ctx(unsigned char* lds_raw, int wave_s) {
    const int tid = wave_s * 64 + lane_id_v();
    ArgsP ap = (ArgsP)__builtin_amdgcn_kernarg_segment_ptr(); asm volatile("" : "+s"(ap));
    int G = (int)gridDim.x, bid = (int)blockIdx.x; asm volatile("" : "+s"(G), "+s"(bid));
    Ctx C{(LAS unsigned char*)lds_raw, tid, tid & 63, wave_s, G, bid, ap};
    return C;
}
enum { I_X = 0, I_WIN, I_BG, I_CW, I_CB, I_PW, I_PS, I_MG, I_WOUT, I_L1G, I_L1B, I_L2G, I_L2B, I_WGD, I_WUD, I_WDD, I_WR, I_BR, I_WGE, I_WUE, I_WDE };
#define WSP(T, off) ((T*)(C.Ap->ws + (off)))

template <bool F8 = false> __device__ __forceinline__ void cvt_item(const float* W, int ldw, int K, int k0, int nsrc0, bf16* WT, int drow0, LAS float* scr, int lane, float fsc = 1.0f) {
    f32x4 t[16];
#pragma unroll
    for (int i = 0; i < 16; ++i) t[i] = *(const f32x4*)(W + (size_t)(k0 + (lane >> 4) + 4 * i) * ldw + nsrc0 + 4 * (lane & 15));
#pragma unroll
    for (int i = 0; i < 16; ++i) { LAS float* p = scr + ((lane >> 4) + 4 * i) * 65 + 4 * (lane & 15); p[0] = t[i].x; p[1] = t[i].y; p[2] = t[i].z; p[3] = t[i].w; }
    LDS_WAIT(); asm volatile("" ::: "memory");
    const int c = lane & 7;
#pragma unroll
    for (int j = 0; j < 8; ++j) { const int n = (lane >> 3) + 8 * j; const LAS float* s = scr + (8 * c) * 65 + n;
        if constexpr (F8) { v2u o; o.x = f8x4(s[0 * 65] * fsc, s[1 * 65] * fsc, s[2 * 65] * fsc, s[3 * 65] * fsc); o.y = f8x4(s[4 * 65] * fsc, s[5 * 65] * fsc, s[6 * 65] * fsc, s[7 * 65] * fsc);
            *(v2u*)((unsigned char*)WT + (size_t)(drow0 + n) * K + k0 + 8 * c) = o; }
        else { v4u o; o.x = pk2(s[0 * 65], s[1 * 65]); o.y = pk2(s[2 * 65], s[3 * 65]); o.z = pk2(s[4 * 65], s[5 * 65]); o.w = pk2(s[6 * 65], s[7 * 65]);
            *(v4u*)(WT + (size_t)(drow0 + n) * K + k0 + 8 * c) = o; } }
    LDS_WAIT(); asm volatile("" ::: "memory");
}
template <int MODE, bool F8 = false> __device__ __forceinline__ void cvt_mat(const float* W, int ldw, int K, int ncols, bf16* WT, int item, LAS float* scr, int lane, float fsc = 1.0f) {
    const int nblk = ncols / 64, kb = item / nblk, nb = item % nblk, n0 = 64 * nb;
    const int drow0 = MODE == 0 ? n0 : ((n0 >> 7) * 256 + (n0 & 127) + (MODE == 2 ? 128 : 0));
    cvt_item<F8>(W, ldw, K, 64 * kb, n0, WT, drow0, scr, lane, fsc);
}
constexpr int CVT_SCR = 64 * 65 * 4;
constexpr int IT_WIN = (D / 64) * (NZ / 64), IT_WOUT = (D / 64) * (D / 64), IT_G = (D / 64) * (FFD / 64), IT_DD = (FFD / 64) * (D / 64), IT_EG = (D / 64) * (FFE / 64), IT_ED = (FFE / 64) * (D / 64);
static_assert(8 * CVT_SCR <= MISC_OFF && NZ % 64 == 0 && FFD % 64 == 0 && FFE % 64 == 0, "converter tiles");
__device__ __forceinline__ void convert_experts(Ctx& C, int j) {
    LAS float* scr = (LAS float*)(C.lds + C.wave * CVT_SCR);
    const int gw = C.bid * NWAVES + C.wave, NGW = C.G * NWAVES;
    static_assert(IT_EG == IT_ED, "expert item counts");
    for (int it = gw; it < 3 * NE * IT_EG; it += NGW) {
        const int kind = it / (NE * IT_EG), e = (it / IT_EG) % NE, r = it % IT_EG;
        if (kind == 0) cvt_mat<1, true>(C.Ap->in[I_WGE] + (size_t)(j * NE + e) * D * FFE, FFE, D, FFE, (bf16*)(WSP(unsigned char, WS_EGU) + (size_t)e * 2 * FFE * D), r, scr, C.lane, F8_WSC);
        else if (kind == 1) cvt_mat<2, true>(C.Ap->in[I_WUE] + (size_t)(j * NE + e) * D * FFE, FFE, D, FFE, (bf16*)(WSP(unsigned char, WS_EGU) + (size_t)e * 2 * FFE * D), r, scr, C.lane, F8_WSC);
        else cvt_mat<0, true>(C.Ap->in[I_WDE] + (size_t)(j * NE + e) * FFE * D, D, FFE, D, (bf16*)(WSP(unsigned char, WS_ED) + (size_t)e * D * FFE), r, scr, C.lane, F8_DSC);
    }
}
__device__ __forceinline__ void load_w8(Ctx& C, LAS float* wl, const float* W, int ldw, int coff) {
    for (int k = C.tid; k < D; k += NTHR) { const float* p = W + (size_t)k * ldw + coff;
#pragma unroll
        for (int g = 0; g < 8; ++g) wl[g * 1024 + k] = p[g]; }
}
__device__ __forceinline__ int colof(int j, int lane) { return (j >> 1) * 512 + 8 * lane + (j & 1) * 4; }
__device__ __forceinline__ void load_vec_f32(const float* p, f32x4 (&v)[4], int lane) {
#pragma unroll
    for (int j = 0; j < 4; ++j) v[j] = *(const f32x4*)(p + colof(j, lane));
}
__device__ __forceinline__ void store_row_f32(float* row, const f32x4 (&v)[4], int lane) {
#pragma unroll
    for (int j = 0; j < 4; ++j) *(f32x4*)(row + colof(j, lane)) = v[j];
}
__device__ __forceinline__ void load_row_bf16(const bf16* row, f32x4 (&v)[4], int lane) {
    const v4u a = *(const v4u*)(row + 8 * lane), b = *(const v4u*)(row + 512 + 8 * lane);
    v[0] = (f32x4){bflo(a.x), bfhi(a.x), bflo(a.y), bfhi(a.y)}; v[1] = (f32x4){bflo(a.z), bfhi(a.z), bflo(a.w), bfhi(a.w)};
    v[2] = (f32x4){bflo(b.x), bfhi(b.x), bflo(b.y), bfhi(b.y)}; v[3] = (f32x4){bflo(b.z), bfhi(b.z), bflo(b.w), bfhi(b.w)};
}
__device__ __forceinline__ void store_row_bf16(bf16* row, const f32x4 (&v)[4], int lane) {
    v4u a, b; a.x = pk2(v[0].x, v[0].y); a.y = pk2(v[0].z, v[0].w); a.z = pk2(v[1].x, v[1].y); a.w = pk2(v[1].z, v[1].w);
    b.x = pk2(v[2].x, v[2].y); b.y = pk2(v[2].z, v[2].w); b.z = pk2(v[3].x, v[3].y); b.w = pk2(v[3].z, v[3].w);
    *(v4u*)(row + 8 * lane) = a; *(v4u*)(row + 512 + 8 * lane) = b;
}
__device__ __forceinline__ void load_row_res(const bf16* trow, const bf16* xrow, f32x4 (&v)[4], int lane) {
    f32x4 t[4], x[4]; load_row_bf16(trow, t, lane); load_row_bf16(xrow, x, lane);
#pragma unroll
    for (int j = 0; j < 4; ++j) v[j] = x[j] * ALPHA + t[j];
}
__device__ __forceinline__ float dot8(const f32x4 (&v)[4], const LAS float* wl, int lane) {
    float a[8];
#pragma unroll
    for (int g = 0; g < 8; ++g) { float s = 0.f;
#pragma unroll
        for (int j = 0; j < 4; ++j) { const f32x4 w = *(const LAS f32x4*)(wl + g * 1024 + colof(j, lane)); s += (v[j].x * w.x + v[j].y * w.y) + (v[j].z * w.z + v[j].w * w.w); }
        a[g] = s; }
    float b4[4], b2[2], b1;
    { const bool hi = (lane & 32) != 0;
#pragma unroll
      for (int i = 0; i < 4; ++i) { const float keep = hi ? a[i + 4] : a[i], send = hi ? a[i] : a[i + 4]; b4[i] = keep + __shfl_xor(send, 32); } }
    { const bool hi = (lane & 16) != 0;
#pragma unroll
      for (int i = 0; i < 2; ++i) { const float keep = hi ? b4[i + 2] : b4[i], send = hi ? b4[i] : b4[i + 2]; b2[i] = keep + __shfl_xor(send, 16); } }
    { const bool hi = (lane & 8) != 0; const float keep = hi ? b2[1] : b2[0], send = hi ? b2[0] : b2[1]; b1 = keep + __shfl_xor(send, 8); }
    b1 += __shfl_xor(b1, 4); b1 += __shfl_xor(b1, 2); b1 += __shfl_xor(b1, 1);
    return b1;
}
__device__ __forceinline__ void write_gates(Ctx& C, int lnext, int m, const f32x4 (&v)[4], const LAS float* wl) {
    const float val = dot8(v, wl, C.lane);
    if ((C.lane & 7) == 0) WSP(float, WS_GATE)[(size_t)m * 8 + (C.lane >> 3)] = val + C.Ap->in[I_BG][lnext * 8 + (C.lane >> 3)];
}

__device__ __forceinline__ void phase_prologue(Ctx& C) {
    LAS float* scr = (LAS float*)(C.lds + C.wave * CVT_SCR);
    const int gw = C.bid * NWAVES + C.wave, NGW = C.G * NWAVES;
    constexpr int IT_PW = (PGC / 64) * (PGC / 64);
    constexpr int NI = 4 * IT_WIN + 4 * IT_WOUT + 4 * IT_G + 2 * IT_DD + DEPTH * NPG * IT_PW;
    for (int it = gw; it < NI; it += NGW) {
        int r = it;
        if (r < 4 * IT_WIN) { const int l = r / IT_WIN; cvt_mat<0>(C.Ap->in[I_WIN] + (size_t)l * D * DIN, DIN, D, NZ, WSP(bf16, WS_WIN) + (size_t)l * NZ * D, r % IT_WIN, scr, C.lane); continue; } r -= 4 * IT_WIN;
        if (r < 4 * IT_WOUT) { const int l = r / IT_WOUT; cvt_mat<0>(C.Ap->in[I_WOUT] + (size_t)l * D * D, D, D, D, WSP(bf16, WS_WOUT) + (size_t)l * D * D, r % IT_WOUT, scr, C.lane); continue; } r -= 4 * IT_WOUT;
        if (r < 2 * IT_G) { const int j = r / IT_G; cvt_mat<1>(C.Ap->in[I_WGD] + (size_t)j * D * FFD, FFD, D, FFD, WSP(bf16, WS_WGU) + (size_t)j * 2 * FFD * D, r % IT_G, scr, C.lane); continue; } r -= 2 * IT_G;
        if (r < 2 * IT_G) { const int j = r / IT_G; cvt_mat<2>(C.Ap->in[I_WUD] + (size_t)j * D * FFD, FFD, D, FFD, WSP(bf16, WS_WGU) + (size_t)j * 2 * FFD * D, r % IT_G, scr, C.lane); continue; } r -= 2 * IT_G;
        if (r < 2 * IT_DD) { const int j = r / IT_DD; cvt_mat<0, true>(C.Ap->in[I_WDD] + (size_t)j * FFD * D, D, FFD, D, (bf16*)(WSP(unsigned char, WS_WD) + (size_t)j * D * FFD), r % IT_DD, scr, C.lane, F8_DSC); continue; } r -= 2 * IT_DD;
        { const int lg = r / IT_PW; cvt_mat<0>(C.Ap->in[I_PW] + (size_t)lg * PGC * PGC, PGC, PGC, PGC, WSP(bf16, WS_PWT) + (size_t)lg * PGC * PGC, r % IT_PW, scr, C.lane); }
    }
    convert_experts(C, 0);
    __syncthreads();
    LAS float* wl = (LAS float*)C.lds;
    load_w8(C, wl, C.Ap->in[I_WIN], DIN, NZ);
    __syncthreads();
    for (int m = gw; m < M; m += NGW) {
        f32x4 v[4]; load_vec_f32(C.Ap->in[I_X] + (size_t)m * D, v, C.lane);
        store_row_bf16(WSP(bf16, WS_XB) + (size_t)m * D, v, C.lane);
        write_gates(C, 0, m, v, wl);
    }
}

__device__ __forceinline__ void phase_conv(Ctx& C, int l) {
    const bf16* Z = WSP(bf16, WS_R2); bf16* QK = WSP(bf16, WS_R4);
    const int c8 = (C.tid & 127) * 8; const float sc = c8 >= 512 ? KSCALE : 1.0f;
    const float* cw = C.Ap->in[I_CW] + (size_t)l * CONVW * 1024 + c8; const float* cb = C.Ap->in[I_CB] + (size_t)l * 1024 + c8;
    float w[CONVW][8], bias[8];
#pragma unroll
    for (int j = 0; j < CONVW; ++j) { const f32x4 a = *(const f32x4*)(cw + j * 1024), b2 = *(const f32x4*)(cw + j * 1024 + 4);
        w[j][0] = a.x; w[j][1] = a.y; w[j][2] = a.z; w[j][3] = a.w; w[j][4] = b2.x; w[j][5] = b2.y; w[j][6] = b2.z; w[j][7] = b2.w; }
    { const f32x4 a = *(const f32x4*)cb, b2 = *(const f32x4*)(cb + 4); bias[0] = a.x; bias[1] = a.y; bias[2] = a.z; bias[3] = a.w; bias[4] = b2.x; bias[5] = b2.y; bias[6] = b2.z; bias[7] = b2.w; }
    const int tg0 = C.bid * (NTHR / 128) + (C.tid >> 7), TGS = C.G * (NTHR / 128);
    for (int tg = tg0; tg < M / 4; tg += TGS) {
        const int m0 = tg * 4, t0 = m0 & (SEQ - 1);
        v4u zr[7];
#pragma unroll
        for (int r = 0; r < 7; ++r) { zr[r] = (v4u){0u, 0u, 0u, 0u}; if (t0 - 3 + r >= 0) zr[r] = *(const v4u*)(Z + (size_t)(m0 - 3 + r) * NZ + ZQ + c8); }
#pragma unroll
        for (int i = 0; i < 4; ++i) { float a[8];
#pragma unroll
            for (int e = 0; e < 8; ++e) a[e] = bias[e];
#pragma unroll
            for (int j = 0; j < CONVW; ++j) { const v4u zz = zr[i + j];
                a[0] += w[j][0] * bflo(zz.x); a[1] += w[j][1] * bfhi(zz.x); a[2] += w[j][2] * bflo(zz.y); a[3] += w[j][3] * bfhi(zz.y);
                a[4] += w[j][4] * bflo(zz.z); a[5] += w[j][5] * bfhi(zz.z); a[6] += w[j][6] * bflo(zz.w); a[7] += w[j][7] * bfhi(zz.w); }
#pragma unroll
            for (int e = 0; e < 8; ++e) a[e] = a[e] * sigmoid_f(a[e]) * sc;
            v4u o; o.x = pk2(a[0], a[1]); o.y = pk2(a[2], a[3]); o.z = pk2(a[4], a[5]); o.w = pk2(a[6], a[7]);
            *(v4u*)(QK + (size_t)(m0 + i) * 1024 + c8) = o; }
    }
}

__device__ __forceinline__ void phase_pool(Ctx& C, int l) {
    typedef short bf16x8 __attribute__((ext_vector_type(8)));
    const bf16* Z = WSP(bf16, WS_R2); bf16* YC = WSP(bf16, WS_R3); const bf16* PWT = WSP(bf16, WS_PWT) + (size_t)l * NPG * PGC * PGC;
    constexpr int UROW = 272, DOFF = 80 * UROW, USZ = DOFF + 64 * UROW;
    static_assert(2 * USZ <= MISC_OFF, "pool LDS");
    LAS unsigned char* L = C.lds;
    const int tid = C.tid, lane = C.lane, w = C.wave, lr = lane & 15, lg = lane >> 4;
    const int NU = (M / 64) * NPG;
    int gprev[2] = {-1, -1}; bf16x8 xw[2][4]; f32x4 sc[2];
#pragma unroll
    for (int s = 0; s < 2; ++s) { sc[s] = (f32x4){0.f, 0.f, 0.f, 0.f};
#pragma unroll
        for (int ks = 0; ks < 4; ++ks) xw[s][ks] = (bf16x8){0, 0, 0, 0, 0, 0, 0, 0}; }
    v4u pu[2][3];
#define PL_LOAD(s_, u_) do { if ((u_) < NU) { const int g_ = (u_) & 3, m0_ = ((u_) >> 2) * 64, t0_ = m0_ & (SEQ - 1); _Pragma("unroll") for (int i_ = 0; i_ < 3; ++i_) { const int p_ = tid + NTHR * i_, r_ = p_ >> 4, ch_ = p_ & 15; \
        pu[s_][i_] = (v4u){0u, 0u, 0u, 0u}; if (r_ < 79 && t0_ - 15 + r_ >= 0) pu[s_][i_] = *(const v4u*)(Z + (size_t)(m0_ - 15 + r_) * NZ + g_ * PGC + ch_ * 8); } } } while (0)
#define PL_STORE(s_) do { _Pragma("unroll") for (int i_ = 0; i_ < 3; ++i_) { const int p_ = tid + NTHR * i_, r_ = p_ >> 4, ch_ = p_ & 15; if (r_ < 79) *(LAS v4u*)(L + (s_) * USZ + r_ * UROW + ch_ * 16) = pu[s_][i_]; } } while (0)
    PL_LOAD(0, C.bid); PL_LOAD(1, C.bid + C.G);
    for (int u0 = C.bid; u0 < NU; u0 += 2 * C.G) {
        const int nu = (u0 + C.G < NU) ? 2 : 1;
        __syncthreads();
        PL_STORE(0); if (nu > 1) PL_STORE(1);
#pragma unroll
        for (int s = 0; s < 2; ++s) { const int g = (u0 + s * C.G) & 3;
            if (s < nu && g != gprev[s]) { gprev[s] = g;
#pragma unroll
                for (int ks = 0; ks < 4; ++ks) xw[s][ks] = *(const bf16x8*)(PWT + (size_t)(g * PGC + 16 * w + lr) * PGC + 32 * ks + 8 * lg);
                sc[s] = *(const f32x4*)(C.Ap->in[I_PS] + (size_t)l * DPOOL + g * PGC + 16 * w + 4 * lg); } }
        __syncthreads();
        PL_LOAD(0, u0 + 2 * C.G); PL_LOAD(1, u0 + 3 * C.G);
#pragma unroll
        for (int s = 0; s < 2; ++s) if (s < nu) { const int u = u0 + s * C.G, g = u & 3, t0 = ((u >> 2) * 64) & (SEQ - 1);
          LAS unsigned char* Ls = L + s * USZ;
          const int cp = tid & 63, r0 = 8 * w, wn = 2 << g;
          float s0 = 0.f, s1 = 0.f;
          for (int j = 0; j < wn; ++j) { const unsigned x = *(const LAS unsigned*)(Ls + (r0 + 15 - j) * UROW + cp * 4); s0 += bflo(x); s1 += bfhi(x); }
#pragma unroll
          for (int i = 0; i < 8; ++i) { const int r = r0 + i, t = t0 + r;
              const unsigned xc = *(const LAS unsigned*)(Ls + (r + 15) * UROW + cp * 4);
              if (i > 0) { const unsigned xo = *(const LAS unsigned*)(Ls + (r + 15 - wn) * UROW + cp * 4); s0 += bflo(xc) - bflo(xo); s1 += bfhi(xc) - bfhi(xo); }
              const float inv = 1.0f / (float)((t + 1) < wn ? (t + 1) : wn);
              *(LAS unsigned*)(Ls + DOFF + r * UROW + cp * 4) = pk2(s0 * inv - bflo(xc), s1 * inv - bfhi(xc)); } }
        __syncthreads();
#pragma unroll
        for (int s = 0; s < 2; ++s) if (s < nu) { const int u = u0 + s * C.G, g = u & 3, m0 = (u >> 2) * 64;
#pragma unroll
          for (int rt = 0; rt < 4; ++rt) { f32x4 acc = {0.f, 0.f, 0.f, 0.f};
#pragma unroll
            for (int ks = 0; ks < 4; ++ks) { const bf16x8 y = *(const LAS bf16x8*)(L + s * USZ + DOFF + (16 * rt + lr) * UROW + (32 * ks + 8 * lg) * 2); acc = __builtin_amdgcn_mfma_f32_16x16x32_bf16(xw[s][ks], y, acc, 0, 0, 0); }
            acc = acc * sc[s]; v2u o; o.x = pk2(acc[0], acc[1]); o.y = pk2(acc[2], acc[3]);
            *(v2u*)(YC + (size_t)(m0 + 16 * rt + lr) * D + g * PGC + 16 * w + 4 * lg) = o; } }
    }
#undef PL_LOAD
#undef PL_STORE
}

__device__ __forceinline__ void ln_apply(f32x4 (&v)[4], const f32x4 (&g)[4], const f32x4 (&b)[4]) {
    float s = 0.f;
#pragma unroll
    for (int j = 0; j < 4; ++j) s += (v[j].x + v[j].y) + (v[j].z + v[j].w);
    const float mean = wave_sum(s) * (1.0f / D); float s2 = 0.f;
#pragma unroll
    for (int j = 0; j < 4; ++j) { v[j] = v[j] - mean; s2 += (v[j].x * v[j].x + v[j].y * v[j].y) + (v[j].z * v[j].z + v[j].w * v[j].w); }
    const float rstd = 1.0f / sqrtf(wave_sum(s2) * (1.0f / D) + LN_EPS);
#pragma unroll
    for (int j = 0; j < 4; ++j) v[j] = v[j] * rstd * g[j] + b[j];
}

template <bool MOE> __device__ __forceinline__ void phase_ln1(Ctx& C, int l) {
    const bf16* T = WSP(bf16, WS_T); bf16* XB = WSP(bf16, WS_XB);
    f32x4 g[4], b[4]; load_vec_f32(C.Ap->in[I_L1G] + (size_t)l * D, g, C.lane); load_vec_f32(C.Ap->in[I_L1B] + (size_t)l * D, b, C.lane);
    if constexpr (!MOE) {
        const int gw = C.bid * NWAVES + C.wave, NGW = C.G * NWAVES;
        f32x4 v[4]; if (gw < M) load_row_res(T + (size_t)gw * D, XB + (size_t)gw * D, v, C.lane);
        for (int m = gw; m < M; m += NGW) {
            f32x4 vn[4]; if (m + NGW < M) load_row_res(T + (size_t)(m + NGW) * D, XB + (size_t)(m + NGW) * D, vn, C.lane);
            ln_apply(v, g, b);
            store_row_bf16(XB + (size_t)m * D, v, C.lane);
#pragma unroll
            for (int j = 0; j < 4; ++j) v[j] = vn[j];
        }
    } else {
        const int jm = l >> 1;
        LAS float* wl = (LAS float*)C.lds;
        LAS int* sel = (LAS int*)(C.lds + 32768);
        LAS int* cnth = sel + 128;
        int* tok_e = WSP(int, MOE_TOK_E); int* tok_pos = WSP(int, MOE_TOK_POS); float* tok_w = WSP(float, MOE_TOK_W); int* blk_cnt = WSP(int, MOE_BLK_CNT);
        load_w8(C, wl, C.Ap->in[I_WR] + (size_t)jm * D * NE, NE, 0);
        __syncthreads();
        const float brl = C.Ap->in[I_BR][jm * NE + (C.lane >> 3)];
        for (int rg = C.bid; rg < M / 128; rg += C.G) {
            f32x4 v[4]; load_row_res(T + (size_t)(rg * 128 + C.wave * 16) * D, XB + (size_t)(rg * 128 + C.wave * 16) * D, v, C.lane);
            for (int i = 0; i < 16; ++i) {
                const int rl = C.wave * 16 + i, m = rg * 128 + rl;
                f32x4 vn[4]; if (i + 1 < 16) load_row_res(T + (size_t)(m + 1) * D, XB + (size_t)(m + 1) * D, vn, C.lane);
                ln_apply(v, g, b);
                store_row_bf16(XB + (size_t)m * D, v, C.lane);
                const float lgt = dot8(v, wl, C.lane) + brl;
                float lg[8];
#pragma unroll
                for (int e = 0; e < 8; ++e) lg[e] = __builtin_bit_cast(float, __builtin_amdgcn_readlane(__builtin_bit_cast(int, lgt), 8 * e));
                int e0 = 0; float v0 = lg[0];
#pragma unroll
                for (int e = 1; e < 8; ++e) if (lg[e] > v0) { v0 = lg[e]; e0 = e; }
                int e1 = -1; float v1 = -3.0e38f;
#pragma unroll
                for (int e = 0; e < 8; ++e) if (e != e0 && lg[e] > v1) { v1 = lg[e]; e1 = e; }
                const float ex = __expf(v1 - v0), w0 = 1.0f / (1.0f + ex), w1 = ex * w0;
                if (C.lane == 0) { sel[rl] = e0 | (e1 << 8); tok_w[(size_t)m * 2] = w0; tok_w[(size_t)m * 2 + 1] = w1; }
#pragma unroll
                for (int j = 0; j < 4; ++j) v[j] = vn[j];
            }
            __syncthreads();
            int e0 = 0, e1 = 0, pos0 = 0, pos1 = 0;
            if (C.tid < 128) {
                const int s = sel[C.tid]; e0 = s & 255; e1 = s >> 8;
                const unsigned long long lt = (1ull << C.lane) - 1ull;
                int cnt8[8];
#pragma unroll
                for (int e = 0; e < 8; ++e) { const unsigned long long m0 = __ballot(e0 == e), m1 = __ballot(e1 == e);
                    if (e0 == e) pos0 = __popcll(m0 & lt); if (e1 == e) pos1 = __popcll(m0) + __popcll(m1 & lt);
                    cnt8[e] = __popcll(m0) + __popcll(m1); }
                if (C.lane == 0) {
#pragma unroll
                    for (int e = 0; e < 8; ++e) cnth[C.wave * 8 + e] = cnt8[e]; }
            }
            __syncthreads();
            if (C.tid < 128) {
                if (C.wave == 1) { pos0 += cnth[e0]; pos1 += cnth[e1]; }
                const int m = rg * 128 + C.tid;
                tok_e[(size_t)m * 2] = e0; tok_e[(size_t)m * 2 + 1] = e1; tok_pos[(size_t)m * 2] = pos0; tok_pos[(size_t)m * 2 + 1] = pos1;
                if (C.tid < 8) blk_cnt[rg * 8 + C.tid] = cnth[C.tid] + cnth[8 + C.tid];
            }
            __syncthreads();
        }
    }
}

__device__ __forceinline__ void phase_moe_prep(Ctx& C) {
    LAS int* cin = (LAS int*)C.lds;
    LAS int* off = cin + 2048;
    LAS int* tot = off + 2048;
    LAS int* base = tot + 8;
    const int* blk_cnt = WSP(int, MOE_BLK_CNT); const int* tok_e = WSP(int, MOE_TOK_E); const int* tok_pos = WSP(int, MOE_TOK_POS);
    int* tok_slot = WSP(int, MOE_TOK_SLOT); int* tile_e = WSP(int, MOE_TILE_E); int* meta = WSP(int, MOE_META);
    for (int i = C.tid; i < 2048; i += NTHR) cin[i] = blk_cnt[i];
    __syncthreads();
    { const int e = C.wave, i = C.lane;
      const int s0 = cin[(4 * i) * 8 + e], s1 = cin[(4 * i + 1) * 8 + e], s2 = cin[(4 * i + 2) * 8 + e], s3 = cin[(4 * i + 3) * 8 + e];
      const int t = s0 + s1 + s2 + s3; int inc = t;
#pragma unroll
      for (int o = 1; o < 64; o <<= 1) { const int y = __shfl_up(inc, o); if (i >= o) inc += y; }
      const int ex = inc - t;
      off[(4 * i) * 8 + e] = ex; off[(4 * i + 1) * 8 + e] = ex + s0; off[(4 * i + 2) * 8 + e] = ex + s0 + s1; off[(4 * i + 3) * 8 + e] = ex + s0 + s1 + s2;
      if (i == 63) tot[e] = inc; }
    __syncthreads();
    if (C.tid == 0) { int bs = 0;
        for (int e = 0; e < 8; ++e) { base[e] = bs; bs += ((tot[e] + 255) >> 8) << 8; }
        base[8] = bs;
        if (C.bid == 0) meta[0] = bs >> 8; }
    __syncthreads();
    if (C.bid == 0) { const int nt = base[8] >> 8;
        for (int rt = C.tid; rt < nt; rt += NTHR) { int e = 0;
#pragma unroll
            for (int k = 1; k < 8; ++k) e += (rt >= (base[k] >> 8)) ? 1 : 0;
            tile_e[rt] = e; } }
    const int gw = C.bid * NWAVES + C.wave, NGW = C.G * NWAVES;
    const bf16* XB = WSP(bf16, WS_XB); unsigned char* HS = WSP(unsigned char, WS_R3);
    for (int m = gw; m < M; m += NGW) {
        const int rg = m >> 7;
        const v4u r0 = *(const v4u*)(XB + (size_t)m * D + 16 * C.lane), r1 = *(const v4u*)(XB + (size_t)m * D + 16 * C.lane + 8);
        v4u o;
        o.x = f8x4(bflo(r0.x) * F8_HSC, bfhi(r0.x) * F8_HSC, bflo(r0.y) * F8_HSC, bfhi(r0.y) * F8_HSC); o.y = f8x4(bflo(r0.z) * F8_HSC, bfhi(r0.z) * F8_HSC, bflo(r0.w) * F8_HSC, bfhi(r0.w) * F8_HSC);
        o.z = f8x4(bflo(r1.x) * F8_HSC, bfhi(r1.x) * F8_HSC, bflo(r1.y) * F8_HSC, bfhi(r1.y) * F8_HSC); o.w = f8x4(bflo(r1.z) * F8_HSC, bfhi(r1.z) * F8_HSC, bflo(r1.w) * F8_HSC, bfhi(r1.w) * F8_HSC);
#pragma unroll
        for (int k = 0; k < 2; ++k) {
            const int e = tok_e[(size_t)m * 2 + k], pos = tok_pos[(size_t)m * 2 + k];
            const int slot = base[e] + off[rg * 8 + e] + pos;
            *(v4u*)(HS + (size_t)slot * D + 16 * C.lane) = o;
            if (C.lane == 0) tok_slot[(size_t)m * 2 + k] = slot;
        }
    }
}

template <bool MOE> __device__ __forceinline__ void phase_ln2(Ctx& C, int l, size_t dummy_off = 0) {
    const bf16* T = WSP(bf16, WS_T); bf16* XB = WSP(bf16, WS_XB); bf16* XBo = dummy_off ? (bf16*)(C.Ap->ws + dummy_off) : XB;
    float* outf = dummy_off ? (float*)(C.Ap->ws + dummy_off) : C.Ap->out;
    LAS float* wl = (LAS float*)C.lds;
    if (l + 1 < DEPTH) { load_w8(C, wl, C.Ap->in[I_WIN] + (size_t)(l + 1) * D * DIN, DIN, NZ); }
    __syncthreads();
    f32x4 g[4], b[4]; load_vec_f32(C.Ap->in[I_L2G] + (size_t)l * D, g, C.lane); load_vec_f32(C.Ap->in[I_L2B] + (size_t)l * D, b, C.lane);
    const int gw = C.bid * NWAVES + C.wave, NGW = C.G * NWAVES;
    const bf16* Y2 = WSP(bf16, WS_R4); const int* tok_slot = WSP(int, MOE_TOK_SLOT); const float* tok_w = WSP(float, MOE_TOK_W);
    for (int m = gw; m < M; m += NGW) {
        f32x4 v[4];
        if constexpr (MOE) {
            const int s0 = tok_slot[(size_t)m * 2], s1 = tok_slot[(size_t)m * 2 + 1]; const float w0 = tok_w[(size_t)m * 2], w1 = tok_w[(size_t)m * 2 + 1];
            f32x4 ya[4], yb[4]; load_row_bf16(XB + (size_t)m * D, v, C.lane); load_row_bf16(Y2 + (size_t)s0 * D, ya, C.lane); load_row_bf16(Y2 + (size_t)s1 * D, yb, C.lane);
#pragma unroll
            for (int j = 0; j < 4; ++j) v[j] = v[j] * ALPHA + (ya[j] * w0 + yb[j] * w1);
        } else load_row_res(T + (size_t)m * D, XB + (size_t)m * D, v, C.lane);
        ln_apply(v, g, b);
        if (l + 1 < DEPTH) { store_row_bf16(XBo + (size_t)m * D, v, C.lane); write_gates(C, l + 1, m, v, wl); }
        else store_row_f32(outf + (size_t)m * D, v, C.lane);
    }
}


typedef short bf16x8 __attribute__((ext_vector_type(8)));
typedef short s16x4 __attribute__((ext_vector_type(4)));
#define MFMA16(X, Y, ACC) __builtin_amdgcn_mfma_f32_16x16x32_bf16((X), (Y), (ACC), 0, 0, 0)
#define LBAR() do { asm volatile("s_waitcnt lgkmcnt(0)" ::: "memory"); __builtin_amdgcn_s_barrier(); asm volatile("" ::: "memory"); } while (0)
__device__ __forceinline__ unsigned off_b(unsigned row, unsigned ch) { return 256u * row + 16u * (ch ^ (((row & 3u) << 2) | ((row >> 2) & 3u))); }
__device__ __forceinline__ unsigned row_addr16(unsigned lane, unsigned rb, unsigned s) { return off_b((lane & 15u) + 16u * rb, 4u * s + (lane >> 4)); }
__device__ __forceinline__ unsigned tr_addr16(unsigned lane, unsigned c, unsigned ks, unsigned t) {
    const unsigned g = lane >> 4, q = (lane & 15u) >> 2, p = lane & 3u;
    return off_b(32u * ks + 8u * g + 4u * t + q, 2u * c + (p >> 1)) + 8u * (p & 1u);
}
__device__ __forceinline__ s16x4 ds_tr16(const LAS unsigned char* p) { return __builtin_bit_cast(s16x4, __builtin_amdgcn_ds_read_tr16_b64_v4i16((LAS s16x4*)p)); }
__device__ __forceinline__ float logsigmoid_f(float x) { return fminf(x, 0.f) - log1pf(__expf(-fabsf(x))); }
#include <type_traits>

namespace m2 {
constexpr int QI = 0, KI0 = 16384, VI0 = 49152, WI = 81920, WROW = 144, TBL = WI + 64 * WROW;
constexpr int T_R = TBL, T_B = TBL + 2048, T_PM = TBL + 4096, T_M = TBL + 6144, T_EM = TBL + 8192, T_SI = TBL + 10240, T_WL = TBL + 12288, T_GC = TBL + 14336, T_PC = T_GC + 64, T_SOLD = T_GC + 128,
              STAT = T_GC + 256, STATP = 26 * 64 * 4, NV = STAT + 2 * STATP, END = NV + 512;
static_assert(END <= MISC_OFF, "mLSTM LDS map");
constexpr size_t SEG_STATE = WS_R4 + 64 * MiB;
constexpr size_t SEG_ITEM_BYTES = 65536 + 8192;
constexpr size_t SEG_SCAL = SEG_STATE + 256 * SEG_ITEM_BYTES;
}
__device__ __forceinline__ void m2_tables(Ctx& C, const float* GT, size_t m0, int h) {
    using namespace m2;
    LAS float* tr = (LAS float*)(C.lds + T_R); LAS float* tb = (LAS float*)(C.lds + T_B); LAS float* tpm = (LAS float*)(C.lds + T_PM);
    LAS float* gc = (LAS float*)(C.lds + T_GC); LAS float* pc = (LAS float*)(C.lds + T_PC);
    const int w = C.wave, lane = C.lane; const size_t m = m0 + (size_t)w * 64 + lane;
    const float ip = GT[m * 8 + h], fp = GT[m * 8 + 4 + h];
    float bt = logsigmoid_f(fp);
#pragma unroll
    for (int o = 1; o < 64; o <<= 1) { const float y = __shfl_up(bt, o); if (lane >= o) bt += y; }
    const float r = ip - bt; float pm = r;
#pragma unroll
    for (int o = 1; o < 64; o <<= 1) { const float y = __shfl_up(pm, o); if (lane >= o) pm = fmaxf(pm, y); }
    tr[w * 64 + lane] = r; tb[w * 64 + lane] = bt; tpm[w * 64 + lane] = pm;
    if (lane == 63) { gc[w] = bt; pc[w] = pm; }
}
__device__ __forceinline__ float m2_chain(Ctx& C, float m_in) {
    using namespace m2;
    LAS float* gc = (LAS float*)(C.lds + T_GC); LAS float* pc = (LAS float*)(C.lds + T_PC); LAS float* so = (LAS float*)(C.lds + T_SOLD);
    const int w = C.wave, lane = C.lane;
    float m = m_in, mprev = m_in, m63 = 0.f;
#pragma unroll
    for (int c = 0; c < 8; ++c) { const float g = gc[c], P = pc[c]; const float M63 = fmaxf(P, m); if (c == w) { mprev = m; m63 = M63; } m = g + M63; }
    unsigned a0 = (unsigned)(T_R + 4 * (w * 64 + lane)); asm volatile("" : "+v"(a0)); LAS float* t0 = (LAS float*)(C.lds + a0);
#define M2T(T) t0[((T) - T_R) / 4]
    const float Mt = fmaxf(M2T(T_PM), mprev);
    M2T(T_M) = Mt; M2T(T_EM) = __expf(-(M2T(T_B) + Mt)); M2T(T_SI) = __expf(mprev - Mt); M2T(T_WL) = __expf(M2T(T_R) - m63);
#undef M2T
    if (lane == 0) so[w] = __expf(mprev - m63);
    return m;
}
struct M2Lane { unsigned trA0[2], trK[2], rowB, rowK, qlB, qhB; };
__device__ __forceinline__ M2Lane m2_lane(unsigned lane) {
    const unsigned lr = lane & 15u, g = lane >> 4, q = lr >> 2, p = lane & 3u; M2Lane K;
#pragma unroll
    for (unsigned t = 0; t < 2; ++t) { const unsigned F = (q << 2) | ((2u * g + t) & 3u), b = p >> 1;
        K.trA0[t] = 256u * (8u * g + 4u * t + q) + 16u * (b ^ (F & 1u)) + 8u * (p & 1u); K.trK[t] = F >> 1; }
    const unsigned Fr = ((lr & 3u) << 2) | ((lr >> 2) & 3u);
    K.rowB = 256u * lr + 16u * (g ^ (Fr & 3u)); K.rowK = Fr >> 2;
    K.qlB = 256u * lr + 16u * ((g >> 1) ^ (Fr & 3u)) + 8u * (g & 1u);
    K.qhB = 256u * lr + 16u * ((2u | (g >> 1)) ^ (Fr & 3u)) + 8u * (g & 1u);
    return K;
}
#define M2_LAUNDER(K) asm volatile("" : "+v"((K).trA0[0]), "+v"((K).trA0[1]), "+v"((K).trK[0]), "+v"((K).trK[1]), "+v"((K).rowB), "+v"((K).rowK), "+v"((K).qlB), "+v"((K).qhB))
__device__ __forceinline__ unsigned tr_addr_f(const M2Lane& K, unsigned c, unsigned ks, unsigned t) { return K.trA0[t] + 8192u * ks + 32u * (c ^ K.trK[t]); }
__device__ __forceinline__ unsigned row_addr_f(const M2Lane& K, unsigned rb, unsigned s) { return K.rowB + 4096u * rb + 64u * (s ^ K.rowK); }
__device__ __forceinline__ unsigned qlo_addr_f(const M2Lane& K, unsigned tq, unsigned ks) { return K.qlB + 4096u * tq + 64u * (ks ^ K.rowK); }
__device__ __forceinline__ unsigned qhi_addr_f(const M2Lane& K, unsigned tq, unsigned ks) { return K.qhB + 4096u * tq + 64u * (ks ^ K.rowK); }
struct M2Stage { v4u q[2], k[2], v[2]; };
__device__ __forceinline__ v4u ldg16(const void* ubase, unsigned toff) { return *(const v4u*)((const char*)ubase + toff); }
template <bool WITH_Q> __device__ __forceinline__ void m2_load(M2Stage& S, const bf16* QK, const bf16* Z, size_t m0c, int h, int tid) {
    const unsigned tq = (unsigned)(((tid >> 4) * 1024 + (tid & 15) * 8) * 2), tz = (unsigned)(((tid >> 4) * NZ + (tid & 15) * 8) * 2);
    const bf16* qb = QK + m0c * 1024 + h * DH; const bf16* zb = Z + m0c * NZ + ZV + h * DH;
#pragma unroll
    for (int i = 0; i < 2; ++i) {
        if (WITH_Q) S.q[i] = ldg16(qb + (size_t)i * 32 * 1024, tq);
        S.k[i] = ldg16(qb + 512 + (size_t)i * 32 * 1024, tq);
        S.v[i] = ldg16(zb + (size_t)i * 32 * NZ, tz); }
}
template <bool WITH_Q> __device__ __forceinline__ void m2_store(const M2Stage& S, LAS unsigned char* L, int buf, int tid) {
    using namespace m2;
    const unsigned o = off_b((unsigned)(tid >> 4), (unsigned)(tid & 15));
#pragma unroll
    for (int i = 0; i < 2; ++i) {
        if (WITH_Q) *(LAS v4u*)(L + QI + i * 8192 + o) = S.q[i];
        *(LAS v4u*)(L + KI0 + buf * 16384 + i * 8192 + o) = S.k[i]; *(LAS v4u*)(L + VI0 + buf * 16384 + i * 8192 + o) = S.v[i]; }
}
__device__ __forceinline__ void m2_update(LAS unsigned char* L, int buf, int c, unsigned lane, const M2Lane& LK, int w, f32x4 (&Dst)[8], f32x4& Dn) {
    using namespace m2;
    const int lr = lane & 15, lg = lane >> 4;
    LAS float* twl = (LAS float*)(L + T_WL); LAS float* so = (LAS float*)(L + T_SOLD);
    bf16x8 yv[2], ya[2];
#pragma unroll
    for (int ks = 0; ks < 2; ++ks) {
        const s16x4 a0 = ds_tr16(L + VI0 + buf * 16384 + tr_addr_f(LK, (unsigned)w, ks, 0)), a1 = ds_tr16(L + VI0 + buf * 16384 + tr_addr_f(LK, (unsigned)w, ks, 1));
        const f32x4 w0 = *(const LAS f32x4*)(twl + c * 64 + 32 * ks + 8 * lg), w1 = *(const LAS f32x4*)(twl + c * 64 + 32 * ks + 8 * lg + 4);
        v4u pv, pa;
        pv.x = pk2(bf2f((unsigned short)a0[0]) * w0[0], bf2f((unsigned short)a0[1]) * w0[1]); pv.y = pk2(bf2f((unsigned short)a0[2]) * w0[2], bf2f((unsigned short)a0[3]) * w0[3]);
        pv.z = pk2(bf2f((unsigned short)a1[0]) * w1[0], bf2f((unsigned short)a1[1]) * w1[1]); pv.w = pk2(bf2f((unsigned short)a1[2]) * w1[2], bf2f((unsigned short)a1[3]) * w1[3]);
        pa.x = pk2(w0[0], w0[1]); pa.y = pk2(w0[2], w0[3]); pa.z = pk2(w1[0], w1[1]); pa.w = pk2(w1[2], w1[3]);
        if (lr != 0) pa = (v4u){0u, 0u, 0u, 0u};
        yv[ks] = __builtin_bit_cast(bf16x8, pv); ya[ks] = __builtin_bit_cast(bf16x8, pa); }
    const float sold = so[c];
#pragma unroll
    for (int j = 0; j < 8; ++j) Dst[j] = Dst[j] * sold;
    Dn = Dn * sold;
#pragma unroll
    for (int jh = 0; jh < 2; ++jh) {
        s16x4 a0[4][2], a1[4][2];
#pragma unroll
        for (int jj = 0; jj < 4; ++jj)
#pragma unroll
            for (int ks = 0; ks < 2; ++ks) { a0[jj][ks] = ds_tr16(L + KI0 + buf * 16384 + tr_addr_f(LK, (unsigned)(4 * jh + jj), ks, 0)); a1[jj][ks] = ds_tr16(L + KI0 + buf * 16384 + tr_addr_f(LK, (unsigned)(4 * jh + jj), ks, 1)); }
        __builtin_amdgcn_sched_barrier(0);
#pragma unroll
        for (int jj = 0; jj < 4; ++jj)
#pragma unroll
            for (int ks = 0; ks < 2; ++ks) { const bf16x8 x = __builtin_shufflevector(a0[jj][ks], a1[jj][ks], 0, 1, 2, 3, 4, 5, 6, 7);
                Dst[4 * jh + jj] = MFMA16(x, yv[ks], Dst[4 * jh + jj]);
                if (4 * jh + jj == w) Dn = MFMA16(x, ya[ks], Dn); }
    }
}

__device__ __forceinline__ void phase_mlstm_x(Ctx& C, int l) {
    using namespace m2;
    const bf16* Z = WSP(bf16, WS_R2); const bf16* QK = WSP(bf16, WS_R4); const float* GT = WSP(float, WS_GATE);
    LAS unsigned char* L = C.lds; const unsigned lane = (unsigned)C.lane; const int w = C.wave, tid = C.tid; (void)l;
    for (int item = C.bid; item < BATCH * NH * 8; item += C.G) {
        const int bh = item >> 3, sg = item & 7, b = bh >> 2, h = bh & 3; const size_t m0 = (size_t)b * SEQ + (size_t)sg * 512;
        __syncthreads();
        m2_tables(C, GT, m0, h);
        M2Stage S; m2_load<false>(S, QK, Z, m0, h, tid);
        __syncthreads();
        const float mfin = m2_chain(C, -1.0e30f);
        m2_store<false>(S, L, 0, tid);
        f32x4 Dst[8], Dn = {0.f, 0.f, 0.f, 0.f};
#pragma unroll
        for (int j = 0; j < 8; ++j) Dst[j] = (f32x4){0.f, 0.f, 0.f, 0.f};
        M2Lane LK = m2_lane(lane);
        __syncthreads();
        for (int c = 0; c < 8; ++c) {
            const int buf = c & 1;
            M2_LAUNDER(LK);
            if (c + 1 < 8) m2_load<false>(S, QK, Z, m0 + (size_t)(c + 1) * 64, h, tid);
            m2_update(L, buf, c, lane, LK, w, Dst, Dn);
            if (c + 1 < 8) m2_store<false>(S, L, buf ^ 1, tid);
            LBAR();
        }
        float* st = (float*)(C.Ap->ws + SEG_STATE + (size_t)item * SEG_ITEM_BYTES);
#pragma unroll
        for (int j = 0; j < 8; ++j) *(f32x4*)((char*)(st + (size_t)(w * 8 + j) * 256) + lane * 16u) = Dst[j];
        *(f32x4*)((char*)(st + 16384 + (size_t)w * 256) + lane * 16u) = Dn;
        if (tid == 0) { LAS float* gc = (LAS float*)(L + T_GC); float G = 0.f;
#pragma unroll
            for (int c = 0; c < 8; ++c) G += gc[c];
            float* sc = (float*)(C.Ap->ws + SEG_SCAL) + (size_t)item * 32; sc[0] = mfin; sc[1] = G; }
    }
}

__device__ __forceinline__ void phase_mlstm_y(Ctx& C, int l) {
    using namespace m2;
    const bf16* Z = WSP(bf16, WS_R2); const bf16* QK = WSP(bf16, WS_R4); const float* GT = WSP(float, WS_GATE); bf16* YC = WSP(bf16, WS_R3);
    LAS unsigned char* L = C.lds; const int w = C.wave, tid0 = C.tid;
    LAS float* tm = (LAS float*)(L + T_M); LAS float* tem = (LAS float*)(L + T_EM); LAS float* tsi = (LAS float*)(L + T_SI); LAS float* trr = (LAS float*)(L + T_R);
    LAS float* stat = (LAS float*)(L + STAT); LAS float* nv = (LAS float*)(L + NV);
    for (int item = C.bid; item < BATCH * NH * 8; item += C.G) {
        const int bh = item >> 3, sg = item & 7, b = bh >> 2, h = bh & 3; const size_t m0 = (size_t)b * SEQ + (size_t)sg * 512;
        __syncthreads();
        m2_tables(C, GT, m0, h);
        float coef[7]; float m_in = 0.f;
        { const float* sc = (const float*)(C.Ap->ws + SEG_SCAL) + (size_t)(bh * 8) * 32;
#pragma unroll
          for (int s2 = 0; s2 < 7; ++s2) { coef[s2] = 0.f;
              if (s2 < sg) { const float ms = sc[s2 * 32], G = sc[s2 * 32 + 1]; const float mn = fmaxf(G + m_in, ms), dec = __expf(G + m_in - mn);
#pragma unroll
                  for (int s3 = 0; s3 < 7; ++s3) if (s3 < s2) coef[s3] *= dec;
                  coef[s2] = __expf(ms - mn); m_in = mn; } } }
        f32x4 Dst[8], Dn = {0.f, 0.f, 0.f, 0.f};
#pragma unroll
        for (int j = 0; j < 8; ++j) Dst[j] = (f32x4){0.f, 0.f, 0.f, 0.f};
        { f32x4 ld[9]; const unsigned lane_c = (unsigned)(tid0 & 63);
#define M2_SEGLOAD(s2_) do { const float* st_ = (const float*)(C.Ap->ws + SEG_STATE + (size_t)(bh * 8 + (s2_)) * SEG_ITEM_BYTES); \
              _Pragma("unroll") for (int j = 0; j < 8; ++j) ld[j] = *(const f32x4*)((const char*)(st_ + (size_t)(w * 8 + j) * 256) + lane_c * 16u); \
              ld[8] = *(const f32x4*)((const char*)(st_ + 16384 + (size_t)w * 256) + lane_c * 16u); } while (0)
          if (sg > 0) M2_SEGLOAD(0);
          for (int s2 = 0; s2 < sg; ++s2) { float cf = coef[0];
#pragma unroll
              for (int s3 = 1; s3 < 7; ++s3) cf = (s2 == s3) ? coef[s3] : cf;
              f32x4 cur[9];
#pragma unroll
              for (int j = 0; j < 9; ++j) cur[j] = ld[j];
              if (s2 + 1 < sg) M2_SEGLOAD(s2 + 1);
#pragma unroll
              for (int j = 0; j < 8; ++j) Dst[j] = Dst[j] + cur[j] * cf;
              Dn = Dn + cur[8] * cf; }
#undef M2_SEGLOAD
        }
        int tid = tid0; asm volatile("" : "+v"(tid));
        const unsigned lane_i = (unsigned)(tid & 63); const int lr_i = (int)(lane_i & 15u), lg_i = (int)(lane_i >> 4);
        const f32x4 gn = *(const f32x4*)(C.Ap->in[I_MG] + (size_t)l * DML + h * DH + 16 * w + 4 * lg_i);
        const unsigned tog = (unsigned)((lr_i * NZ + 4 * lg_i) * 2), tyc = (unsigned)((lr_i * D + 4 * lg_i) * 2);
        const unsigned lane_y = lane_i; M2Lane LK = m2_lane(lane_y);
        unsigned qa0 = off_b(lane_y, 2u * (unsigned)w), qa1 = off_b(lane_y, 2u * (unsigned)w + 1u);
        M2Stage S; m2_load<true>(S, QK, Z, m0, h, tid);
        __syncthreads();
        (void)m2_chain(C, m_in);
        m2_store<true>(S, L, 0, tid);
        if (lr_i == 0) *(LAS f32x4*)(nv + 16 * w + 4 * lg_i) = Dn;
        bf16x8 xin[4];
#pragma unroll
        for (int ks = 0; ks < 4; ++ks) { v4u p; p.x = pk2(Dst[2 * ks][0], Dst[2 * ks][1]); p.y = pk2(Dst[2 * ks][2], Dst[2 * ks][3]); p.z = pk2(Dst[2 * ks + 1][0], Dst[2 * ks + 1][1]); p.w = pk2(Dst[2 * ks + 1][2], Dst[2 * ks + 1][3]); xin[ks] = __builtin_bit_cast(bf16x8, p); }
        __syncthreads();
        const int tt = w >> 1, jt = w & 1;
        for (int c = 0; c < 8; ++c) {
            const int buf = c & 1, par = c & 1; const size_t mc = m0 + (size_t)c * 64;
            M2_LAUNDER(LK);
            unsigned lane = lane_y; asm volatile("" : "+v"(lane), "+v"(qa0), "+v"(qa1));
            const int lr = (int)(lane & 15u), lg = (int)(lane >> 4);
            LAS float* dens = stat + par * (26 * 64); LAS float* nqs = dens + 2 * 64; LAS float* lns = dens + 10 * 64; LAS float* lnq = dens + 18 * 64;
            if (c + 1 < 8) m2_load<true>(S, QK, Z, mc + 64, h, tid);
            v2u og[4];
#pragma unroll
            for (int tq = 0; tq < 4; ++tq) og[tq] = *(const v2u*)((const char*)(Z + (mc + 16 * tq) * NZ + ZO + h * DH + 16 * w) + tog);
            { bf16x8 yq[4], xa[4], xb[4];
#pragma unroll
              for (int s4 = 0; s4 < 4; ++s4) { yq[s4] = *(const LAS bf16x8*)(L + QI + row_addr_f(LK, tt, s4));
                  xa[s4] = *(const LAS bf16x8*)(L + KI0 + buf * 16384 + row_addr_f(LK, 2 * jt, s4)); xb[s4] = *(const LAS bf16x8*)(L + KI0 + buf * 16384 + row_addr_f(LK, 2 * jt + 1, s4)); }
              const int t = 16 * tt + lr, s0a = 32 * jt + 4 * lg, s0b = s0a + 16; const float Mt = tm[c * 64 + t];
              const f32x4 rsa = *(const LAS f32x4*)(trr + c * 64 + s0a), rsb = *(const LAS f32x4*)(trr + c * 64 + s0b);
              const v4u q0 = *(const LAS v4u*)(L + QI + qa0), q1 = *(const LAS v4u*)(L + QI + qa1);
              const f32x4 n0 = *(const LAS f32x4*)(nv + 16 * w), n1 = *(const LAS f32x4*)(nv + 16 * w + 4), n2 = *(const LAS f32x4*)(nv + 16 * w + 8), n3 = *(const LAS f32x4*)(nv + 16 * w + 12);
              __builtin_amdgcn_sched_barrier(0);
              f32x4 acca = {0.f, 0.f, 0.f, 0.f}, accb = {0.f, 0.f, 0.f, 0.f};
#pragma unroll
              for (int s4 = 0; s4 < 4; ++s4) { acca = MFMA16(xa[s4], yq[s4], acca); accb = MFMA16(xb[s4], yq[s4], accb); }
              const float nqp = (bflo(q0.x) * n0[0] + bfhi(q0.x) * n0[1] + bflo(q0.y) * n0[2] + bfhi(q0.y) * n0[3]) + (bflo(q0.z) * n1[0] + bfhi(q0.z) * n1[1] + bflo(q0.w) * n1[2] + bfhi(q0.w) * n1[3])
                              + (bflo(q1.x) * n2[0] + bfhi(q1.x) * n2[1] + bflo(q1.y) * n2[2] + bfhi(q1.y) * n2[3]) + (bflo(q1.z) * n3[0] + bfhi(q1.z) * n3[1] + bflo(q1.w) * n3[2] + bfhi(q1.w) * n3[3]);
              nqs[w * 64 + lane] = nqp;
              float wa[4], wb[4]; float rsum = 0.f;
#pragma unroll
              for (int r = 0; r < 4; ++r) { wa[r] = (s0a + r <= t) ? acca[r] * __expf(fminf(rsa[r] - Mt, 0.f)) : 0.f; wb[r] = (s0b + r <= t) ? accb[r] * __expf(fminf(rsb[r] - Mt, 0.f)) : 0.f; }
              v2u oa, ob; oa.x = pk2(wa[0], wa[1]); oa.y = pk2(wa[2], wa[3]); ob.x = pk2(wb[0], wb[1]); ob.y = pk2(wb[2], wb[3]);
              rsum = (bflo(oa.x) + bfhi(oa.x)) + (bflo(oa.y) + bfhi(oa.y)) + (bflo(ob.x) + bfhi(ob.x)) + (bflo(ob.y) + bfhi(ob.y));
              rsum += __shfl_xor(rsum, 16); rsum += __shfl_xor(rsum, 32);
              if (lg == 0) dens[jt * 64 + t] = rsum;
              *(LAS v2u*)(L + WI + t * WROW + s0a * 2) = oa; *(LAS v2u*)(L + WI + t * WROW + s0b * 2) = ob; }
            LBAR();
            f32x4 hv[4];
            { bf16x8 xv[2];
#pragma unroll
              for (int ks = 0; ks < 2; ++ks) { const s16x4 a0 = ds_tr16(L + VI0 + buf * 16384 + tr_addr_f(LK, (unsigned)w, ks, 0)), a1 = ds_tr16(L + VI0 + buf * 16384 + tr_addr_f(LK, (unsigned)w, ks, 1));
                  xv[ks] = __builtin_shufflevector(a0, a1, 0, 1, 2, 3, 4, 5, 6, 7); }
#pragma unroll
              for (int th = 0; th < 2; ++th) {
                  bf16x8 yw[2][2]; s16x4 ql[2][4], qh[2][4];
#pragma unroll
                  for (int u = 0; u < 2; ++u) { const int tq = 2 * th + u;
#pragma unroll
                      for (int ks = 0; ks < 2; ++ks) yw[u][ks] = *(const LAS bf16x8*)(L + WI + (16 * tq + lr) * WROW + (32 * ks + 8 * lg) * 2);
#pragma unroll
                      for (int ks = 0; ks < 4; ++ks) { ql[u][ks] = *(const LAS s16x4*)(L + QI + qlo_addr_f(LK, tq, ks));
                          qh[u][ks] = *(const LAS s16x4*)(L + QI + qhi_addr_f(LK, tq, ks)); } }
                  __builtin_amdgcn_sched_barrier(0);
#pragma unroll
                  for (int u = 0; u < 2; ++u) { const int tq = 2 * th + u, t = 16 * tq + lr; f32x4 accI = {0.f, 0.f, 0.f, 0.f}, accE = {0.f, 0.f, 0.f, 0.f};
#pragma unroll
                      for (int ks = 0; ks < 2; ++ks) accI = MFMA16(xv[ks], yw[u][ks], accI);
#pragma unroll
                      for (int ks = 0; ks < 4; ++ks) { const bf16x8 y = __builtin_shufflevector(ql[u][ks], qh[u][ks], 0, 1, 2, 3, 4, 5, 6, 7); accE = MFMA16(xin[ks], y, accE); }
                      const float sI = tsi[c * 64 + t]; const float nqt = ((nqs[t] + nqs[64 + t]) + (nqs[128 + t] + nqs[192 + t])) + ((nqs[256 + t] + nqs[320 + t]) + (nqs[384 + t] + nqs[448 + t]));
                      const float den = (dens[t] + dens[64 + t]) + sI * nqt; const float inv = 1.0f / fmaxf(fabsf(den), tem[c * 64 + t]);
                      hv[tq] = (accI + accE * sI) * inv;
                      float s1 = (hv[tq][0] + hv[tq][1]) + (hv[tq][2] + hv[tq][3]), s2 = (hv[tq][0] * hv[tq][0] + hv[tq][1] * hv[tq][1]) + (hv[tq][2] * hv[tq][2] + hv[tq][3] * hv[tq][3]);
                      s1 += __shfl_xor(s1, 16); s1 += __shfl_xor(s1, 32); s2 += __shfl_xor(s2, 16); s2 += __shfl_xor(s2, 32);
                      if (lg == 0) { lns[w * 64 + t] = s1; lnq[w * 64 + t] = s2; } }
              } }
            LBAR();
#pragma unroll
            for (int tq = 0; tq < 4; ++tq) { const int t = 16 * tq + lr;
                const float ls = ((lns[t] + lns[64 + t]) + (lns[128 + t] + lns[192 + t])) + ((lns[256 + t] + lns[320 + t]) + (lns[384 + t] + lns[448 + t]));
                const float lq = ((lnq[t] + lnq[64 + t]) + (lnq[128 + t] + lnq[192 + t])) + ((lnq[256 + t] + lnq[320 + t]) + (lnq[384 + t] + lnq[448 + t]));
                const float mean = ls * (1.0f / DH); const float var = fmaxf(lq * (1.0f / DH) - mean * mean, 0.f); const float rstd = 1.0f / sqrtf(var + LN_EPS);
                const float o0 = bflo(og[tq].x), o1 = bfhi(og[tq].x), o2 = bflo(og[tq].y), o3 = bfhi(og[tq].y);
                const float y0 = sigmoid_f(o0) * ((hv[tq][0] - mean) * rstd * gn[0]), y1 = sigmoid_f(o1) * ((hv[tq][1] - mean) * rstd * gn[1]);
                const float y2 = sigmoid_f(o2) * ((hv[tq][2] - mean) * rstd * gn[2]), y3 = sigmoid_f(o3) * ((hv[tq][3] - mean) * rstd * gn[3]);
                v2u o; o.x = pk2(y0, y1); o.y = pk2(y2, y3);
                *(v2u*)((char*)(YC + (mc + 16 * tq) * D + DPOOL + h * DH + 16 * w) + tyc) = o; }
            LBAR();
            if (c + 1 < 8) {
                m2_update(L, buf, c, lane, LK, w, Dst, Dn);
#pragma unroll
                for (int ks = 0; ks < 4; ++ks) { v4u p; p.x = pk2(Dst[2 * ks][0], Dst[2 * ks][1]); p.y = pk2(Dst[2 * ks][2], Dst[2 * ks][3]); p.z = pk2(Dst[2 * ks + 1][0], Dst[2 * ks + 1][1]); p.w = pk2(Dst[2 * ks + 1][2], Dst[2 * ks + 1][3]); xin[ks] = __builtin_bit_cast(bf16x8, p); }
                if (lr == 0) *(LAS f32x4*)(nv + 16 * w + 4 * lg) = Dn;
                m2_store<true>(S, L, buf ^ 1, tid);
            }
            LBAR();
        }
    }
}

enum { PH_INPROJ = 0, PH_CONV = 1, PH_MLSTM = 2, PH_POOLFIN = 3, PH_OUTPROJ = 4, PH_LN1 = 5, PH_F0 = 6, PH_F1 = 7, PH_F2 = 8, PH_LN2M = 17 };
__global__ void __launch_bounds__(NTHR, 2) fwd(Args args) {
    extern __shared__ __attribute__((aligned(16))) unsigned char lds_raw[];
    const int wave_s = __builtin_amdgcn_readfirstlane((int)(threadIdx.x >> 6));
    { Ctx C = make_ctx(lds_raw, wave_s);
      for (int u = C.tid; u < (LDS_BYTES - MISC_OFF) / 4; u += NTHR) ((LAS unsigned*)(C.lds + MISC_OFF))[u] = 0u;
      __syncthreads();
      (void)xcd_barrier_post((unsigned*)(C.Ap->ws + WS_CTL) + CW_BAR + C.Ap->li * XCD_BAR_WORDS, (volatile LAS unsigned*)(C.lds + MISC_OFF) + 8); }
    const int lo = args.ph_lo, hi = args.ph_hi; (void)args;
#ifndef DUP_MASK
#define DUP_MASK 0
#endif
#define DUPB(bit) ((((DUP_MASK) >> (bit)) & 1) != 0)
#ifndef DUP_N
#define DUP_N 1
#endif
#define REP(bit) for (int rep_ = 0; rep_ < (((DUP_MASK) >> (bit)) & 1) * (DUP_N) + 1; ++rep_)
#define IN(k) (lo <= (k) && (k) < hi)
#define SEAM(k) do { if (hi > (k) + 1) { Ctx Cb = make_ctx(lds_raw, wave_s); XcdBarrier bar; bar.bar = (unsigned*)(Cb.Ap->ws + WS_CTL) + CW_BAR + Cb.Ap->li * XCD_BAR_WORDS; bar.x = xb_xcc_id(); \
        bar.st = (volatile LAS unsigned*)(Cb.lds + MISC_OFF) + 8; xcd_barrier(bar); if (DUPB(15)) xcd_barrier(bar); } } while (0)
#define PHASE(k, body) do { if (IN(k)) { Ctx C = make_ctx(lds_raw, wave_s); { Ctx C = make_ctx(lds_raw, wave_s); body } SEAM(k); } } while (0)

    if (IN(0)) { Ctx C = make_ctx(lds_raw, wave_s); REP(13) phase_prologue(C); SEAM(0); }
#pragma nounroll
    for (int l = 0; l < DEPTH; ++l) {
        const int pb = 1 + l * NPH; const int jj = l >> 1; const bool moe = (l & 1) != 0;
        if (IN(pb + PH_INPROJ)) { Ctx C = make_ctx(lds_raw, wave_s);
            pg8::Gemm g{WSP(bf16, WS_XB), WSP(bf16, WS_WIN) + (size_t)l * NZ * D, M, NZ, D}; pg8::StaticOrder S; S.init(M, NZ, C.G, C.bid);
            REP(0) { pg8::EpiBf16 E{WSP(bf16, WS_R2), NZ, (DUPB(16) && rep_ == 0) ? 1 : 0};
            pg8::gemm_phase<pg8::EpiBf16, pg8::StaticOrder, true, true>(C.lds, g, S, E, C.wave); }
            SEAM(pb + PH_INPROJ);
        }
        if (IN(pb + PH_CONV)) { Ctx C = make_ctx(lds_raw, wave_s); REP(1) { phase_conv(C, l); phase_pool(C, l); } SEAM(pb + PH_CONV); }
        if (IN(pb + PH_MLSTM)) { Ctx C = make_ctx(lds_raw, wave_s); REP(2) phase_mlstm_x(C, l); SEAM(pb + PH_MLSTM); }
        if (IN(pb + PH_POOLFIN)) { Ctx C = make_ctx(lds_raw, wave_s); REP(3) phase_mlstm_y(C, l); if (l == 2) { __syncthreads(); Ctx C2 = make_ctx(lds_raw, wave_s); REP(14) convert_experts(C2, 1); } SEAM(pb + PH_POOLFIN); }
        if (IN(pb + PH_OUTPROJ)) { Ctx C = make_ctx(lds_raw, wave_s);
            pg8::Gemm g{WSP(bf16, WS_R3), WSP(bf16, WS_WOUT) + (size_t)l * D * D, M, D, D}; pg8::StaticOrder S; S.init(M, D, C.G, C.bid);
            pg8::EpiBf16 E{WSP(bf16, WS_T), D};
            REP(4) pg8::gemm_phase<pg8::EpiBf16, pg8::StaticOrder, true, true>(C.lds, g, S, E, C.wave);
            SEAM(pb + PH_OUTPROJ);
        }
        if (!moe) {
            if (IN(pb + PH_LN1)) { Ctx C = make_ctx(lds_raw, wave_s); REP(5) phase_ln1<false>(C, l); SEAM(pb + PH_LN1); }
            if (IN(pb + PH_F0)) { Ctx C = make_ctx(lds_raw, wave_s);
                pg8::Gemm g{WSP(bf16, WS_XB), WSP(bf16, WS_WGU) + (size_t)jj * 2 * FFD * D, M, 2 * FFD, D}; pg8::StaticOrder S; S.init(M, 2 * FFD, C.G, C.bid);
                pg8::EpiSwiGLU8 E{WSP(bf16, WS_R2), FFD, 1.0f, F8_ASC};
                REP(6) pg8::gemm_phase<pg8::EpiSwiGLU8, pg8::StaticOrder, true, true>(C.lds, g, S, E, C.wave);
                SEAM(pb + PH_F0);
            }
            if (IN(pb + PH_F1)) { Ctx C = make_ctx(lds_raw, wave_s);
                pg8::Gemm g{WSP(bf16, WS_R2), (const bf16*)(WSP(unsigned char, WS_WD) + (size_t)jj * D * FFD), M, D, FFD / 2}; pg8::StaticOrder S; S.init(M, D, C.G, C.bid);
                pg8::EpiBf16S E{WSP(bf16, WS_T), D, 1.0f / (F8_DSC * F8_ASC)};
                REP(7) pg8::gemm_phase<pg8::EpiBf16S, pg8::StaticOrder, true, true, 1>(C.lds, g, S, E, C.wave);
                SEAM(pb + PH_F1);
            }
            if (IN(pb + PH_F2)) { Ctx C = make_ctx(lds_raw, wave_s); REP(8) phase_ln2<false>(C, l); SEAM(pb + PH_F2); }
        } else {
            if (IN(pb + PH_LN1)) { Ctx C = make_ctx(lds_raw, wave_s); REP(5) phase_ln1<true>(C, l); SEAM(pb + PH_LN1); }
            if (IN(pb + PH_F0)) { Ctx C = make_ctx(lds_raw, wave_s); REP(9) phase_moe_prep(C); SEAM(pb + PH_F0); }
#pragma nounroll
            for (int p = 0; p < NPASS; ++p) {
                const int rt0 = p * PASS_TILES;
                if (IN(pb + PH_F1 + 2 * p)) { Ctx C = make_ctx(lds_raw, wave_s);
                    const int NT = __builtin_amdgcn_readfirstlane(WSP(int, MOE_META)[0]); int ntp = NT - rt0; if (p + 1 < NPASS) ntp = ntp > PASS_TILES ? PASS_TILES : ntp;
                    if (ntp > 0) {
                        pg8::Gemm g{(const bf16*)(WSP(unsigned char, WS_R3) + (size_t)rt0 * 256 * D), WSP(bf16, WS_EGU), ntp * 256, 2 * FFE, D / 2};
                        pg8::GroupedOrder S; S.init(ntp, 2 * FFE, C.G, C.bid, rt0, WSP(int, MOE_TILE_E));
                        pg8::EpiSwiGLU8 E{WSP(bf16, WS_R2), FFE, 1.0f / (F8_WSC * F8_HSC), F8_ASC};
                        REP(10) pg8::gemm_phase<pg8::EpiSwiGLU8, pg8::GroupedOrder, true, true, 1>(C.lds, g, S, E, C.wave);
                    }
                    SEAM(pb + PH_F1 + 2 * p);
                }
                if (IN(pb + PH_F2 + 2 * p)) { Ctx C = make_ctx(lds_raw, wave_s);
                    const int NT = __builtin_amdgcn_readfirstlane(WSP(int, MOE_META)[0]); int ntp = NT - rt0; if (p + 1 < NPASS) ntp = ntp > PASS_TILES ? PASS_TILES : ntp;
                    if (ntp > 0) {
                        pg8::Gemm g{WSP(bf16, WS_R2), WSP(bf16, WS_ED), ntp * 256, D, FFE / 2}; pg8::GroupedOrder S; S.init(ntp, D, C.G, C.bid, rt0, WSP(int, MOE_TILE_E));
                        pg8::EpiBf16S E{WSP(bf16, WS_R4) + (size_t)rt0 * 256 * D, D, 1.0f / (F8_DSC * F8_ASC)};
                        REP(11) pg8::gemm_phase<pg8::EpiBf16S, pg8::GroupedOrder, true, true, 1>(C.lds, g, S, E, C.wave);
                    }
                    SEAM(pb + PH_F2 + 2 * p);
                }
            }
            if (IN(pb + PH_LN2M)) { Ctx C = make_ctx(lds_raw, wave_s); REP(12) phase_ln2<true>(C, l, (DUPB(12) && rep_ == 0) ? WS_R2 : 0); SEAM(pb + PH_LN2M); }
        }
    }
#undef IN
#undef SEAM
}

static bool phase_exists(int id) { if (id == 0) return true; const int l = (id - 1) / NPH, k = (id - 1) % NPH; return (l & 1) ? true : (k <= PH_F2); }
extern "C" void kernel_launch(void* const* d_in, const int* in_sizes, int n_in, void* d_out, int out_size, void* d_ws, size_t ws_size, hipStream_t stream) {
    static int grid = 0;
    if (grid == 0) {
        if (n_in != 21 || out_size != M * D || ws_size < WS_END) { fprintf(stderr, "kernel_launch: unexpected shapes (n_in %d, out %d, ws %zu)\n", n_in, out_size, ws_size); grid = -1; return; }
        int dev = 0, cus = 0, per_cu = 0;
        if (hipGetDevice(&dev) != hipSuccess || hipDeviceGetAttribute(&cus, hipDeviceAttributeMultiprocessorCount, dev) != hipSuccess) { grid = -1; return; }
        if (hipFuncSetAttribute((const void*)fwd, hipFuncAttributeMaxDynamicSharedMemorySize, LDS_BYTES) != hipSuccess) { fprintf(stderr, "kernel_launch: hipFuncSetAttribute failed\n"); grid = -1; return; }
        if (hipOccupancyMaxActiveBlocksPerMultiprocessor(&per_cu, (const void*)fwd, NTHR, LDS_BYTES) != hipSuccess || per_cu < 1) { fprintf(stderr, "kernel_launch: occupancy query says %d blocks per CU\n", per_cu); (void)hipGetLastError(); if (per_cu < 1) { grid = -1; return; } }
        grid = cus;
    }
    if (grid < 0) return;
    (void)in_sizes;
    if (hipMemsetAsync((char*)d_ws + WS_CTL, 0, CTL_ZERO_BYTES, stream) != hipSuccess) return;
    Args a{};
    for (int i = 0; i < 21; ++i) a.in[i] = (const float*)d_in[i];
    a.out = (float*)d_out; a.ws = (unsigned char*)d_ws; a.pad = 0;
#if MK_ONE_LAUNCH
    a.ph_lo = 0; a.ph_hi = NPHASES; a.li = 0;
    hipLaunchKernelGGL(fwd, dim3(grid), dim3(NTHR), LDS_BYTES, stream, a);
#else
    for (int id = 0; id < NPHASES; ++id) { if (!phase_exists(id)) continue;
        a.ph_lo = id; a.ph_hi = id + 1; a.li = id;
        hipLaunchKernelGGL(fwd, dim3(grid), dim3(NTHR), LDS_BYTES, stream, a); }
#endif
}
```

```cpp
#include <hip/hip_runtime.h>
#include <cstdio>
#include <cstdint>
#ifndef MK_ONE_LAUNCH
#define MK_ONE_LAUNCH 1
#endif
namespace pg8 {
#define PG8_LAS __attribute__((address_space(3)))
typedef unsigned short bf16_t;
typedef short bf16x8 __attribute__((ext_vector_type(8)));
typedef float f32x4 __attribute__((ext_vector_type(4)));
typedef unsigned u32x4 __attribute__((ext_vector_type(4)));
constexpr int BM = 256, BK = 64, HALF = 128, HTB = HALF * BK * 2  , STAGE_BYTES = 8 * HTB, NXCD = 8, WGM = 8;

__host__ __device__ __forceinline__ int lds_byte(int r, int c) { const int st = (r >> 4) * 2 + (c >> 5), rr = r & 15, cc = c & 31, ob = rr * 64 + cc * 2; return st * 1024 + (ob ^ (((ob >> 9) & 1) << 5)); }
__host__ __device__ __forceinline__ void stage_rc(int b, int& R, int& C) { const int st = b / 1024, sb = b % 1024, swz = sb ^ (((sb >> 9) & 1) << 5); R = (st >> 1) * 16 + swz / 64; C = (st & 1) * 32 + (swz % 64) / 2; }
__host__ __device__ __forceinline__ int perm32(int rho) { const int n = rho >> 4, i = rho & 15; return 8 * (i >> 2) + 4 * n + (i & 3); }

struct Unit { int pm, pn, pb; };
struct Gemm { const bf16_t* A; const bf16_t* Bt; int M, N, K; };

struct StaticOrder {
    int nM, nN, nwg, G, c;
    __host__ __device__ void init(int M, int N, int G_, int c_) { nM = M / BM; nN = N / BM; nwg = nM * nN; G = G_; c = c_; }
    __host__ __device__ bool next(int i, Unit& u) const {
        const long L = (long)i * G + c; if (L >= nwg) return false;
        int wgid = (int)L; { const int q = nwg / NXCD, r = nwg % NXCD, xcd = wgid % NXCD, off = wgid / NXCD; wgid = (xcd < r ? xcd * (q + 1) : r * (q + 1) + (xcd - r) * q) + off; }
        const int nig = WGM * nN, gid = wgid / nig, fm = gid * WGM, gsz = (nM - fm) < WGM ? (nM - fm) : WGM;
        u.pm = fm + ((wgid % nig) % gsz); u.pn = (wgid % nig) / gsz; u.pb = u.pn; return true;
    }
    __device__ __forceinline__ void a_ready(const Unit&) const {}
    __device__ __forceinline__ void done(const Unit&) const {}
};
struct GroupedOrder {
    StaticOrder so; int rt0; const int* tile_e;
    __device__ void init(int ntp, int N, int G_, int c_, int rt0_, const int* te) { so.init(ntp * BM, N, G_, c_); rt0 = rt0_; tile_e = te; }
    __device__ bool next(int i, Unit& u) const {
        if (!so.next(i, u)) return false;
        const int e = __builtin_amdgcn_readfirstlane(tile_e[rt0 + u.pm]); u.pb = e * so.nN + u.pn; return true;
    }
    __device__ __forceinline__ void a_ready(const Unit&) const {}
    __device__ __forceinline__ void done(const Unit&) const {}
};

#ifndef PG8_ST_AUX
#define PG8_ST_AUX 0
#endif
#define PG8_RSRC(p) __builtin_amdgcn_make_buffer_rsrc((void*)(p), 0, 0x7fffffff, 0x00020000)
#define PG8_ST128(w, rs, off) __builtin_amdgcn_raw_buffer_store_b128((w), (rs), (off), 0, PG8_ST_AUX)
#define PG8_ST64(w, rs, off) __builtin_amdgcn_raw_buffer_store_b64((w), (rs), (off), 0, PG8_ST_AUX)
__device__ __forceinline__ unsigned cvt_pk_bf16(float lo, float hi) { unsigned r; asm volatile("v_cvt_pk_bf16_f32 %0, %1, %2" : "=v"(r) : "v"(lo), "v"(hi)); return r; }

struct EpiBf16 {
    static constexpr bool PERM = true, AFTER_DRAIN = false;
    bf16_t* O; int ldc; int nostore = 0;
    __device__ __forceinline__ void operator()(const f32x4 (&acc)[2][2][4][2], const Unit& u, int wr, int wc, int fr, int fq) const {
        const int row0 = u.pm * BM + wr * 64 + fr; const int col0 = u.pn * BM + wc * 32 + 8 * fq; const auto rs = PG8_RSRC(O);
#pragma unroll
        for (int ai = 0; ai < 2; ++ai)
#pragma unroll
            for (int m = 0; m < 4; ++m) { const int off = ((row0 + ai * HALF + m * 16) * ldc + col0) * 2;
#pragma unroll
                for (int bj = 0; bj < 2; ++bj) { const f32x4 v0 = acc[ai][bj][m][0], v1 = acc[ai][bj][m][1];
                    u32x4 w; w.x = cvt_pk_bf16(v0[0], v0[1]); w.y = cvt_pk_bf16(v0[2], v0[3]); w.z = cvt_pk_bf16(v1[0], v1[1]); w.w = cvt_pk_bf16(v1[2], v1[3]);
                    if (!nostore || w.x == 0x12345678u) PG8_ST128(w, rs, off + bj * HALF * 2); } }
    }
};
__device__ __forceinline__ float silu_f(float g) { return g * __builtin_amdgcn_rcpf(1.0f + __expf(-g)); }
__device__ __forceinline__ unsigned cvt_fp8x4(float a, float b, float c, float d) {
    a = fminf(fmaxf(a, -448.f), 448.f); b = fminf(fmaxf(b, -448.f), 448.f); c = fminf(fmaxf(c, -448.f), 448.f); d = fminf(fmaxf(d, -448.f), 448.f);
    int r = __builtin_amdgcn_cvt_pk_fp8_f32(a, b, 0, false); r = __builtin_amdgcn_cvt_pk_fp8_f32(c, d, r, true); return (unsigned)r; }
template <bool OUT8> struct EpiSwiGLUT {
    static constexpr bool PERM = true, AFTER_DRAIN = false;
    bf16_t* O; int ldc; float insc = 1.0f; float outsc = 1.0f;
    __device__ __forceinline__ void operator()(const f32x4 (&acc)[2][2][4][2], const Unit& u, int wr, int wc, int fr, int fq) const {
        const int row0 = u.pm * BM + wr * 64 + fr; const int col0 = u.pn * HALF + wc * 32 + 8 * fq;
        const float c1 = -1.4426950408889634f * insc, c2 = insc * insc * outsc; const auto rs = PG8_RSRC(O);
#pragma unroll
        for (int ai = 0; ai < 2; ++ai)
#pragma unroll
            for (int m = 0; m < 4; ++m) {
                const f32x4 g0 = acc[ai][0][m][0], g1 = acc[ai][0][m][1], u0 = acc[ai][1][m][0], u1 = acc[ai][1][m][1];
                const f32x4 t0 = g0 * c1, t1 = g1 * c1; f32x4 d0, d1;
#pragma unroll
                for (int j = 0; j < 4; ++j) { d0[j] = __builtin_amdgcn_exp2f(t0[j]); d1[j] = __builtin_amdgcn_exp2f(t1[j]); }
                d0 = d0 + 1.0f; d1 = d1 + 1.0f;
#pragma unroll
                for (int j = 0; j < 4; ++j) { d0[j] = __builtin_amdgcn_rcpf(d0[j]); d1[j] = __builtin_amdgcn_rcpf(d1[j]); }
                const f32x4 h0 = (g0 * u0) * (d0 * c2), h1 = (g1 * u1) * (d1 * c2);
                if constexpr (OUT8) { typedef unsigned u32x2_ __attribute__((ext_vector_type(2)));
                    u32x2_ w; w.x = cvt_fp8x4(h0[0], h0[1], h0[2], h0[3]); w.y = cvt_fp8x4(h1[0], h1[1], h1[2], h1[3]);
                    PG8_ST64(w, rs, (row0 + ai * HALF + m * 16) * ldc + col0); }
                else {
                    u32x4 w; w.x = cvt_pk_bf16(h0[0], h0[1]); w.y = cvt_pk_bf16(h0[2], h0[3]); w.z = cvt_pk_bf16(h1[0], h1[1]); w.w = cvt_pk_bf16(h1[2], h1[3]);
                    PG8_ST128(w, rs, ((row0 + ai * HALF + m * 16) * ldc + col0) * 2); } }
    }
};
typedef EpiSwiGLUT<false> EpiSwiGLU; typedef EpiSwiGLUT<true> EpiSwiGLU8;
struct EpiBf16S {
    static constexpr bool PERM = true, AFTER_DRAIN = false;
    bf16_t* O; int ldc; float insc;
    __device__ __forceinline__ void operator()(const f32x4 (&acc)[2][2][4][2], const Unit& u, int wr, int wc, int fr, int fq) const {
        const int row0 = u.pm * BM + wr * 64 + fr; const int col0 = u.pn * BM + wc * 32 + 8 * fq; const auto rs = PG8_RSRC(O);
#pragma unroll
        for (int ai = 0; ai < 2; ++ai)
#pragma unroll
            for (int m = 0; m < 4; ++m) { const int off = ((row0 + ai * HALF + m * 16) * ldc + col0) * 2;
#pragma unroll
                for (int bj = 0; bj < 2; ++bj) { const f32x4 v0 = acc[ai][bj][m][0] * insc, v1 = acc[ai][bj][m][1] * insc;
                    u32x4 w; w.x = cvt_pk_bf16(v0[0], v0[1]); w.y = cvt_pk_bf16(v0[2], v0[3]); w.z = cvt_pk_bf16(v1[0], v1[1]); w.w = cvt_pk_bf16(v1[2], v1[3]);
                    PG8_ST128(w, rs, off + bj * HALF * 2); } }
    }
};

template <class Epi, class Sched, bool ALIGN_EPI = false, bool SP2 = false, int DT = 0>
__device__ __forceinline__ void gemm_phase(PG8_LAS unsigned char* lds, const Gemm g, const Sched& S, const Epi& E, int wave_s) {
    int lane_l; asm volatile("v_mbcnt_lo_u32_b32 %0, -1, 0\n\tv_mbcnt_hi_u32_b32 %0, -1, %0" : "=v"(lane_l));
    const int tid_l = wave_s * 64 + lane_l;
    const int tid = tid_l, wid = __builtin_amdgcn_readfirstlane(tid >> 6), lane = tid & 63, wr = wid >> 2, wc = wid & 3, fr = lane & 15, fq = lane >> 4;
    const int K = g.K, nt = K / BK;
    unsigned voffA[2], voffB[2];
#pragma unroll
    for (int i = 0; i < 2; ++i) { int R, C; stage_rc(tid * 16 + i * 8192, R, C); const int Rb = Epi::PERM ? ((R & ~31) + perm32(R & 31)) : R;
        voffA[i] = (unsigned)(R * K + C) * 2u; voffB[i] = (unsigned)(Rb * K + C) * 2u; }
    const size_t kstep = (size_t)(BK * 2);
    const size_t hstep = (size_t)HALF * K * 2;
    const size_t tstep = 2 * hstep;
    const unsigned ldsw = (unsigned)wid * 1024u;
    const int aoff = lds_byte(wr * 64 + fr, fq * 8), boff = lds_byte(wc * 32 + fr, fq * 8);
#define PG8_SA(b, h) (((b) * 2 + (h)) * HTB)
#define PG8_SB(b, h) ((4 + (b) * 2 + (h)) * HTB)
#define PG8_STAGE(bufoff, gbase, voff) do { _Pragma("unroll") for (int _i = 0; _i < 2; ++_i) \
        __builtin_amdgcn_global_load_lds((const unsigned*)((const char*)(gbase) + (voff)[_i]), (PG8_LAS unsigned*)(lds + (bufoff) + ldsw + _i * 8192), 16, 0, 0); } while (0)
#define PG8_LDA(dst, b, h) do { _Pragma("unroll") for (int m = 0; m < 4; ++m) { \
        if constexpr (DT == 1) { const pg8_i4 l0_ = *(const PG8_LAS pg8_i4*)(lds + PG8_SA(b, h) + aoff + m * 2048), l1_ = *(const PG8_LAS pg8_i4*)(lds + PG8_SA(b, h) + aoff + m * 2048 + 1024); dst##8[m] = __builtin_shufflevector(l0_, l1_, 0, 1, 2, 3, 4, 5, 6, 7); } \
        else { _Pragma("unroll") for (int k = 0; k < 2; ++k) dst[m][k] = *(const PG8_LAS bf16x8*)(lds + PG8_SA(b, h) + aoff + m * 2048 + k * 1024); } } } while (0)
#define PG8_LDB(dst, b, h) do { _Pragma("unroll") for (int n = 0; n < 2; ++n) { \
        if constexpr (DT == 1) { const pg8_i4 l0_ = *(const PG8_LAS pg8_i4*)(lds + PG8_SB(b, h) + boff + n * 2048), l1_ = *(const PG8_LAS pg8_i4*)(lds + PG8_SB(b, h) + boff + n * 2048 + 1024); dst##8[n] = __builtin_shufflevector(l0_, l1_, 0, 1, 2, 3, 4, 5, 6, 7); } \
        else { _Pragma("unroll") for (int k = 0; k < 2; ++k) dst[n][k] = *(const PG8_LAS bf16x8*)(lds + PG8_SB(b, h) + boff + n * 2048 + k * 1024); } } } while (0)
#define PG8_MMA(ai, bj, At, Bt) do { __builtin_amdgcn_s_setprio(1); \
        if constexpr (DT == 1) { asm volatile("s_nop 1" ::: ); _Pragma("unroll") for (int m = 0; m < 4; ++m) _Pragma("unroll") for (int n = 0; n < 2; ++n) \
            asm volatile("v_mfma_f32_16x16x128_f8f6f4 %0, %1, %2, %0" : "+v"(acc[ai][bj][m][n]) : "v"(Bt##8[n]), "v"(At##8[m])); } \
        else { _Pragma("unroll") for (int m = 0; m < 4; ++m) _Pragma("unroll") for (int n = 0; n < 2; ++n) _Pragma("unroll") for (int k = 0; k < 2; ++k) \
            acc[ai][bj][m][n] = __builtin_amdgcn_mfma_f32_16x16x32_bf16(Bt[n][k], At[m][k], acc[ai][bj][m][n], 0, 0, 0); } \
        __builtin_amdgcn_s_setprio(0); } while (0)
#define PG8_WAIT_V(n) asm volatile("s_waitcnt vmcnt(" #n ")" ::: "memory")
#define PG8_WAIT_L(n) asm volatile("s_waitcnt lgkmcnt(" #n ")" ::: "memory")
#define PG8_BAR __builtin_amdgcn_s_barrier()
#define PG8_SCHED __builtin_amdgcn_sched_barrier(0)
    Unit cur, nxt; int ui = 0;
    if (!S.next(0, cur)) return;
    f32x4 acc[2][2][4][2];
    float zl_ = 0.f; asm volatile("" : "+v"(zl_));
#pragma unroll
    for (int a = 0; a < 2; ++a)
#pragma unroll
        for (int b = 0; b < 2; ++b)
#pragma unroll
            for (int m = 0; m < 4; ++m)
#pragma unroll
                for (int n = 0; n < 2; ++n) acc[a][b][m][n] = (f32x4){zl_, zl_, zl_, zl_};
    typedef int pg8_i4 __attribute__((ext_vector_type(4))); typedef int pg8_i8 __attribute__((ext_vector_type(8)));
    bf16x8 At[4][2], B0[2][2], B1[2][2]; pg8_i8 At8[4], B08[2], B18[2];
    (void)At; (void)B0; (void)B1; (void)At8; (void)B08; (void)B18;
    const char* cA = (const char*)g.A + (size_t)cur.pm * tstep; const char* cB = (const char*)g.Bt + (size_t)cur.pb * tstep;
    S.a_ready(cur);
    if constexpr (SP2) {
        PG8_STAGE(PG8_SB(0, 0), cB, voffB); PG8_STAGE(PG8_SB(0, 1), cB + hstep, voffB); PG8_STAGE(PG8_SA(0, 0), cA, voffA); PG8_STAGE(PG8_SA(0, 1), cA + hstep, voffA);
        if (wr == 1) PG8_BAR;
        PG8_WAIT_V(2); PG8_BAR;
        PG8_STAGE(PG8_SB(1, 0), cB + kstep, voffB); PG8_STAGE(PG8_SA(1, 0), cA + kstep, voffA); PG8_STAGE(PG8_SB(1, 1), cB + hstep + kstep, voffB);
        PG8_WAIT_V(6); PG8_BAR;
    } else {
        PG8_STAGE(PG8_SB(0, 0), cB, voffB); PG8_STAGE(PG8_SA(0, 0), cA, voffA); PG8_STAGE(PG8_SB(0, 1), cB + hstep, voffB); PG8_STAGE(PG8_SA(0, 1), cA + hstep, voffA);
        if (wr == 1) PG8_BAR;
        PG8_WAIT_V(4); PG8_BAR;
        PG8_STAGE(PG8_SB(1, 0), cB + kstep, voffB); PG8_STAGE(PG8_SA(1, 0), cA + kstep, voffA); PG8_STAGE(PG8_SB(1, 1), cB + hstep + kstep, voffB);
        PG8_WAIT_V(6); PG8_BAR;
    }
    for (;;) {
        const bool has_next = S.next(ui + 1, nxt);
        const char* nA = has_next ? (const char*)g.A + (size_t)nxt.pm * tstep : cA; const char* nB = has_next ? (const char*)g.Bt + (size_t)nxt.pb * tstep : cB;
        for (int t = 0; t < nt; t += 2) {
            const bool last = (t == nt - 2);
            const char* a1 = cA + (size_t)(t + 1) * kstep;
            const char* a2 = last ? nA : cA + (size_t)(t + 2) * kstep; const char* b2 = last ? nB : cB + (size_t)(t + 2) * kstep;
            const char* a3 = a2 + kstep; const char* b3 = b2 + kstep;
            if (last && has_next) S.a_ready(nxt);
            if constexpr (SP2) {
            PG8_LDB(B0, 0, 0); PG8_LDB(B1, 0, 1); PG8_SCHED; PG8_LDA(At, 0, 0); PG8_STAGE(PG8_SA(1, 1), a1 + hstep, voffA);
            PG8_WAIT_V(8); PG8_WAIT_L(0); PG8_BAR; PG8_MMA(0, 0, At, B0); PG8_MMA(0, 1, At, B1); PG8_BAR; PG8_SCHED;
            PG8_LDA(At, 0, 1); PG8_STAGE(PG8_SB(0, 0), b2, voffB); PG8_STAGE(PG8_SB(0, 1), b2 + hstep, voffB); PG8_STAGE(PG8_SA(0, 0), a2, voffA);
            PG8_WAIT_V(8); PG8_WAIT_L(0); PG8_BAR; PG8_MMA(1, 0, At, B0); PG8_MMA(1, 1, At, B1); PG8_BAR; PG8_SCHED;
            PG8_LDB(B0, 1, 0); PG8_LDB(B1, 1, 1); PG8_SCHED; PG8_LDA(At, 1, 0); PG8_STAGE(PG8_SA(0, 1), a2 + hstep, voffA);
            PG8_WAIT_V(8); PG8_WAIT_L(0); PG8_BAR; PG8_MMA(0, 0, At, B0); PG8_MMA(0, 1, At, B1); PG8_BAR; PG8_SCHED;
            PG8_LDA(At, 1, 1); PG8_STAGE(PG8_SB(1, 0), b3, voffB); PG8_STAGE(PG8_SB(1, 1), b3 + hstep, voffB); PG8_STAGE(PG8_SA(1, 0), a3, voffA);
            PG8_WAIT_V(8); PG8_WAIT_L(0); PG8_BAR; PG8_MMA(1, 0, At, B0); PG8_MMA(1, 1, At, B1); PG8_BAR; PG8_SCHED;
            } else {
            PG8_LDB(B0, 0, 0); PG8_SCHED; PG8_LDA(At, 0, 0); PG8_STAGE(PG8_SA(1, 1), a1 + hstep, voffA);
            PG8_WAIT_L(8); PG8_BAR; PG8_WAIT_L(0); PG8_MMA(0, 0, At, B0); PG8_BAR; PG8_SCHED;
            PG8_LDB(B1, 0, 1); PG8_STAGE(PG8_SB(0, 0), b2, voffB);
            PG8_BAR; PG8_WAIT_L(0); PG8_MMA(0, 1, At, B1); PG8_BAR;
            PG8_LDA(At, 0, 1); PG8_STAGE(PG8_SA(0, 0), a2, voffA);
            PG8_BAR; PG8_WAIT_L(0); PG8_MMA(1, 0, At, B0); PG8_BAR; PG8_SCHED;
            PG8_STAGE(PG8_SB(0, 1), b2 + hstep, voffB);
            PG8_WAIT_V(6); PG8_BAR; PG8_MMA(1, 1, At, B1); PG8_BAR;
            PG8_LDB(B0, 1, 0); PG8_SCHED; PG8_LDA(At, 1, 0); PG8_STAGE(PG8_SA(0, 1), a2 + hstep, voffA);
            PG8_WAIT_L(8); PG8_BAR; PG8_WAIT_L(0); PG8_MMA(0, 0, At, B0); PG8_BAR; PG8_SCHED;
            PG8_LDB(B1, 1, 1); PG8_STAGE(PG8_SB(1, 0), b3, voffB);
            PG8_BAR; PG8_WAIT_L(0); PG8_MMA(0, 1, At, B1); PG8_BAR;
            PG8_LDA(At, 1, 1); PG8_STAGE(PG8_SA(1, 0), a3, voffA);
            PG8_BAR; PG8_WAIT_L(0); PG8_MMA(1, 0, At, B0); PG8_BAR; PG8_SCHED;
            PG8_STAGE(PG8_SB(1, 1), b3 + hstep, voffB);
            PG8_WAIT_V(6); PG8_BAR; PG8_MMA(1, 1, At, B1); PG8_BAR;
            }
        }
        if constexpr (DT == 1) asm volatile("s_nop 15\n\ts_nop 15" ::: );
        if constexpr (ALIGN_EPI) { if (wr == 0) PG8_BAR; }
        if constexpr (!Epi::AFTER_DRAIN) { E(acc, cur, wr, wc, fr, fq); S.done(cur); }
        if (!has_next) break;
        float zl2_ = 0.f; asm volatile("" : "+v"(zl2_));
#pragma unroll
        for (int a = 0; a < 2; ++a)
#pragma unroll
            for (int b = 0; b < 2; ++b)
#pragma unroll
                for (int m = 0; m < 4; ++m)
#pragma unroll
                    for (int n = 0; n < 2; ++n) acc[a][b][m][n] = (f32x4){zl2_, zl2_, zl2_, zl2_};
        cur = nxt; cA = nA; cB = nB; ++ui;
        if constexpr (ALIGN_EPI) { if (wr == 1) PG8_BAR; }
    }
    PG8_WAIT_V(0);
    if constexpr (!ALIGN_EPI) { if (wr == 0) PG8_BAR; }
    PG8_BAR;
    if constexpr (Epi::AFTER_DRAIN) { E.fused(acc, cur, wr, wc, fr, fq, lds, wid, lane); S.done(cur); }
#undef PG8_SA
#undef PG8_SB
#undef PG8_STAGE
#undef PG8_LDA
#undef PG8_LDB
#undef PG8_MMA
#undef PG8_WAIT_V
#undef PG8_WAIT_L
#undef PG8_BAR
#undef PG8_SCHED
}
}

constexpr int BATCH = 8, SEQ = 4096, D = 1024, M = BATCH * SEQ, DEPTH = 4;
constexpr int DPOOL = 512, NPG = 4, PGC = 128, DML = 512, NH = 4, DH = 128, CONVW = 4;
constexpr int DIN = 2568, NZ = 2560;
constexpr int ZQ = 512, ZK = 1024, ZV = 1536, ZO = 2048;
constexpr int FFD = 2816, NE = 8, FFE = 3584;
constexpr float ALPHA = 1.6817928305074290f;
constexpr float LN_EPS = 1e-5f;
constexpr float KSCALE = 0.08838834764831845f;
constexpr int NWAVES = 8, NTHR = 512;
constexpr float F8_WSC = 64.0f, F8_HSC = 8.0f, F8_DSC = 256.0f, F8_ASC = 8.0f;
constexpr int MAX_TILES = 2 * M / 256 + NE, PASS_TILES = MAX_TILES, NPASS = 1;
constexpr int NPH = 18, NPHASES = 1 + DEPTH * NPH;

constexpr size_t MiB = 1u << 20;
constexpr size_t WS_CTL = 0, CTL_ZERO_BYTES = 2 * MiB;
constexpr size_t WS_GATE = 2 * MiB;
constexpr size_t WS_PWT = 3 * MiB;
constexpr size_t WS_MOE = 4 * MiB;
constexpr size_t MOE_TOK_E = WS_MOE, MOE_TOK_POS = WS_MOE + 256 * 1024, MOE_TOK_W = WS_MOE + 512 * 1024, MOE_TOK_SLOT = WS_MOE + 768 * 1024,
                 MOE_BLK_CNT = WS_MOE + 1024 * 1024, MOE_TILE_E = MOE_BLK_CNT + 8192, MOE_META = MOE_TILE_E + 4096;
constexpr size_t WS_WIN = 8 * MiB, WS_WOUT = 28 * MiB, WS_WGU = 36 * MiB, WS_WD = 58 * MiB, WS_EGU = 70 * MiB, WS_ED = 182 * MiB;
constexpr size_t WS_T = 238 * MiB;
constexpr size_t WS_XB = 302 * MiB;
constexpr size_t WS_R2 = 366 * MiB;
constexpr size_t WS_R3 = 606 * MiB;
constexpr size_t WS_R4 = 738 * MiB;
constexpr size_t WS_END = 870 * MiB;
constexpr size_t IN_FLOATS = (size_t)M * D + (size_t)DEPTH * D * DIN + 32 + 16384 + 4096 + 262144 + 2048 + 2048 + (size_t)DEPTH * D * D + 4 * 4096 + 3 * (size_t)2 * D * FFD + 16384 + 16 + 3 * (size_t)2 * NE * D * FFE;
static_assert(WS_END <= IN_FLOATS * 4, "workspace map exceeds the guaranteed d_ws size");
static_assert(WS_WIN + (size_t)DEPTH * NZ * D * 2 <= WS_WOUT && WS_WOUT + (size_t)DEPTH * D * D * 2 <= WS_WGU && WS_WGU + (size_t)2 * 2 * FFD * D * 2 <= WS_WD && WS_WD + (size_t)2 * D * FFD * 2 <= WS_EGU, "ws map 1");
static_assert(WS_EGU + (size_t)NE * 2 * FFE * D * 2 <= WS_ED && WS_ED + (size_t)NE * D * FFE * 2 <= WS_T && WS_T + (size_t)M * D * 2 <= WS_XB && WS_XB + (size_t)M * D * 2 <= WS_R2, "ws map 2");
static_assert(WS_R2 + (size_t)M * FFD * 2 <= WS_R3 && WS_R2 + (size_t)M * NZ * 2 <= WS_R3 && WS_R2 + (size_t)MAX_TILES * 256 * FFE <= WS_R3, "ws map 3");
static_assert(WS_R3 + (size_t)(2 * M + NE * 256) * D * 2 <= WS_R4 && WS_R4 + (size_t)(2 * M + NE * 256) * D * 2 <= WS_END && (size_t)M * 1024 * 2 + (size_t)M * 512 * 4 <= WS_END - WS_R4, "ws map 4");
constexpr int CW_BAR = 4096;
constexpr int LDS_BYTES = 147456, RING_BYTES = 131072, MISC_OFF = LDS_BYTES - 256;

#define GAS __attribute__((address_space(1)))
#define LAS __attribute__((address_space(3)))
typedef unsigned short bf16;
typedef unsigned v4u __attribute__((ext_vector_type(4)));
typedef unsigned v2u __attribute__((ext_vector_type(2)));
typedef float f32x4 __attribute__((ext_vector_type(4)));
#define LDS_WAIT() asm volatile("s_waitcnt lgkmcnt(0)" ::: "memory")
__device__ __forceinline__ unsigned f2bf(float f) { unsigned u = __builtin_bit_cast(unsigned, f); return (u + 0x7fffu + ((u >> 16) & 1u)) >> 16; }
typedef __bf16 bf16x2_hw __attribute__((ext_vector_type(2)));
typedef float f32x2_hw __attribute__((ext_vector_type(2)));
__device__ __forceinline__ unsigned pk2(float lo, float hi) { const f32x2_hw v = {lo, hi}; return __builtin_bit_cast(unsigned, __builtin_convertvector(v, bf16x2_hw)); }
__device__ __forceinline__ unsigned f8x4(float a, float b, float c, float d) {
    a = fminf(fmaxf(a, -448.f), 448.f); b = fminf(fmaxf(b, -448.f), 448.f); c = fminf(fmaxf(c, -448.f), 448.f); d = fminf(fmaxf(d, -448.f), 448.f);
    int r = __builtin_amdgcn_cvt_pk_fp8_f32(a, b, 0, false); r = __builtin_amdgcn_cvt_pk_fp8_f32(c, d, r, true); return (unsigned)r; }
__device__ __forceinline__ float bf2f(unsigned short b) { return __builtin_bit_cast(float, (unsigned)b << 16); }
__device__ __forceinline__ float bflo(unsigned w) { return __builtin_bit_cast(float, w << 16); }
__device__ __forceinline__ float bfhi(unsigned w) { return __builtin_bit_cast(float, w & 0xffff0000u); }
__device__ __forceinline__ int lane_id_v() { int l; asm volatile("v_mbcnt_lo_u32_b32 %0, -1, 0\n\tv_mbcnt_hi_u32_b32 %0, -1, %0" : "=v"(l)); return l; }
__device__ __forceinline__ float my_shfl_xor(float v, int o) { const int l = lane_id_v(); return __builtin_bit_cast(float, __builtin_amdgcn_ds_bpermute((l ^ o) << 2, __builtin_bit_cast(int, v))); }
__device__ __forceinline__ float my_shfl_up(float v, int o) { const int l = lane_id_v(); const int s = (l - o) < 0 ? l : (l - o); return __builtin_bit_cast(float, __builtin_amdgcn_ds_bpermute(s << 2, __builtin_bit_cast(int, v))); }
__device__ __forceinline__ int my_shfl_up(int v, int o) { const int l = lane_id_v(); const int s = (l - o) < 0 ? l : (l - o); return __builtin_amdgcn_ds_bpermute(s << 2, v); }
#define __shfl_xor(v, o) my_shfl_xor((v), (o))
#define __shfl_up(v, o) my_shfl_up((v), (o))
__device__ __forceinline__ float wave_sum(float v) {
#pragma unroll
    for (int o = 1; o < 64; o <<= 1) v += __shfl_xor(v, o);
    return v;
}
__device__ __forceinline__ float sigmoid_f(float x) { return 1.0f / (1.0f + __expf(-x)); }
#define XB_TMO      128
#define XB_XCNT(j)  (256  + 64 * (j))
#define XB_XSUB(j)  (1280 + 64 * (j))
#define XB_XGEN(j)  (2304 + 64 * (j))
#define XB_TOP      3328
#define XB_TOPGEN   3392
#define XCD_BAR_WORDS 3456
#define XB_SPIN_CAP (1u << 18)

__device__ __forceinline__ unsigned xb_ld(unsigned* p)              { return __hip_atomic_load(p, __ATOMIC_RELAXED, __HIP_MEMORY_SCOPE_AGENT); }
__device__ __forceinline__ unsigned xb_add(unsigned* p, unsigned v) { return __hip_atomic_fetch_add(p, v, __ATOMIC_RELAXED, __HIP_MEMORY_SCOPE_AGENT); }
__device__ __forceinline__ unsigned xb_xcc_id() { return (unsigned)__builtin_amdgcn_s_getreg((3 << 11) | 20) & 0xFu; }
#define XB_SPIN(cond, bar) do { unsigned _sp = 0; while (cond) { __builtin_amdgcn_s_sleep(1); \
    if ((++_sp & 255u) == 0u) { if (xb_ld(&(bar)[XB_TMO])) break; if (_sp > XB_SPIN_CAP) { atomicAdd(&(bar)[XB_TMO], 1u); break; } } } } while (0)

struct XcdBarrier {
    unsigned* bar; unsigned x;
    volatile LAS unsigned* st;
};

__device__ __forceinline__ XcdBarrier xcd_barrier_post(unsigned* bar, volatile LAS unsigned* st) {
    XcdBarrier b; b.bar = bar; b.x = xb_xcc_id(); b.st = st;
    if (threadIdx.x == 0) (void)xb_add(&bar[XB_XCNT(b.x)], 1u);
    return b;
}
__device__ __forceinline__ void xcd_barrier_complete(unsigned* bar, unsigned x, unsigned& nloc, unsigned& nx) {
    const unsigned G = gridDim.x * gridDim.y * gridDim.z;
    unsigned sum, cnt, mine, sp = 0u;
    for (;;) {
        sum = 0u; cnt = 0u; mine = 0u;
#pragma unroll
        for (unsigned j = 0; j < 16; ++j) { const unsigned c = xb_ld(&bar[XB_XCNT(j)]); sum += c; cnt += (c > 0u) ? 1u : 0u; mine = (j == x) ? c : mine; }
        if (sum == G) break;
        __builtin_amdgcn_s_sleep(1);
        if ((++sp & 255u) == 0u) { if (xb_ld(&bar[XB_TMO])) break; if (sp > XB_SPIN_CAP) { atomicAdd(&bar[XB_TMO], 1u); break; } }
    }
    nloc = mine > 0u ? mine : 1u; nx = cnt > 0u ? cnt : 1u;
}

__device__ __forceinline__ void xcd_barrier(const XcdBarrier& b) {
    asm volatile("s_waitcnt vmcnt(0)" ::: "memory");
    __syncthreads();
    if (threadIdx.x == 0) {
        unsigned* bar = b.bar;
        __builtin_amdgcn_s_waitcnt(0);
        unsigned nloc = b.st[0], nx = b.st[1];
        if (nloc == 0u) { xcd_barrier_complete(bar, b.x, nloc, nx); b.st[0] = nloc; b.st[1] = nx; }
        const unsigned old = xb_add(&bar[XB_XSUB(b.x)], 1u);
        const unsigned gen = old / nloc;
        if (old + 1u == (gen + 1u) * nloc) {
            __builtin_amdgcn_fence(__ATOMIC_RELEASE, "agent");
            asm volatile("s_waitcnt vmcnt(0)" ::: "memory");
            const unsigned og = xb_add(&bar[XB_TOP], 1u);
            const unsigned tgt = (og / nx + 1u) * nx;
            if (og + 1u != tgt) XB_SPIN(xb_ld(&bar[XB_TOP]) < tgt, bar);
            xb_add(&bar[XB_XGEN(b.x)], 1u);
            __builtin_amdgcn_fence(__ATOMIC_ACQUIRE, "agent");
            asm volatile("s_waitcnt vmcnt(0)" ::: "memory");
        } else {
            XB_SPIN(xb_ld(&bar[XB_XGEN(b.x)]) == gen, bar);
            __builtin_amdgcn_fence(__ATOMIC_ACQUIRE, "agent");
            asm volatile("s_waitcnt vmcnt(0)" ::: "memory");
        }
    }
    __syncthreads();
}

struct Args { const float* in[21]; float* out; unsigned char* ws; int ph_lo, ph_hi, li, pad; };
static_assert(sizeof(Args) == 21 * 8 + 8 + 8 + 16, "Args has no padding");
typedef const __attribute__((address_space(4))) Args* ArgsP;
struct Ctx {
    LAS unsigned char* lds; int tid, lane, wave, G, bid;
    ArgsP Ap;
};
__device__ __forceinline__ Ctx make_ctx(unsigned char* lds_raw, int wave_s) {
    const int tid = wave_s * 64 + lane_id_v();
    ArgsP ap = (ArgsP)__builtin_amdgcn_kernarg_segment_ptr(); asm volatile("" : "+s"(ap));
    int G = (int)gridDim.x, bid = (int)blockIdx.x; asm volatile("" : "+s"(G), "+s"(bid));
    Ctx C{(LAS unsigned char*)lds_raw, tid, tid & 63, wave_s, G, bid, ap};
    return C;
}
enum { I_X = 0, I_WIN, I_BG, I_CW, I_CB, I_PW, I_PS, I_MG, I_WOUT, I_L1G, I_L1B, I_L2G, I_L2B, I_WGD, I_WUD, I_WDD, I_WR, I_BR, I_WGE, I_WUE, I_WDE };
#define WSP(T, off) ((T*)(C.Ap->ws + (off)))

template <bool F8 = false> __device__ __forceinline__ void cvt_item(const float* W, int ldw, int K, int k0, int nsrc0, bf16* WT, int drow0, LAS float* scr, int lane, float fsc = 1.0f) {
    f32x4 t[16];
#pragma unroll
    for (int i = 0; i < 16; ++i) t[i] = *(const f32x4*)(W + (size_t)(k0 + (lane >> 4) + 4 * i) * ldw + nsrc0 + 4 * (lane & 15));
#pragma unroll
    for (int i = 0; i < 16; ++i) { LAS float* p = scr + ((lane >> 4) + 4 * i) * 65 + 4 * (lane & 15); p[0] = t[i].x; p[1] = t[i].y; p[2] = t[i].z; p[3] = t[i].w; }
    LDS_WAIT(); asm volatile("" ::: "memory");
    const int c = lane & 7;
#pragma unroll
    for (int j = 0; j < 8; ++j) { const int n = (lane >> 3) + 8 * j; const LAS float* s = scr + (8 * c) * 65 + n;
        if constexpr (F8) { v2u o; o.x = f8x4(s[0 * 65] * fsc, s[1 * 65] * fsc, s[2 * 65] * fsc, s[3 * 65] * fsc); o.y = f8x4(s[4 * 65] * fsc, s[5 * 65] * fsc, s[6 * 65] * fsc, s[7 * 65] * fsc);
            *(v2u*)((unsigned char*)WT + (size_t)(drow0 + n) * K + k0 + 8 * c) = o; }
        else { v4u o; o.x = pk2(s[0 * 65], s[1 * 65]); o.y = pk2(s[2 * 65], s[3 * 65]); o.z = pk2(s[4 * 65], s[5 * 65]); o.w = pk2(s[6 * 65], s[7 * 65]);
            *(v4u*)(WT + (size_t)(drow0 + n) * K + k0 + 8 * c) = o; } }
    LDS_WAIT(); asm volatile("" ::: "memory");
}
template <int MODE, bool F8 = false> __device__ __forceinline__ void cvt_mat(const float* W, int ldw, int K, int ncols, bf16* WT, int item, LAS float* scr, int lane, float fsc = 1.0f) {
    const int nblk = ncols / 64, kb = item / nblk, nb = item % nblk, n0 = 64 * nb;
    const int drow0 = MODE == 0 ? n0 : ((n0 >> 7) * 256 + (n0 & 127) + (MODE == 2 ? 128 : 0));
    cvt_item<F8>(W, ldw, K, 64 * kb, n0, WT, drow0, scr, lane, fsc);
}
constexpr int CVT_SCR = 64 * 65 * 4;
constexpr int IT_WIN = (D / 64) * (NZ / 64), IT_WOUT = (D / 64) * (D / 64), IT_G = (D / 64) * (FFD / 64), IT_DD = (FFD / 64) * (D / 64), IT_EG = (D / 64) * (FFE / 64), IT_ED = (FFE / 64) * (D / 64);
static_assert(8 * CVT_SCR <= MISC_OFF && NZ % 64 == 0 && FFD % 64 == 0 && FFE % 64 == 0, "converter tiles");
__device__ __forceinline__ void convert_experts(Ctx& C, int j) {
    LAS float* scr = (LAS float*)(C.lds + C.wave * CVT_SCR);
    const int gw = C.bid * NWAVES + C.wave, NGW = C.G * NWAVES;
    static_assert(IT_EG == IT_ED, "expert item counts");
    for (int it = gw; it < 3 * NE * IT_EG; it += NGW) {
        const int kind = it / (NE * IT_EG), e = (it / IT_EG) % NE, r = it % IT_EG;
        if (kind == 0) cvt_mat<1, true>(C.Ap->in[I_WGE] + (size_t)(j * NE + e) * D * FFE, FFE, D, FFE, (bf16*)(WSP(unsigned char, WS_EGU) + (size_t)e * 2 * FFE * D), r, scr, C.lane, F8_WSC);
        else if (kind == 1) cvt_mat<2, true>(C.Ap->in[I_WUE] + (size_t)(j * NE + e) * D * FFE, FFE, D, FFE, (bf16*)(WSP(unsigned char, WS_EGU) + (size_t)e * 2 * FFE * D), r, scr, C.lane, F8_WSC);
        else cvt_mat<0, true>(C.Ap->in[I_WDE] + (size_t)(j * NE + e) * FFE * D, D, FFE, D, (bf16*)(WSP(unsigned char, WS_ED) + (size_t)e * D * FFE), r, scr, C.lane, F8_DSC);
    }
}
__device__ __forceinline__ void load_w8(Ctx& C, LAS float* wl, const float* W, int ldw, int coff) {
    for (int k = C.tid; k < D; k += NTHR) { const float* p = W + (size_t)k * ldw + coff;
#pragma unroll
        for (int g = 0; g < 8; ++g) wl[g * 1024 + k] = p[g]; }
}
__device__ __forceinline__ int colof(int j, int lane) { return (j >> 1) * 512 + 8 * lane + (j & 1) * 4; }
__device__ __forceinline__ void load_vec_f32(const float* p, f32x4 (&v)[4], int lane) {
#pragma unroll
    for (int j = 0; j < 4; ++j) v[j] = *(const f32x4*)(p + colof(j, lane));
}
__device__ __forceinline__ void store_row_f32(float* row, const f32x4 (&v)[4], int lane) {
#pragma unroll
    for (int j = 0; j < 4; ++j) *(f32x4*)(row + colof(j, lane)) = v[j];
}
__device__ __forceinline__ void load_row_bf16(const bf16* row, f32x4 (&v)[4], int lane) {
    const v4u a = *(const v4u*)(row + 8 * lane), b = *(const v4u*)(row + 512 + 8 * lane);
    v[0] = (f32x4){bflo(a.x), bfhi(a.x), bflo(a.y), bfhi(a.y)}; v[1] = (f32x4){bflo(a.z), bfhi(a.z), bflo(a.w), bfhi(a.w)};
    v[2] = (f32x4){bflo(b.x), bfhi(b.x), bflo(b.y), bfhi(b.y)}; v[3] = (f32x4){bflo(b.z), bfhi(b.z), bflo(b.w), bfhi(b.w)};
}
__device__ __forceinline__ void store_row_bf16(bf16* row, const f32x4 (&v)[4], int lane) {
    v4u a, b; a.x = pk2(v[0].x, v[0].y); a.y = pk2(v[0].z, v[0].w); a.z = pk2(v[1].x, v[1].y); a.w = pk2(v[1].z, v[1].w);
    b.x = pk2(v[2].x, v[2].y); b.y = pk2(v[2].z, v[2].w); b.z = pk2(v[3].x, v[3].y); b.w = pk2(v[3].z, v[3].w);
    *(v4u*)(row + 8 * lane) = a; *(v4u*)(row + 512 + 8 * lane) = b;
}
__device__ __forceinline__ void load_row_res(const bf16* trow, const bf16* xrow, f32x4 (&v)[4], int lane) {
    f32x4 t[4], x[4]; load_row_bf16(trow, t, lane); load_row_bf16(xrow, x, lane);
#pragma unroll
    for (int j = 0; j < 4; ++j) v[j] = x[j] * ALPHA + t[j];
}
__device__ __forceinline__ float dot8(const f32x4 (&v)[4], const LAS float* wl, int lane) {
    float a[8];
#pragma unroll
    for (int g = 0; g < 8; ++g) { float s = 0.f;
#pragma unroll
        for (int j = 0; j < 4; ++j) { const f32x4 w = *(const LAS f32x4*)(wl + g * 1024 + colof(j, lane)); s += (v[j].x * w.x + v[j].y * w.y) + (v[j].z * w.z + v[j].w * w.w); }
        a[g] = s; }
    float b4[4], b2[2], b1;
    { const bool hi = (lane & 32) != 0;
#pragma unroll
      for (int i = 0; i < 4; ++i) { const float keep = hi ? a[i + 4] : a[i], send = hi ? a[i] : a[i + 4]; b4[i] = keep + __shfl_xor(send, 32); } }
    { const bool hi = (lane & 16) != 0;
#pragma unroll
      for (int i = 0; i < 2; ++i) { const float keep = hi ? b4[i + 2] : b4[i], send = hi ? b4[i] : b4[i + 2]; b2[i] = keep + __shfl_xor(send, 16); } }
    { const bool hi = (lane & 8) != 0; const float keep = hi ? b2[1] : b2[0], send = hi ? b2[0] : b2[1]; b1 = keep + __shfl_xor(send, 8); }
    b1 += __shfl_xor(b1, 4); b1 += __shfl_xor(b1, 2); b1 += __shfl_xor(b1, 1);
    return b1;
}
__device__ __forceinline__ void write_gates(Ctx& C, int lnext, int m, const f32x4 (&v)[4], const LAS float* wl) {
    const float val = dot8(v, wl, C.lane);
    if ((C.lane & 7) == 0) WSP(float, WS_GATE)[(size_t)m * 8 + (C.lane >> 3)] = val + C.Ap->in[I_BG][lnext * 8 + (C.lane >> 3)];
}

__device__ __forceinline__ void phase_prologue(Ctx& C) {
    LAS float* scr = (LAS float*)(C.lds + C.wave * CVT_SCR);
    const int gw = C.bid * NWAVES + C.wave, NGW = C.G * NWAVES;
    constexpr int IT_PW = (PGC / 64) * (PGC / 64);
    constexpr int NI = 4 * IT_WIN + 4 * IT_WOUT + 4 * IT_G + 2 * IT_DD + DEPTH * NPG * IT_PW;
    for (int it = gw; it < NI; it += NGW) {
        int r = it;
        if (r < 4 * IT_WIN) { const int l = r / IT_WIN; cvt_mat<0>(C.Ap->in[I_WIN] + (size_t)l * D * DIN, DIN, D, NZ, WSP(bf16, WS_WIN) + (size_t)l * NZ * D, r % IT_WIN, scr, C.lane); continue; } r -= 4 * IT_WIN;
        if (r < 4 * IT_WOUT) { const int l = r / IT_WOUT; cvt_mat<0>(C.Ap->in[I_WOUT] + (size_t)l * D * D, D, D, D, WSP(bf16, WS_WOUT) + (size_t)l * D * D, r % IT_WOUT, scr, C.lane); continue; } r -= 4 * IT_WOUT;
        if (r < 2 * IT_G) { const int j = r / IT_G; cvt_mat<1>(C.Ap->in[I_WGD] + (size_t)j * D * FFD, FFD, D, FFD, WSP(bf16, WS_WGU) + (size_t)j * 2 * FFD * D, r % IT_G, scr, C.lane); continue; } r -= 2 * IT_G;
        if (r < 2 * IT_G) { const int j = r / IT_G; cvt_mat<2>(C.Ap->in[I_WUD] + (size_t)j * D * FFD, FFD, D, FFD, WSP(bf16, WS_WGU) + (size_t)j * 2 * FFD * D, r % IT_G, scr, C.lane); continue; } r -= 2 * IT_G;
        if (r < 2 * IT_DD) { const int j = r / IT_DD; cvt_mat<0, true>(C.Ap->in[I_WDD] + (size_t)j * FFD * D, D, FFD, D, (bf16*)(WSP(unsigned char, WS_WD) + (size_t)j * D * FFD), r % IT_DD, scr, C.lane, F8_DSC); continue; } r -= 2 * IT_DD;
        { const int lg = r / IT_PW; cvt_mat<0>(C.Ap->in[I_PW] + (size_t)lg * PGC * PGC, PGC, PGC, PGC, WSP(bf16, WS_PWT) + (size_t)lg * PGC * PGC, r % IT_PW, scr, C.lane); }
    }
    convert_experts(C, 0);
    __syncthreads();
    LAS float* wl = (LAS float*)C.lds;
    load_w8(C, wl, C.Ap->in[I_WIN], DIN, NZ);
    __syncthreads();
    for (int m = gw; m < M; m += NGW) {
        f32x4 v[4]; load_vec_f32(C.Ap->in[I_X] + (size_t)m * D, v, C.lane);
        store_row_bf16(WSP(bf16, WS_XB) + (size_t)m * D, v, C.lane);
        write_gates(C, 0, m, v, wl);
    }
}

__device__ __forceinline__ void phase_conv(Ctx& C, int l) {
    const bf16* Z = WSP(bf16, WS_R2); bf16* QK = WSP(bf16, WS_R4);
    const int c8 = (C.tid & 127) * 8; const float sc = c8 >= 512 ? KSCALE : 1.0f;
    const float* cw = C.Ap->in[I_CW] + (size_t)l * CONVW * 1024 + c8; const float* cb = C.Ap->in[I_CB] + (size_t)l * 1024 + c8;
    float w[CONVW][8], bias[8];
#pragma unroll
    for (int j = 0; j < CONVW; ++j) { const f32x4 a = *(const f32x4*)(cw + j * 1024), b2 = *(const f32x4*)(cw + j * 1024 + 4);
        w[j][0] = a.x; w[j][1] = a.y; w[j][2] = a.z; w[j][3] = a.w; w[j][4] = b2.x; w[j][5] = b2.y; w[j][6] = b2.z; w[j][7] = b2.w; }
    { const f32x4 a = *(const f32x4*)cb, b2 = *(const f32x4*)(cb + 4); bias[0] = a.x; bias[1] = a.y; bias[2] = a.z; bias[3] = a.w; bias[4] = b2.x; bias[5] = b2.y; bias[6] = b2.z; bias[7] = b2.w; }
    const int tg0 = C.bid * (NTHR / 128) + (C.tid >> 7), TGS = C.G * (NTHR / 128);
    for (int tg = tg0; tg < M / 4; tg += TGS) {
        const int m0 = tg * 4, t0 = m0 & (SEQ - 1);
        v4u zr[7];
#pragma unroll
        for (int r = 0; r < 7; ++r) { zr[r] = (v4u){0u, 0u, 0u, 0u}; if (t0 - 3 + r >= 0) zr[r] = *(const v4u*)(Z + (size_t)(m0 - 3 + r) * NZ + ZQ + c8); }
#pragma unroll
        for (int i = 0; i < 4; ++i) { float a[8];
#pragma unroll
            for (int e = 0; e < 8; ++e) a[e] = bias[e];
#pragma unroll
            for (int j = 0; j < CONVW; ++j) { const v4u zz = zr[i + j];
                a[0] += w[j][0] * bflo(zz.x); a[1] += w[j][1] * bfhi(zz.x); a[2] += w[j][2] * bflo(zz.y); a[3] += w[j][3] * bfhi(zz.y);
                a[4] += w[j][4] * bflo(zz.z); a[5] += w[j][5] * bfhi(zz.z); a[6] += w[j][6] * bflo(zz.w); a[7] += w[j][7] * bfhi(zz.w); }
#pragma unroll
            for (int e = 0; e < 8; ++e) a[e] = a[e] * sigmoid_f(a[e]) * sc;
            v4u o; o.x = pk2(a[0], a[1]); o.y = pk2(a[2], a[3]); o.z = pk2(a[4], a[5]); o.w = pk2(a[6], a[7]);
            *(v4u*)(QK + (size_t)(m0 + i) * 1024 + c8) = o; }
    }
}

__device__ __forceinline__ void phase_pool(Ctx& C, int l) {
    typedef short bf16x8 __attribute__((ext_vector_type(8)));
    const bf16* Z = WSP(bf16, WS_R2); bf16* YC = WSP(bf16, WS_R3); const bf16* PWT = WSP(bf16, WS_PWT) + (size_t)l * NPG * PGC * PGC;
    constexpr int UROW = 272, DOFF = 80 * UROW, USZ = DOFF + 64 * UROW;
    static_assert(2 * USZ <= MISC_OFF, "pool LDS");
    LAS unsigned char* L = C.lds;
    const int tid = C.tid, lane = C.lane, w = C.wave, lr = lane & 15, lg = lane >> 4;
    const int NU = (M / 64) * NPG;
    int gprev[2] = {-1, -1}; bf16x8 xw[2][4]; f32x4 sc[2];
#pragma unroll
    for (int s = 0; s < 2; ++s) { sc[s] = (f32x4){0.f, 0.f, 0.f, 0.f};
#pragma unroll
        for (int ks = 0; ks < 4; ++ks) xw[s][ks] = (bf16x8){0, 0, 0, 0, 0, 0, 0, 0}; }
    v4u pu[2][3];
#define PL_LOAD(s_, u_) do { if ((u_) < NU) { const int g_ = (u_) & 3, m0_ = ((u_) >> 2) * 64, t0_ = m0_ & (SEQ - 1); _Pragma("unroll") for (int i_ = 0; i_ < 3; ++i_) { const int p_ = tid + NTHR * i_, r_ = p_ >> 4, ch_ = p_ & 15; \
        pu[s_][i_] = (v4u){0u, 0u, 0u, 0u}; if (r_ < 79 && t0_ - 15 + r_ >= 0) pu[s_][i_] = *(const v4u*)(Z + (size_t)(m0_ - 15 + r_) * NZ + g_ * PGC + ch_ * 8); } } } while (0)
#define PL_STORE(s_) do { _Pragma("unroll") for (int i_ = 0; i_ < 3; ++i_) { const int p_ = tid + NTHR * i_, r_ = p_ >> 4, ch_ = p_ & 15; if (r_ < 79) *(LAS v4u*)(L + (s_) * USZ + r_ * UROW + ch_ * 16) = pu[s_][i_]; } } while (0)
    PL_LOAD(0, C.bid); PL_LOAD(1, C.bid + C.G);
    for (int u0 = C.bid; u0 < NU; u0 += 2 * C.G) {
        const int nu = (u0 + C.G < NU) ? 2 : 1;
        __syncthreads();
        PL_STORE(0); if (nu > 1) PL_STORE(1);
#pragma unroll
        for (int s = 0; s < 2; ++s) { const int g = (u0 + s * C.G) & 3;
            if (s < nu && g != gprev[s]) { gprev[s] = g;
#pragma unroll
                for (int ks = 0; ks < 4; ++ks) xw[s][ks] = *(const bf16x8*)(PWT + (size_t)(g * PGC + 16 * w + lr) * PGC + 32 * ks + 8 * lg);
                sc[s] = *(const f32x4*)(C.Ap->in[I_PS] + (size_t)l * DPOOL + g * PGC + 16 * w + 4 * lg); } }
        __syncthreads();
        PL_LOAD(0, u0 + 2 * C.G); PL_LOAD(1, u0 + 3 * C.G);
#pragma unroll
        for (int s = 0; s < 2; ++s) if (s < nu) { const int u = u0 + s * C.G, g = u & 3, t0 = ((u >> 2) * 64) & (SEQ - 1);
          LAS unsigned char* Ls = L + s * USZ;
          const int cp = tid & 63, r0 = 8 * w, wn = 2 << g;
          float s0 = 0.f, s1 = 0.f;
          for (int j = 0; j < wn; ++j) { const unsigned x = *(const LAS unsigned*)(Ls + (r0 + 15 - j) * UROW + cp * 4); s0 += bflo(x); s1 += bfhi(x); }
#pragma unroll
          for (int i = 0; i < 8; ++i) { const int r = r0 + i, t = t0 + r;
              const unsigned xc = *(const LAS unsigned*)(Ls + (r + 15) * UROW + cp * 4);
              if (i > 0) { const unsigned xo = *(const LAS unsigned*)(Ls + (r + 15 - wn) * UROW + cp * 4); s0 += bflo(xc) - bflo(xo); s1 += bfhi(xc) - bfhi(xo); }
              const float inv = 1.0f / (float)((t + 1) < wn ? (t + 1) : wn);
              *(LAS unsigned*)(Ls + DOFF + r * UROW + cp * 4) = pk2(s0 * inv - bflo(xc), s1 * inv - bfhi(xc)); } }
        __syncthreads();
#pragma unroll
        for (int s = 0; s < 2; ++s) if (s < nu) { const int u = u0 + s * C.G, g = u & 3, m0 = (u >> 2) * 64;
#pragma unroll
          for (int rt = 0; rt < 4; ++rt) { f32x4 acc = {0.f, 0.f, 0.f, 0.f};
#pragma unroll
            for (int ks = 0; ks < 4; ++ks) { const bf16x8 y = *(const LAS bf16x8*)(L + s * USZ + DOFF + (16 * rt + lr) * UROW + (32 * ks + 8 * lg) * 2); acc = __builtin_amdgcn_mfma_f32_16x16x32_bf16(xw[s][ks], y, acc, 0, 0, 0); }
            acc = acc * sc[s]; v2u o; o.x = pk2(acc[0], acc[1]); o.y = pk2(acc[2], acc[3]);
            *(v2u*)(YC + (size_t)(m0 + 16 * rt + lr) * D + g * PGC + 16 * w + 4 * lg) = o; } }
    }
#undef PL_LOAD
#undef PL_STORE
}

__device__ __forceinline__ void ln_apply(f32x4 (&v)[4], const f32x4 (&g)[4], const f32x4 (&b)[4]) {
    float s = 0.f;
#pragma unroll
    for (int j = 0; j < 4; ++j) s += (v[j].x + v[j].y) + (v[j].z + v[j].w);
    const float mean = wave_sum(s) * (1.0f / D); float s2 = 0.f;
#pragma unroll
    for (int j = 0; j < 4; ++j) { v[j] = v[j] - mean; s2 += (v[j].x * v[j].x + v[j].y * v[j].y) + (v[j].z * v[j].z + v[j].w * v[j].w); }
    const float rstd = 1.0f / sqrtf(wave_sum(s2) * (1.0f / D) + LN_EPS);
#pragma unroll
    for (int j = 0; j < 4; ++j) v[j] = v[j] * rstd * g[j] + b[j];
}

template <bool MOE> __device__ __forceinline__ void phase_ln1(Ctx& C, int l) {
    const bf16* T = WSP(bf16, WS_T); bf16* XB = WSP(bf16, WS_XB);
    f32x4 g[4], b[4]; load_vec_f32(C.Ap->in[I_L1G] + (size_t)l * D, g, C.lane); load_vec_f32(C.Ap->in[I_L1B] + (size_t)l * D, b, C.lane);
    if constexpr (!MOE) {
        const int gw = C.bid * NWAVES + C.wave, NGW = C.G * NWAVES;
        f32x4 v[4]; if (gw < M) load_row_res(T + (size_t)gw * D, XB + (size_t)gw * D, v, C.lane);
        for (int m = gw; m < M; m += NGW) {
            f32x4 vn[4]; if (m + NGW < M) load_row_res(T + (size_t)(m + NGW) * D, XB + (size_t)(m + NGW) * D, vn, C.lane);
            ln_apply(v, g, b);
            store_row_bf16(XB + (size_t)m * D, v, C.lane);
#pragma unroll
            for (int j = 0; j < 4; ++j) v[j] = vn[j];
        }
    } else {
        const int jm = l >> 1;
        LAS float* wl = (LAS float*)C.lds;
        LAS int* sel = (LAS int*)(C.lds + 32768);
        LAS int* cnth = sel + 128;
        int* tok_e = WSP(int, MOE_TOK_E); int* tok_pos = WSP(int, MOE_TOK_POS); float* tok_w = WSP(float, MOE_TOK_W); int* blk_cnt = WSP(int, MOE_BLK_CNT);
        load_w8(C, wl, C.Ap->in[I_WR] + (size_t)jm * D * NE, NE, 0);
        __syncthreads();
        const float brl = C.Ap->in[I_BR][jm * NE + (C.lane >> 3)];
        for (int rg = C.bid; rg < M / 128; rg += C.G) {
            f32x4 v[4]; load_row_res(T + (size_t)(rg * 128 + C.wave * 16) * D, XB + (size_t)(rg * 128 + C.wave * 16) * D, v, C.lane);
            for (int i = 0; i < 16; ++i) {
                const int rl = C.wave * 16 + i, m = rg * 128 + rl;
                f32x4 vn[4]; if (i + 1 < 16) load_row_res(T + (size_t)(m + 1) * D, XB + (size_t)(m + 1) * D, vn, C.lane);
                ln_apply(v, g, b);
                store_row_bf16(XB + (size_t)m * D, v, C.lane);
                const float lgt = dot8(v, wl, C.lane) + brl;
                float lg[8];
#pragma unroll
                for (int e = 0; e < 8; ++e) lg[e] = __builtin_bit_cast(float, __builtin_amdgcn_readlane(__builtin_bit_cast(int, lgt), 8 * e));
                int e0 = 0; float v0 = lg[0];
#pragma unroll
                for (int e = 1; e < 8; ++e) if (lg[e] > v0) { v0 = lg[e]; e0 = e; }
                int e1 = -1; float v1 = -3.0e38f;
#pragma unroll
                for (int e = 0; e < 8; ++e) if (e != e0 && lg[e] > v1) { v1 = lg[e]; e1 = e; }
                const float ex = __expf(v1 - v0), w0 = 1.0f / (1.0f + ex), w1 = ex * w0;
                if (C.lane == 0) { sel[rl] = e0 | (e1 << 8); tok_w[(size_t)m * 2] = w0; tok_w[(size_t)m * 2 + 1] = w1; }
#pragma unroll
                for (int j = 0; j < 4; ++j) v[j] = vn[j];
            }
            __syncthreads();
            int e0 = 0, e1 = 0, pos0 = 0, pos1 = 0;
            if (C.tid < 128) {
                const int s = sel[C.tid]; e0 = s & 255; e1 = s >> 8;
                const unsigned long long lt = (1ull << C.lane) - 1ull;
                int cnt8[8];
#pragma unroll
                for (int e = 0; e < 8; ++e) { const unsigned long long m0 = __ballot(e0 == e), m1 = __ballot(e1 == e);
                    if (e0 == e) pos0 = __popcll(m0 & lt); if (e1 == e) pos1 = __popcll(m0) + __popcll(m1 & lt);
                    cnt8[e] = __popcll(m0) + __popcll(m1); }
                if (C.lane == 0) {
#pragma unroll
                    for (int e = 0; e < 8; ++e) cnth[C.wave * 8 + e] = cnt8[e]; }
            }
            __syncthreads();
            if (C.tid < 128) {
                if (C.wave == 1) { pos0 += cnth[e0]; pos1 += cnth[e1]; }
                const int m = rg * 128 + C.tid;
                tok_e[(size_t)m * 2] = e0; tok_e[(size_t)m * 2 + 1] = e1; tok_pos[(size_t)m * 2] = pos0; tok_pos[(size_t)m * 2 + 1] = pos1;
                if (C.tid < 8) blk_cnt[rg * 8 + C.tid] = cnth[C.tid] + cnth[8 + C.tid];
            }
            __syncthreads();
        }
    }
}

__device__ __forceinline__ void phase_moe_prep(Ctx& C) {
    LAS int* cin = (LAS int*)C.lds;
    LAS int* off = cin + 2048;
    LAS int* tot = off + 2048;
    LAS int* base = tot + 8;
    const int* blk_cnt = WSP(int, MOE_BLK_CNT); const int* tok_e = WSP(int, MOE_TOK_E); const int* tok_pos = WSP(int, MOE_TOK_POS);
    int* tok_slot = WSP(int, MOE_TOK_SLOT); int* tile_e = WSP(int, MOE_TILE_E); int* meta = WSP(int, MOE_META);
    for (int i = C.tid; i < 2048; i += NTHR) cin[i] = blk_cnt[i];
    __syncthreads();
    { const int e = C.wave, i = C.lane;
      const int s0 = cin[(4 * i) * 8 + e], s1 = cin[(4 * i + 1) * 8 + e], s2 = cin[(4 * i + 2) * 8 + e], s3 = cin[(4 * i + 3) * 8 + e];
      const int t = s0 + s1 + s2 + s3; int inc = t;
#pragma unroll
      for (int o = 1; o < 64; o <<= 1) { const int y = __shfl_up(inc, o); if (i >= o) inc += y; }
      const int ex = inc - t;
      off[(4 * i) * 8 + e] = ex; off[(4 * i + 1) * 8 + e] = ex + s0; off[(4 * i + 2) * 8 + e] = ex + s0 + s1; off[(4 * i + 3) * 8 + e] = ex + s0 + s1 + s2;
      if (i == 63) tot[e] = inc; }
    __syncthreads();
    if (C.tid == 0) { int bs = 0;
        for (int e = 0; e < 8; ++e) { base[e] = bs; bs += ((tot[e] + 255) >> 8) << 8; }
        base[8] = bs;
        if (C.bid == 0) meta[0] = bs >> 8; }
    __syncthreads();
    if (C.bid == 0) { const int nt = base[8] >> 8;
        for (int rt = C.tid; rt < nt; rt += NTHR) { int e = 0;
#pragma unroll
            for (int k = 1; k < 8; ++k) e += (rt >= (base[k] >> 8)) ? 1 : 0;
            tile_e[rt] = e; } }
    const int gw = C.bid * NWAVES + C.wave, NGW = C.G * NWAVES;
    const bf16* XB = WSP(bf16, WS_XB); unsigned char* HS = WSP(unsigned char, WS_R3);
    for (int m = gw; m < M; m += NGW) {
        const int rg = m >> 7;
        const v4u r0 = *(const v4u*)(XB + (size_t)m * D + 16 * C.lane), r1 = *(const v4u*)(XB + (size_t)m * D + 16 * C.lane + 8);
        v4u o;
        o.x = f8x4(bflo(r0.x) * F8_HSC, bfhi(r0.x) * F8_HSC, bflo(r0.y) * F8_HSC, bfhi(r0.y) * F8_HSC); o.y = f8x4(bflo(r0.z) * F8_HSC, bfhi(r0.z) * F8_HSC, bflo(r0.w) * F8_HSC, bfhi(r0.w) * F8_HSC);
        o.z = f8x4(bflo(r1.x) * F8_HSC, bfhi(r1.x) * F8_HSC, bflo(r1.y) * F8_HSC, bfhi(r1.y) * F8_HSC); o.w = f8x4(bflo(r1.z) * F8_HSC, bfhi(r1.z) * F8_HSC, bflo(r1.w) * F8_HSC, bfhi(r1.w) * F8_HSC);
#pragma unroll
        for (int k = 0; k < 2; ++k) {
            const int e = tok_e[(size_t)m * 2 + k], pos = tok_pos[(size_t)m * 2 + k];
            const int slot = base[e] + off[rg * 8 + e] + pos;
            *(v4u*)(HS + (size_t)slot * D + 16 * C.lane) = o;
            if (C.lane == 0) tok_slot[(size_t)m * 2 + k] = slot;
        }
    }
}

template <bool MOE> __device__ __forceinline__ void phase_ln2(Ctx& C, int l, size_t dummy_off = 0) {
    const bf16* T = WSP(bf16, WS_T); bf16* XB = WSP(bf16, WS_XB); bf16* XBo = dummy_off ? (bf16*)(C.Ap->ws + dummy_off) : XB;
    float* outf = dummy_off ? (float*)(C.Ap->ws + dummy_off) : C.Ap->out;
    LAS float* wl = (LAS float*)C.lds;
    if (l + 1 < DEPTH) { load_w8(C, wl, C.Ap->in[I_WIN] + (size_t)(l + 1) * D * DIN, DIN, NZ); }
    __syncthreads();
    f32x4 g[4], b[4]; load_vec_f32(C.Ap->in[I_L2G] + (size_t)l * D, g, C.lane); load_vec_f32(C.Ap->in[I_L2B] + (size_t)l * D, b, C.lane);
    const int gw = C.bid * NWAVES + C.wave, NGW = C.G * NWAVES;
    const bf16* Y2 = WSP(bf16, WS_R4); const int* tok_slot = WSP(int, MOE_TOK_SLOT); const float* tok_w = WSP(float, MOE_TOK_W);
    for (int m = gw; m < M; m += NGW) {
        f32x4 v[4];
        if constexpr (MOE) {
            const int s0 = tok_slot[(size_t)m * 2], s1 = tok_slot[(size_t)m * 2 + 1]; const float w0 = tok_w[(size_t)m * 2], w1 = tok_w[(size_t)m * 2 + 1];
            f32x4 ya[4], yb[4]; load_row_bf16(XB + (size_t)m * D, v, C.lane); load_row_bf16(Y2 + (size_t)s0 * D, ya, C.lane); load_row_bf16(Y2 + (size_t)s1 * D, yb, C.lane);
#pragma unroll
            for (int j = 0; j < 4; ++j) v[j] = v[j] * ALPHA + (ya[j] * w0 + yb[j] * w1);
        } else load_row_res(T + (size_t)m * D, XB + (size_t)m * D, v, C.lane);
        ln_apply(v, g, b);
        if (l + 1 < DEPTH) { store_row_bf16(XBo + (size_t)m * D, v, C.lane); write_gates(C, l + 1, m, v, wl); }
        else store_row_f32(outf + (size_t)m * D, v, C.lane);
    }
}


typedef short bf16x8 __attribute__((ext_vector_type(8)));
typedef short s16x4 __attribute__((ext_vector_type(4)));
#define MFMA16(X, Y, ACC) __builtin_amdgcn_mfma_f32_16x16x32_bf16((X), (Y), (ACC), 0, 0, 0)
#define LBAR() do { asm volatile("s_waitcnt lgkmcnt(0)" ::: "memory"); __builtin_amdgcn_s_barrier(); asm volatile("" ::: "memory"); } while (0)
__device__ __forceinline__ unsigned off_b(unsigned row, unsigned ch) { return 256u * row + 16u * (ch ^ (((row & 3u) << 2) | ((row >> 2) & 3u))); }
__device__ __forceinline__ unsigned row_addr16(unsigned lane, unsigned rb, unsigned s) { return off_b((lane & 15u) + 16u * rb, 4u * s + (lane >> 4)); }
__device__ __forceinline__ unsigned tr_addr16(unsigned lane, unsigned c, unsigned ks, unsigned t) {
    const unsigned g = lane >> 4, q = (lane & 15u) >> 2, p = lane & 3u;
    return off_b(32u * ks + 8u * g + 4u * t + q, 2u * c + (p >> 1)) + 8u * (p & 1u);
}
__device__ __forceinline__ s16x4 ds_tr16(const LAS unsigned char* p) { return __builtin_bit_cast(s16x4, __builtin_amdgcn_ds_read_tr16_b64_v4i16((LAS s16x4*)p)); }
__device__ __forceinline__ float logsigmoid_f(float x) { return fminf(x, 0.f) - log1pf(__expf(-fabsf(x))); }
#include <type_traits>

namespace m2 {
constexpr int QI = 0, KI0 = 16384, VI0 = 49152, WI = 81920, WROW = 144, TBL = WI + 64 * WROW;
constexpr int T_R = TBL, T_B = TBL + 2048, T_PM = TBL + 4096, T_M = TBL + 6144, T_EM = TBL + 8192, T_SI = TBL + 10240, T_WL = TBL + 12288, T_GC = TBL + 14336, T_PC = T_GC + 64, T_SOLD = T_GC + 128,
              STAT = T_GC + 256, STATP = 26 * 64 * 4, NV = STAT + 2 * STATP, END = NV + 512;
static_assert(END <= MISC_OFF, "mLSTM LDS map");
constexpr size_t SEG_STATE = WS_R4 + 64 * MiB;
constexpr size_t SEG_ITEM_BYTES = 65536 + 8192;
constexpr size_t SEG_SCAL = SEG_STATE + 256 * SEG_ITEM_BYTES;
}
__device__ __forceinline__ void m2_tables(Ctx& C, const float* GT, size_t m0, int h) {
    using namespace m2;
    LAS float* tr = (LAS float*)(C.lds + T_R); LAS float* tb = (LAS float*)(C.lds + T_B); LAS float* tpm = (LAS float*)(C.lds + T_PM);
    LAS float* gc = (LAS float*)(C.lds + T_GC); LAS float* pc = (LAS float*)(C.lds + T_PC);
    const int w = C.wave, lane = C.lane; const size_t m = m0 + (size_t)w * 64 + lane;
    const float ip = GT[m * 8 + h], fp = GT[m * 8 + 4 + h];
    float bt = logsigmoid_f(fp);
#pragma unroll
    for (int o = 1; o < 64; o <<= 1) { const float y = __shfl_up(bt, o); if (lane >= o) bt += y; }
    const float r = ip - bt; float pm = r;
#pragma unroll
    for (int o = 1; o < 64; o <<= 1) { const float y = __shfl_up(pm, o); if (lane >= o) pm = fmaxf(pm, y); }
    tr[w * 64 + lane] = r; tb[w * 64 + lane] = bt; tpm[w * 64 + lane] = pm;
    if (lane == 63) { gc[w] = bt; pc[w] = pm; }
}
__device__ __forceinline__ float m2_chain(Ctx& C, float m_in) {
    using namespace m2;
    LAS float* gc = (LAS float*)(C.lds + T_GC); LAS float* pc = (LAS float*)(C.lds + T_PC); LAS float* so = (LAS float*)(C.lds + T_SOLD);
    const int w = C.wave, lane = C.lane;
    float m = m_in, mprev = m_in, m63 = 0.f;
#pragma unroll
    for (int c = 0; c < 8; ++c) { const float g = gc[c], P = pc[c]; const float M63 = fmaxf(P, m); if (c == w) { mprev = m; m63 = M63; } m = g + M63; }
    unsigned a0 = (unsigned)(T_R + 4 * (w * 64 + lane)); asm volatile("" : "+v"(a0)); LAS float* t0 = (LAS float*)(C.lds + a0);
#define M2T(T) t0[((T) - T_R) / 4]
    const float Mt = fmaxf(M2T(T_PM), mprev);
    M2T(T_M) = Mt; M2T(T_EM) = __expf(-(M2T(T_B) + Mt)); M2T(T_SI) = __expf(mprev - Mt); M2T(T_WL) = __expf(M2T(T_R) - m63);
#undef M2T
    if (lane == 0) so[w] = __expf(mprev - m63);
    return m;
}
struct M2Lane { unsigned trA0[2], trK[2], rowB, rowK, qlB, qhB; };
__device__ __forceinline__ M2Lane m2_lane(unsigned lane) {
    const unsigned lr = lane & 15u, g = lane >> 4, q = lr >> 2, p = lane & 3u; M2Lane K;
#pragma unroll
    for (unsigned t = 0; t < 2; ++t) { const unsigned F = (q << 2) | ((2u * g + t) & 3u), b = p >> 1;
        K.trA0[t] = 256u * (8u * g + 4u * t + q) + 16u * (b ^ (F & 1u)) + 8u * (p & 1u); K.trK[t] = F >> 1; }
    const unsigned Fr = ((lr & 3u) << 2) | ((lr >> 2) & 3u);
    K.rowB = 256u * lr + 16u * (g ^ (Fr & 3u)); K.rowK = Fr >> 2;
    K.qlB = 256u * lr + 16u * ((g >> 1) ^ (Fr & 3u)) + 8u * (g & 1u);
    K.qhB = 256u * lr + 16u * ((2u | (g >> 1)) ^ (Fr & 3u)) + 8u * (g & 1u);
    return K;
}
#define M2_LAUNDER(K) asm volatile("" : "+v"((K).trA0[0]), "+v"((K).trA0[1]), "+v"((K).trK[0]), "+v"((K).trK[1]), "+v"((K).rowB), "+v"((K).rowK), "+v"((K).qlB), "+v"((K).qhB))
__device__ __forceinline__ unsigned tr_addr_f(const M2Lane& K, unsigned c, unsigned ks, unsigned t) { return K.trA0[t] + 8192u * ks + 32u * (c ^ K.trK[t]); }
__device__ __forceinline__ unsigned row_addr_f(const M2Lane& K, unsigned rb, unsigned s) { return K.rowB + 4096u * rb + 64u * (s ^ K.rowK); }
__device__ __forceinline__ unsigned qlo_addr_f(const M2Lane& K, unsigned tq, unsigned ks) { return K.qlB + 4096u * tq + 64u * (ks ^ K.rowK); }
__device__ __forceinline__ unsigned qhi_addr_f(const M2Lane& K, unsigned tq, unsigned ks) { return K.qhB + 4096u * tq + 64u * (ks ^ K.rowK); }
struct M2Stage { v4u q[2], k[2], v[2]; };
__device__ __forceinline__ v4u ldg16(const void* ubase, unsigned toff) { return *(const v4u*)((const char*)ubase + toff); }
template <bool WITH_Q> __device__ __forceinline__ void m2_load(M2Stage& S, const bf16* QK, const bf16* Z, size_t m0c, int h, int tid) {
    const unsigned tq = (unsigned)(((tid >> 4) * 1024 + (tid & 15) * 8) * 2), tz = (unsigned)(((tid >> 4) * NZ + (tid & 15) * 8) * 2);
    const bf16* qb = QK + m0c * 1024 + h * DH; const bf16* zb = Z + m0c * NZ + ZV + h * DH;
#pragma unroll
    for (int i = 0; i < 2; ++i) {
        if (WITH_Q) S.q[i] = ldg16(qb + (size_t)i * 32 * 1024, tq);
        S.k[i] = ldg16(qb + 512 + (size_t)i * 32 * 1024, tq);
        S.v[i] = ldg16(zb + (size_t)i * 32 * NZ, tz); }
}
template <bool WITH_Q> __device__ __forceinline__ void m2_store(const M2Stage& S, LAS unsigned char* L, int buf, int tid) {
    using namespace m2;
    const unsigned o = off_b((unsigned)(tid >> 4), (unsigned)(tid & 15));
#pragma unroll
    for (int i = 0; i < 2; ++i) {
        if (WITH_Q) *(LAS v4u*)(L + QI + i * 8192 + o) = S.q[i];
        *(LAS v4u*)(L + KI0 + buf * 16384 + i * 8192 + o) = S.k[i]; *(LAS v4u*)(L + VI0 + buf * 16384 + i * 8192 + o) = S.v[i]; }
}
__device__ __forceinline__ void m2_update(LAS unsigned char* L, int buf, int c, unsigned lane, const M2Lane& LK, int w, f32x4 (&Dst)[8], f32x4& Dn) {
    using namespace m2;
    const int lr = lane & 15, lg = lane >> 4;
    LAS float* twl = (LAS float*)(L + T_WL); LAS float* so = (LAS float*)(L + T_SOLD);
    bf16x8 yv[2], ya[2];
#pragma unroll
    for (int ks = 0; ks < 2; ++ks) {
        const s16x4 a0 = ds_tr16(L + VI0 + buf * 16384 + tr_addr_f(LK, (unsigned)w, ks, 0)), a1 = ds_tr16(L + VI0 + buf * 16384 + tr_addr_f(LK, (unsigned)w, ks, 1));
        const f32x4 w0 = *(const LAS f32x4*)(twl + c * 64 + 32 * ks + 8 * lg), w1 = *(const LAS f32x4*)(twl + c * 64 + 32 * ks + 8 * lg + 4);
        v4u pv, pa;
        pv.x = pk2(bf2f((unsigned short)a0[0]) * w0[0], bf2f((unsigned short)a0[1]) * w0[1]); pv.y = pk2(bf2f((unsigned short)a0[2]) * w0[2], bf2f((unsigned short)a0[3]) * w0[3]);
        pv.z = pk2(bf2f((unsigned short)a1[0]) * w1[0], bf2f((unsigned short)a1[1]) * w1[1]); pv.w = pk2(bf2f((unsigned short)a1[2]) * w1[2], bf2f((unsigned short)a1[3]) * w1[3]);
        pa.x = pk2(w0[0], w0[1]); pa.y = pk2(w0[2], w0[3]); pa.z = pk2(w1[0], w1[1]); pa.w = pk2(w1[2], w1[3]);
        if (lr != 0) pa = (v4u){0u, 0u, 0u, 0u};
        yv[ks] = __builtin_bit_cast(bf16x8, pv); ya[ks] = __builtin_bit_cast(bf16x8, pa); }
    const float sold = so[c];
#pragma unroll
    for (int j = 0; j < 8; ++j) Dst[j] = Dst[j] * sold;
    Dn = Dn * sold;
#pragma unroll
    for (int jh = 0; jh < 2; ++jh) {
        s16x4 a0[4][2], a1[4][2];
#pragma unroll
        for (int jj = 0; jj < 4; ++jj)
#pragma unroll
            for (int ks = 0; ks < 2; ++ks) { a0[jj][ks] = ds_tr16(L + KI0 + buf * 16384 + tr_addr_f(LK, (unsigned)(4 * jh + jj), ks, 0)); a1[jj][ks] = ds_tr16(L + KI0 + buf * 16384 + tr_addr_f(LK, (unsigned)(4 * jh + jj), ks, 1)); }
        __builtin_amdgcn_sched_barrier(0);
#pragma unroll
        for (int jj = 0; jj < 4; ++jj)
#pragma unroll
            for (int ks = 0; ks < 2; ++ks) { const bf16x8 x = __builtin_shufflevector(a0[jj][ks], a1[jj][ks], 0, 1, 2, 3, 4, 5, 6, 7);
                Dst[4 * jh + jj] = MFMA16(x, yv[ks], Dst[4 * jh + jj]);
                if (4 * jh + jj == w) Dn = MFMA16(x, ya[ks], Dn); }
    }
}

__device__ __forceinline__ void phase_mlstm_x(Ctx& C, int l) {
    using namespace m2;
    const bf16* Z = WSP(bf16, WS_R2); const bf16* QK = WSP(bf16, WS_R4); const float* GT = WSP(float, WS_GATE);
    LAS unsigned char* L = C.lds; const unsigned lane = (unsigned)C.lane; const int w = C.wave, tid = C.tid; (void)l;
    for (int item = C.bid; item < BATCH * NH * 8; item += C.G) {
        const int bh = item >> 3, sg = item & 7, b = bh >> 2, h = bh & 3; const size_t m0 = (size_t)b * SEQ + (size_t)sg * 512;
        __syncthreads();
        m2_tables(C, GT, m0, h);
        M2Stage S; m2_load<false>(S, QK, Z, m0, h, tid);
        __syncthreads();
        const float mfin = m2_chain(C, -1.0e30f);
        m2_store<false>(S, L, 0, tid);
        f32x4 Dst[8], Dn = {0.f, 0.f, 0.f, 0.f};
#pragma unroll
        for (int j = 0; j < 8; ++j) Dst[j] = (f32x4){0.f, 0.f, 0.f, 0.f};
        M2Lane LK = m2_lane(lane);
        __syncthreads();
        for (int c = 0; c < 8; ++c) {
            const int buf = c & 1;
            M2_LAUNDER(LK);
            if (c + 1 < 8) m2_load<false>(S, QK, Z, m0 + (size_t)(c + 1) * 64, h, tid);
            m2_update(L, buf, c, lane, LK, w, Dst, Dn);
            if (c + 1 < 8) m2_store<false>(S, L, buf ^ 1, tid);
            LBAR();
        }
        float* st = (float*)(C.Ap->ws + SEG_STATE + (size_t)item * SEG_ITEM_BYTES);
#pragma unroll
        for (int j = 0; j < 8; ++j) *(f32x4*)((char*)(st + (size_t)(w * 8 + j) * 256) + lane * 16u) = Dst[j];
        *(f32x4*)((char*)(st + 16384 + (size_t)w * 256) + lane * 16u) = Dn;
        if (tid == 0) { LAS float* gc = (LAS float*)(L + T_GC); float G = 0.f;
#pragma unroll
            for (int c = 0; c < 8; ++c) G += gc[c];
            float* sc = (float*)(C.Ap->ws + SEG_SCAL) + (size_t)item * 32; sc[0] = mfin; sc[1] = G; }
    }
}

__device__ __forceinline__ void phase_mlstm_y(Ctx& C, int l) {
    using namespace m2;
    const bf16* Z = WSP(bf16, WS_R2); const bf16* QK = WSP(bf16, WS_R4); const float* GT = WSP(float, WS_GATE); bf16* YC = WSP(bf16, WS_R3);
    LAS unsigned char* L = C.lds; const int w = C.wave, tid0 = C.tid;
    LAS float* tm = (LAS float*)(L + T_M); LAS float* tem = (LAS float*)(L + T_EM); LAS float* tsi = (LAS float*)(L + T_SI); LAS float* trr = (LAS float*)(L + T_R);
    LAS float* stat = (LAS float*)(L + STAT); LAS float* nv = (LAS float*)(L + NV);
    for (int item = C.bid; item < BATCH * NH * 8; item += C.G) {
        const int bh = item >> 3, sg = item & 7, b = bh >> 2, h = bh & 3; const size_t m0 = (size_t)b * SEQ + (size_t)sg * 512;
        __syncthreads();
        m2_tables(C, GT, m0, h);
        float coef[7]; float m_in = 0.f;
        { const float* sc = (const float*)(C.Ap->ws + SEG_SCAL) + (size_t)(bh * 8) * 32;
#pragma unroll
          for (int s2 = 0; s2 < 7; ++s2) { coef[s2] = 0.f;
              if (s2 < sg) { const float ms = sc[s2 * 32], G = sc[s2 * 32 + 1]; const float mn = fmaxf(G + m_in, ms), dec = __expf(G + m_in - mn);
#pragma unroll
                  for (int s3 = 0; s3 < 7; ++s3) if (s3 < s2) coef[s3] *= dec;
                  coef[s2] = __expf(ms - mn); m_in = mn; } } }
        f32x4 Dst[8], Dn = {0.f, 0.f, 0.f, 0.f};
#pragma unroll
        for (int j = 0; j < 8; ++j) Dst[j] = (f32x4){0.f, 0.f, 0.f, 0.f};
        { f32x4 ld[9]; const unsigned lane_c = (unsigned)(tid0 & 63);
#define M2_SEGLOAD(s2_) do { const float* st_ = (const float*)(C.Ap->ws + SEG_STATE + (size_t)(bh * 8 + (s2_)) * SEG_ITEM_BYTES); \
              _Pragma("unroll") for (int j = 0; j < 8; ++j) ld[j] = *(const f32x4*)((const char*)(st_ + (size_t)(w * 8 + j) * 256) + lane_c * 16u); \
              ld[8] = *(const f32x4*)((const char*)(st_ + 16384 + (size_t)w * 256) + lane_c * 16u); } while (0)
          if (sg > 0) M2_SEGLOAD(0);
          for (int s2 = 0; s2 < sg; ++s2) { float cf = coef[0];
#pragma unroll
              for (int s3 = 1; s3 < 7; ++s3) cf = (s2 == s3) ? coef[s3] : cf;
              f32x4 cur[9];
#pragma unroll
              for (int j = 0; j < 9; ++j) cur[j] = ld[j];
              if (s2 + 1 < sg) M2_SEGLOAD(s2 + 1);
#pragma unroll
              for (int j = 0; j < 8; ++j) Dst[j] = Dst[j] + cur[j] * cf;
              Dn = Dn + cur[8] * cf; }
#undef M2_SEGLOAD
        }
        int tid = tid0; asm volatile("" : "+v"(tid));
        const unsigned lane_i = (unsigned)(tid & 63); const int lr_i = (int)(lane_i & 15u), lg_i = (int)(lane_i >> 4);
        const f32x4 gn = *(const f32x4*)(C.Ap->in[I_MG] + (size_t)l * DML + h * DH + 16 * w + 4 * lg_i);
        const unsigned tog = (unsigned)((lr_i * NZ + 4 * lg_i) * 2), tyc = (unsigned)((lr_i * D + 4 * lg_i) * 2);
        const unsigned lane_y = lane_i; M2Lane LK = m2_lane(lane_y);
        unsigned qa0 = off_b(lane_y, 2u * (unsigned)w), qa1 = off_b(lane_y, 2u * (unsigned)w + 1u);
        M2Stage S; m2_load<true>(S, QK, Z, m0, h, tid);
        __syncthreads();
        (void)m2_chain(C, m_in);
        m2_store<true>(S, L, 0, tid);
        if (lr_i == 0) *(LAS f32x4*)(nv + 16 * w + 4 * lg_i) = Dn;
        bf16x8 xin[4];
#pragma unroll
        for (int ks = 0; ks < 4; ++ks) { v4u p; p.x = pk2(Dst[2 * ks][0], Dst[2 * ks][1]); p.y = pk2(Dst[2 * ks][2], Dst[2 * ks][3]); p.z = pk2(Dst[2 * ks + 1][0], Dst[2 * ks + 1][1]); p.w = pk2(Dst[2 * ks + 1][2], Dst[2 * ks + 1][3]); xin[ks] = __builtin_bit_cast(bf16x8, p); }
        __syncthreads();
        const int tt = w >> 1, jt = w & 1;
        for (int c = 0; c < 8; ++c) {
            const int buf = c & 1, par = c & 1; const size_t mc = m0 + (size_t)c * 64;
            M2_LAUNDER(LK);
            unsigned lane = lane_y; asm volatile("" : "+v"(lane), "+v"(qa0), "+v"(qa1));
            const int lr = (int)(lane & 15u), lg = (int)(lane >> 4);
            LAS float* dens = stat + par * (26 * 64); LAS float* nqs = dens + 2 * 64; LAS float* lns = dens + 10 * 64; LAS float* lnq = dens + 18 * 64;
            if (c + 1 < 8) m2_load<true>(S, QK, Z, mc + 64, h, tid);
            v2u og[4];
#pragma unroll
            for (int tq = 0; tq < 4; ++tq) og[tq] = *(const v2u*)((const char*)(Z + (mc + 16 * tq) * NZ + ZO + h * DH + 16 * w) + tog);
            { bf16x8 yq[4], xa[4], xb[4];
#pragma unroll
              for (int s4 = 0; s4 < 4; ++s4) { yq[s4] = *(const LAS bf16x8*)(L + QI + row_addr_f(LK, tt, s4));
                  xa[s4] = *(const LAS bf16x8*)(L + KI0 + buf * 16384 + row_addr_f(LK, 2 * jt, s4)); xb[s4] = *(const LAS bf16x8*)(L + KI0 + buf * 16384 + row_addr_f(LK, 2 * jt + 1, s4)); }
              const int t = 16 * tt + lr, s0a = 32 * jt + 4 * lg, s0b = s0a + 16; const float Mt = tm[c * 64 + t];
              const f32x4 rsa = *(const LAS f32x4*)(trr + c * 64 + s0a), rsb = *(const LAS f32x4*)(trr + c * 64 + s0b);
              const v4u q0 = *(const LAS v4u*)(L + QI + qa0), q1 = *(const LAS v4u*)(L + QI + qa1);
              const f32x4 n0 = *(const LAS f32x4*)(nv + 16 * w), n1 = *(const LAS f32x4*)(nv + 16 * w + 4), n2 = *(const LAS f32x4*)(nv + 16 * w + 8), n3 = *(const LAS f32x4*)(nv + 16 * w + 12);
              __builtin_amdgcn_sched_barrier(0);
              f32x4 acca = {0.f, 0.f, 0.f, 0.f}, accb = {0.f, 0.f, 0.f, 0.f};
#pragma unroll
              for (int s4 = 0; s4 < 4; ++s4) { acca = MFMA16(xa[s4], yq[s4], acca); accb = MFMA16(xb[s4], yq[s4], accb); }
              const float nqp = (bflo(q0.x) * n0[0] + bfhi(q0.x) * n0[1] + bflo(q0.y) * n0[2] + bfhi(q0.y) * n0[3]) + (bflo(q0.z) * n1[0] + bfhi(q0.z) * n1[1] + bflo(q0.w) * n1[2] + bfhi(q0.w) * n1[3])
                              + (bflo(q1.x) * n2[0] + bfhi(q1.x) * n2[1] + bflo(q1.y) * n2[2] + bfhi(q1.y) * n2[3]) + (bflo(q1.z) * n3[0] + bfhi(q1.z) * n3[1] + bflo(q1.w) * n3[2] + bfhi(q1.w) * n3[3]);
              nqs[w * 64 + lane] = nqp;
              float wa[4], wb[4]; float rsum = 0.f;
#pragma unroll
              for (int r = 0; r < 4; ++r) { wa[r] = (s0a + r <= t) ? acca[r] * __expf(fminf(rsa[r] - Mt, 0.f)) : 0.f; wb[r] = (s0b + r <= t) ? accb[r] * __expf(fminf(rsb[r] - Mt, 0.f)) : 0.f; }
              v2u oa, ob; oa.x = pk2(wa[0], wa[1]); oa.y = pk2(wa[2], wa[3]); ob.x = pk2(wb[0], wb[1]); ob.y = pk2(wb[2], wb[3]);
              rsum = (bflo(oa.x) + bfhi(oa.x)) + (bflo(oa.y) + bfhi(oa.y)) + (bflo(ob.x) + bfhi(ob.x)) + (bflo(ob.y) + bfhi(ob.y));
              rsum += __shfl_xor(rsum, 16); rsum += __shfl_xor(rsum, 32);
              if (lg == 0) dens[jt * 64 + t] = rsum;
              *(LAS v2u*)(L + WI + t * WROW + s0a * 2) = oa; *(LAS v2u*)(L + WI + t * WROW + s0b * 2) = ob; }
            LBAR();
            f32x4 hv[4];
            { bf16x8 xv[2];
#pragma unroll
              for (int ks = 0; ks < 2; ++ks) { const s16x4 a0 = ds_tr16(L + VI0 + buf * 16384 + tr_addr_f(LK, (unsigned)w, ks, 0)), a1 = ds_tr16(L + VI0 + buf * 16384 + tr_addr_f(LK, (unsigned)w, ks, 1));
                  xv[ks] = __builtin_shufflevector(a0, a1, 0, 1, 2, 3, 4, 5, 6, 7); }
#pragma unroll
              for (int th = 0; th < 2; ++th) {
                  bf16x8 yw[2][2]; s16x4 ql[2][4], qh[2][4];
#pragma unroll
                  for (int u = 0; u < 2; ++u) { const int tq = 2 * th + u;
#pragma unroll
                      for (int ks = 0; ks < 2; ++ks) yw[u][ks] = *(const LAS bf16x8*)(L + WI + (16 * tq + lr) * WROW + (32 * ks + 8 * lg) * 2);
#pragma unroll
                      for (int ks = 0; ks < 4; ++ks) { ql[u][ks] = *(const LAS s16x4*)(L + QI + qlo_addr_f(LK, tq, ks));
                          qh[u][ks] = *(const LAS s16x4*)(L + QI + qhi_addr_f(LK, tq, ks)); } }
                  __builtin_amdgcn_sched_barrier(0);
#pragma unroll
                  for (int u = 0; u < 2; ++u) { const int tq = 2 * th + u, t = 16 * tq + lr; f32x4 accI = {0.f, 0.f, 0.f, 0.f}, accE = {0.f, 0.f, 0.f, 0.f};
#pragma unroll
                      for (int ks = 0; ks < 2; ++ks) accI = MFMA16(xv[ks], yw[u][ks], accI);
#pragma unroll
                      for (int ks = 0; ks < 4; ++ks) { const bf16x8 y = __builtin_shufflevector(ql[u][ks], qh[u][ks], 0, 1, 2, 3, 4, 5, 6, 7); accE = MFMA16(xin[ks], y, accE); }
                      const float sI = tsi[c * 64 + t]; const float nqt = ((nqs[t] + nqs[64 + t]) + (nqs[128 + t] + nqs[192 + t])) + ((nqs[256 + t] + nqs[320 + t]) + (nqs[384 + t] + nqs[448 + t]));
                      const float den = (dens[t] + dens[64 + t]) + sI * nqt; const float inv = 1.0f / fmaxf(fabsf(den), tem[c * 64 + t]);
                      hv[tq] = (accI + accE * sI) * inv;
                      float s1 = (hv[tq][0] + hv[tq][1]) + (hv[tq][2] + hv[tq][3]), s2 = (hv[tq][0] * hv[tq][0] + hv[tq][1] * hv[tq][1]) + (hv[tq][2] * hv[tq][2] + hv[tq][3] * hv[tq][3]);
                      s1 += __shfl_xor(s1, 16); s1 += __shfl_xor(s1, 32); s2 += __shfl_xor(s2, 16); s2 += __shfl_xor(s2, 32);
                      if (lg == 0) { lns[w * 64 + t] = s1; lnq[w * 64 + t] = s2; } }
              } }
            LBAR();
#pragma unroll
            for (int tq = 0; tq < 4; ++tq) { const int t = 16 * tq + lr;
                const float ls = ((lns[t] + lns[64 + t]) + (lns[128 + t] + lns[192 + t])) + ((lns[256 + t] + lns[320 + t]) + (lns[384 + t] + lns[448 + t]));
                const float lq = ((lnq[t] + lnq[64 + t]) + (lnq[128 + t] + lnq[192 + t])) + ((lnq[256 + t] + lnq[320 + t]) + (lnq[384 + t] + lnq[448 + t]));
                const float mean = ls * (1.0f / DH); const float var = fmaxf(lq * (1.0f / DH) - mean * mean, 0.f); const float rstd = 1.0f / sqrtf(var + LN_EPS);
                const float o0 = bflo(og[tq].x), o1 = bfhi(og[tq].x), o2 = bflo(og[tq].y), o3 = bfhi(og[tq].y);
                const float y0 = sigmoid_f(o0) * ((hv[tq][0] - mean) * rstd * gn[0]), y1 = sigmoid_f(o1) * ((hv[tq][1] - mean) * rstd * gn[1]);
                const float y2 = sigmoid_f(o2) * ((hv[tq][2] - mean) * rstd * gn[2]), y3 = sigmoid_f(o3) * ((hv[tq][3] - mean) * rstd * gn[3]);
                v2u o; o.x = pk2(y0, y1); o.y = pk2(y2, y3);
                *(v2u*)((char*)(YC + (mc + 16 * tq) * D + DPOOL + h * DH + 16 * w) + tyc) = o; }
            LBAR();
            if (c + 1 < 8) {
                m2_update(L, buf, c, lane, LK, w, Dst, Dn);
#pragma unroll
                for (int ks = 0; ks < 4; ++ks) { v4u p; p.x = pk2(Dst[2 * ks][0], Dst[2 * ks][1]); p.y = pk2(Dst[2 * ks][2], Dst[2 * ks][3]); p.z = pk2(Dst[2 * ks + 1][0], Dst[2 * ks + 1][1]); p.w = pk2(Dst[2 * ks + 1][2], Dst[2 * ks + 1][3]); xin[ks] = __builtin_bit_cast(bf16x8, p); }
                if (lr == 0) *(LAS f32x4*)(nv + 16 * w + 4 * lg) = Dn;
                m2_store<true>(S, L, buf ^ 1, tid);
            }
            LBAR();
        }
    }
}

enum { PH_INPROJ = 0, PH_CONV = 1, PH_MLSTM = 2, PH_POOLFIN = 3, PH_OUTPROJ = 4, PH_LN1 = 5, PH_F0 = 6, PH_F1 = 7, PH_F2 = 8, PH_LN2M = 17 };
__global__ void __launch_bounds__(NTHR, 2) fwd(Args args) {
    extern __shared__ __attribute__((aligned(16))) unsigned char lds_raw[];
    const int wave_s = __builtin_amdgcn_readfirstlane((int)(threadIdx.x >> 6));
    { Ctx C = make_ctx(lds_raw, wave_s);
      for (int u = C.tid; u < (LDS_BYTES - MISC_OFF) / 4; u += NTHR) ((LAS unsigned*)(C.lds + MISC_OFF))[u] = 0u;
      __syncthreads();
      (void)xcd_barrier_post((unsigned*)(C.Ap->ws + WS_CTL) + CW_BAR + C.Ap->li * XCD_BAR_WORDS, (volatile LAS unsigned*)(C.lds + MISC_OFF) + 8); }
    const int lo = args.ph_lo, hi = args.ph_hi; (void)args;
#ifndef DUP_MASK
#define DUP_MASK 0
#endif
#define DUPB(bit) ((((DUP_MASK) >> (bit)) & 1) != 0)
#ifndef DUP_N
#define DUP_N 1
#endif
#define REP(bit) for (int rep_ = 0; rep_ < (((DUP_MASK) >> (bit)) & 1) * (DUP_N) + 1; ++rep_)
#define IN(k) (lo <= (k) && (k) < hi)
#define SEAM(k) do { if (hi > (k) + 1) { Ctx Cb = make_ctx(lds_raw, wave_s); XcdBarrier bar; bar.bar = (unsigned*)(Cb.Ap->ws + WS_CTL) + CW_BAR + Cb.Ap->li * XCD_BAR_WORDS; bar.x = xb_xcc_id(); \
        bar.st = (volatile LAS unsigned*)(Cb.lds + MISC_OFF) + 8; xcd_barrier(bar); if (DUPB(15)) xcd_barrier(bar); } } while (0)
#define PHASE(k, body) do { if (IN(k)) { Ctx C = make_ctx(lds_raw, wave_s); { Ctx C = make_ctx(lds_raw, wave_s); body } SEAM(k); } } while (0)

    if (IN(0)) { Ctx C = make_ctx(lds_raw, wave_s); REP(13) phase_prologue(C); SEAM(0); }
#pragma nounroll
    for (int l = 0; l < DEPTH; ++l) {
        const int pb = 1 + l * NPH; const int jj = l >> 1; const bool moe = (l & 1) != 0;
        if (IN(pb + PH_INPROJ)) { Ctx C = make_ctx(lds_raw, wave_s);
            pg8::Gemm g{WSP(bf16, WS_XB), WSP(bf16, WS_WIN) + (size_t)l * NZ * D, M, NZ, D}; pg8::StaticOrder S; S.init(M, NZ, C.G, C.bid);
            REP(0) { pg8::EpiBf16 E{WSP(bf16, WS_R2), NZ, (DUPB(16) && rep_ == 0) ? 1 : 0};
            pg8::gemm_phase<pg8::EpiBf16, pg8::StaticOrder, true, true>(C.lds, g, S, E, C.wave); }
            SEAM(pb + PH_INPROJ);
        }
        if (IN(pb + PH_CONV)) { Ctx C = make_ctx(lds_raw, wave_s); REP(1) { phase_conv(C, l); phase_pool(C, l); } SEAM(pb + PH_CONV); }
        if (IN(pb + PH_MLSTM)) { Ctx C = make_ctx(lds_raw, wave_s); REP(2) phase_mlstm_x(C, l); SEAM(pb + PH_MLSTM); }
        if (IN(pb + PH_POOLFIN)) { Ctx C = make_ctx(lds_raw, wave_s); REP(3) phase_mlstm_y(C, l); if (l == 2) { __syncthreads(); Ctx C2 = make_ctx(lds_raw, wave_s); REP(14) convert_experts(C2, 1); } SEAM(pb + PH_POOLFIN); }
        if (IN(pb + PH_OUTPROJ)) { Ctx C = make_ctx(lds_raw, wave_s);
            pg8::Gemm g{WSP(bf16, WS_R3), WSP(bf16, WS_WOUT) + (size_t)l * D * D, M, D, D}; pg8::StaticOrder S; S.init(M, D, C.G, C.bid);
            pg8::EpiBf16 E{WSP(bf16, WS_T), D};
            REP(4) pg8::gemm_phase<pg8::EpiBf16, pg8::StaticOrder, true, true>(C.lds, g, S, E, C.wave);
            SEAM(pb + PH_OUTPROJ);
        }
        if (!moe) {
            if (IN(pb + PH_LN1)) { Ctx C = make_ctx(lds_raw, wave_s); REP(5) phase_ln1<false>(C, l); SEAM(pb + PH_LN1); }
            if (IN(pb + PH_F0)) { Ctx C = make_ctx(lds_raw, wave_s);
                pg8::Gemm g{WSP(bf16, WS_XB), WSP(bf16, WS_WGU) + (size_t)jj * 2 * FFD * D, M, 2 * FFD, D}; pg8::StaticOrder S; S.init(M, 2 * FFD, C.G, C.bid);
                pg8::EpiSwiGLU8 E{WSP(bf16, WS_R2), FFD, 1.0f, F8_ASC};
                REP(6) pg8::gemm_phase<pg8::EpiSwiGLU8, pg8::StaticOrder, true, true>(C.lds, g, S, E, C.wave);
                SEAM(pb + PH_F0);
            }
            if (IN(pb + PH_F1)) { Ctx C = make_ctx(lds_raw, wave_s);
                pg8::Gemm g{WSP(bf16, WS_R2), (const bf16*)(WSP(unsigned char, WS_WD) + (size_t)jj * D * FFD), M, D, FFD / 2}; pg8::StaticOrder S; S.init(M, D, C.G, C.bid);
                pg8::EpiBf16S E{WSP(bf16, WS_T), D, 1.0f / (F8_DSC * F8_ASC)};
                REP(7) pg8::gemm_phase<pg8::EpiBf16S, pg8::StaticOrder, true, true, 1>(C.lds, g, S, E, C.wave);
                SEAM(pb + PH_F1);
            }
            if (IN(pb + PH_F2)) { Ctx C = make_ctx(lds_raw, wave_s); REP(8) phase_ln2<false>(C, l); SEAM(pb + PH_F2); }
        } else {
            if (IN(pb + PH_LN1)) { Ctx C = make_ctx(lds_raw, wave_s); REP(5) phase_ln1<true>(C, l); SEAM(pb + PH_LN1); }
            if (IN(pb + PH_F0)) { Ctx C = make_ctx(lds_raw, wave_s); REP(9) phase_moe_prep(C); SEAM(pb + PH_F0); }
#pragma nounroll
            for (int p = 0; p < NPASS; ++p) {
                const int rt0 = p * PASS_TILES;
                if (IN(pb + PH_F1 + 2 * p)) { Ctx C = make_ctx(lds_raw, wave_s);
                    const int NT = __builtin_amdgcn_readfirstlane(WSP(int, MOE_META)[0]); int ntp = NT - rt0; if (p + 1 < NPASS) ntp = ntp > PASS_TILES ? PASS_TILES : ntp;
                    if (ntp > 0) {
                        pg8::Gemm g{(const bf16*)(WSP(unsigned char, WS_R3) + (size_t)rt0 * 256 * D), WSP(bf16, WS_EGU), ntp * 256, 2 * FFE, D / 2};
                        pg8::GroupedOrder S; S.init(ntp, 2 * FFE, C.G, C.bid, rt0, WSP(int, MOE_TILE_E));
                        pg8::EpiSwiGLU8 E{WSP(bf16, WS_R2), FFE, 1.0f / (F8_WSC * F8_HSC), F8_ASC};
                        REP(10) pg8::gemm_phase<pg8::EpiSwiGLU8, pg8::GroupedOrder, true, true, 1>(C.lds, g, S, E, C.wave);
                    }
                    SEAM(pb + PH_F1 + 2 * p);
                }
                if (IN(pb + PH_F2 + 2 * p)) { Ctx C = make_ctx(lds_raw, wave_s);
                    const int NT = __builtin_amdgcn_readfirstlane(WSP(int, MOE_META)[0]); int ntp = NT - rt0; if (p + 1 < NPASS) ntp = ntp > PASS_TILES ? PASS_TILES : ntp;
                    if (ntp > 0) {
                        pg8::Gemm g{WSP(bf16, WS_R2), WSP(bf16, WS_ED), ntp * 256, D, FFE / 2}; pg8::GroupedOrder S; S.init(ntp, D, C.G, C.bid, rt0, WSP(int, MOE_TILE_E));
                        pg8::EpiBf16S E{WSP(bf16, WS_R4) + (size_t)rt0 * 256 * D, D, 1.0f / (F8_DSC * F8_ASC)};
                        REP(11) pg8::gemm_phase<pg8::EpiBf16S, pg8::GroupedOrder, true, true, 1>(C.lds, g, S, E, C.wave);
                    }
                    SEAM(pb + PH_F2 + 2 * p);
                }
            }
            if (IN(pb + PH_LN2M)) { Ctx C = make_ctx(lds_raw, wave_s); REP(12) phase_ln2<true>(C, l, (DUPB(12) && rep_ == 0) ? WS_R2 : 0); SEAM(pb + PH_LN2M); }
        }
    }
#undef IN
#undef SEAM
}

static bool phase_exists(int id) { if (id == 0) return true; const int l = (id - 1) / NPH, k = (id - 1) % NPH; return (l & 1) ? true : (k <= PH_F2); }
extern "C" void kernel_launch(void* const* d_in, const int* in_sizes, int n_in, void* d_out, int out_size, void* d_ws, size_t ws_size, hipStream_t stream) {
    static int grid = 0;
    if (grid == 0) {
        if (n_in != 21 || out_size != M * D || ws_size < WS_END) { fprintf(stderr, "kernel_launch: unexpected shapes (n_in %d, out %d, ws %zu)\n", n_in, out_size, ws_size); grid = -1; return; }
        int dev = 0, cus = 0, per_cu = 0;
        if (hipGetDevice(&dev) != hipSuccess || hipDeviceGetAttribute(&cus, hipDeviceAttributeMultiprocessorCount, dev) != hipSuccess) { grid = -1; return; }
        if (hipFuncSetAttribute((const void*)fwd, hipFuncAttributeMaxDynamicSharedMemorySize, LDS_BYTES) != hipSuccess) { fprintf(stderr, "kernel_launch: hipFuncSetAttribute failed\n"); grid = -1; return; }
        if (hipOccupancyMaxActiveBlocksPerMultiprocessor(&per_cu, (const void*)fwd, NTHR, LDS_BYTES) != hipSuccess || per_cu < 1) { fprintf(stderr, "kernel_launch: occupancy query says %d blocks per CU\n", per_cu); (void)hipGetLastError(); if (per_cu < 1) { grid = -1; return; } }
        grid = cus;
    }
    if (grid < 0) return;
    (void)in_sizes;
    if (hipMemsetAsync((char*)d_ws + WS_CTL, 0, CTL_ZERO_BYTES, stream) != hipSuccess) return;
    Args a{};
    for (int i = 0; i < 21; ++i) a.in[i] = (const float*)d_in[i];
    a.out = (float*)d_out; a.ws = (unsigned char*)d_ws; a.pad = 0;
#if MK_ONE_LAUNCH
    a.ph_lo = 0; a.ph_hi = NPHASES; a.li = 0;
    hipLaunchKernelGGL(fwd, dim3(grid), dim3(NTHR), LDS_BYTES, stream, a);
#else
    for (int id = 0; id < NPHASES; ++id) { if (!phase_exists(id)) continue;
        a.ph_lo = id; a.ph_hi = id + 1; a.li = id;
        hipLaunchKernelGGL(fwd, dim3(grid), dim3(NTHR), LDS_BYTES, stream, a); }
#endif
}
```

```cpp
#include <hip/hip_runtime.h>
#include <cstdio>
#include <cstdint>
#ifndef MK_ONE_LAUNCH
#define MK_ONE_LAUNCH 1
#endif
namespace pg8 {
#define PG8_LAS __attribute__((address_space(3)))
typedef unsigned short bf16_t;
typedef short bf16x8 __attribute__((ext_vector_type(8)));
typedef float f32x4 __attribute__((ext_vector_type(4)));
typedef unsigned u32x4 __attribute__((ext_vector_type(4)));
constexpr int BM = 256, BK = 64, HALF = 128, HTB = HALF * BK * 2  , STAGE_BYTES = 8 * HTB, NXCD = 8, WGM = 8;

__host__ __device__ __forceinline__ int lds_byte(int r, int c) { const int st = (r >> 4) * 2 + (c >> 5), rr = r & 15, cc = c & 31, ob = rr * 64 + cc * 2; return st * 1024 + (ob ^ (((ob >> 9) & 1) << 5)); }
__host__ __device__ __forceinline__ void stage_rc(int b, int& R, int& C) { const int st = b / 1024, sb = b % 1024, swz = sb ^ (((sb >> 9) & 1) << 5); R = (st >> 1) * 16 + swz / 64; C = (st & 1) * 32 + (swz % 64) / 2; }
__host__ __device__ __forceinline__ int perm32(int rho) { const int n = rho >> 4, i = rho & 15; return 8 * (i >> 2) + 4 * n + (i & 3); }

struct Unit { int pm, pn, pb; };
struct Gemm { const bf16_t* A; const bf16_t* Bt; int M, N, K; };

struct StaticOrder {
    int nM, nN, nwg, G, c;
    __host__ __device__ void init(int M, int N, int G_, int c_) { nM = M / BM; nN = N / BM; nwg = nM * nN; G = G_; c = c_; }
    __host__ __device__ bool next(int i, Unit& u) const {
        const long L = (long)i * G + c; if (L >= nwg) return false;
        int wgid = (int)L; { const int q = nwg / NXCD, r = nwg % NXCD, xcd = wgid % NXCD, off = wgid / NXCD; wgid = (xcd < r ? xcd * (q + 1) : r * (q + 1) + (xcd - r) * q) + off; }
        const int nig = WGM * nN, gid = wgid / nig, fm = gid * WGM, gsz = (nM - fm) < WGM ? (nM - fm) : WGM;
        u.pm = fm + ((wgid % nig) % gsz); u.pn = (wgid % nig) / gsz; u.pb = u.pn; return true;
    }
    __device__ __forceinline__ void a_ready(const Unit&) const {}
    __device__ __forceinline__ void done(const Unit&) const {}
};
struct GroupedOrder {
    StaticOrder so; int rt0; const int* tile_e;
    __device__ void init(int ntp, int N, int G_, int c_, int rt0_, const int* te) { so.init(ntp * BM, N, G_, c_); rt0 = rt0_; tile_e = te; }
    __device__ bool next(int i, Unit& u) const {
        if (!so.next(i, u)) return false;
        const int e = __builtin_amdgcn_readfirstlane(tile_e[rt0 + u.pm]); u.pb = e * so.nN + u.pn; return true;
    }
    __device__ __forceinline__ void a_ready(const Unit&) const {}
    __device__ __forceinline__ void done(const Unit&) const {}
};

#ifndef PG8_ST_AUX
#define PG8_ST_AUX 0
#endif
#define PG8_RSRC(p) __builtin_amdgcn_make_buffer_rsrc((void*)(p), 0, 0x7fffffff, 0x00020000)
#define PG8_ST128(w, rs, off) __builtin_amdgcn_raw_buffer_store_b128((w), (rs), (off), 0, PG8_ST_AUX)
#define PG8_ST64(w, rs, off) __builtin_amdgcn_raw_buffer_store_b64((w), (rs), (off), 0, PG8_ST_AUX)
__device__ __forceinline__ unsigned cvt_pk_bf16(float lo, float hi) { unsigned r; asm volatile("v_cvt_pk_bf16_f32 %0, %1, %2" : "=v"(r) : "v"(lo), "v"(hi)); return r; }

struct EpiBf16 {
    static constexpr bool PERM = true, AFTER_DRAIN = false;
    bf16_t* O; int ldc; int nostore = 0;
    __device__ __forceinline__ void operator()(const f32x4 (&acc)[2][2][4][2], const Unit& u, int wr, int wc, int fr, int fq) const {
        const int row0 = u.pm * BM + wr * 64 + fr; const int col0 = u.pn * BM + wc * 32 + 8 * fq; const auto rs = PG8_RSRC(O);
#pragma unroll
        for (int ai = 0; ai < 2; ++ai)
#pragma unroll
            for (int m = 0; m < 4; ++m) { const int off = ((row0 + ai * HALF + m * 16) * ldc + col0) * 2;
#pragma unroll
                for (int bj = 0; bj < 2; ++bj) { const f32x4 v0 = acc[ai][bj][m][0], v1 = acc[ai][bj][m][1];
                    u32x4 w; w.x = cvt_pk_bf16(v0[0], v0[1]); w.y = cvt_pk_bf16(v0[2], v0[3]); w.z = cvt_pk_bf16(v1[0], v1[1]); w.w = cvt_pk_bf16(v1[2], v1[3]);
                    if (!nostore || w.x == 0x12345678u) PG8_ST128(w, rs, off + bj * HALF * 2); } }
    }
};
__device__ __forceinline__ float silu_f(float g) { return g * __builtin_amdgcn_rcpf(1.0f + __expf(-g)); }
__device__ __forceinline__ unsigned cvt_fp8x4(float a, float b, float c, float d) {
    a = fminf(fmaxf(a, -448.f), 448.f); b = fminf(fmaxf(b, -448.f), 448.f); c = fminf(fmaxf(c, -448.f), 448.f); d = fminf(fmaxf(d, -448.f), 448.f);
    int r = __builtin_amdgcn_cvt_pk_fp8_f32(a, b, 0, false); r = __builtin_amdgcn_cvt_pk_fp8_f32(c, d, r, true); return (unsigned)r; }
template <bool OUT8> struct EpiSwiGLUT {
    static constexpr bool PERM = true, AFTER_DRAIN = false;
    bf16_t* O; int ldc; float insc = 1.0f; float outsc = 1.0f;
    __device__ __forceinline__ void operator()(const f32x4 (&acc)[2][2][4][2], const Unit& u, int wr, int wc, int fr, int fq) const {
        const int row0 = u.pm * BM + wr * 64 + fr; const int col0 = u.pn * HALF + wc * 32 + 8 * fq;
        const float c1 = -1.4426950408889634f * insc, c2 = insc * insc * outsc; const auto rs = PG8_RSRC(O);
#pragma unroll
        for (int ai = 0; ai < 2; ++ai)
#pragma unroll
            for (int m = 0; m < 4; ++m) {
                const f32x4 g0 = acc[ai][0][m][0], g1 = acc[ai][0][m][1], u0 = acc[ai][1][m][0], u1 = acc[ai][1][m][1];
                const f32x4 t0 = g0 * c1, t1 = g1 * c1; f32x4 d0, d1;
#pragma unroll
                for (int j = 0; j < 4; ++j) { d0[j] = __builtin_amdgcn_exp2f(t0[j]); d1[j] = __builtin_amdgcn_exp2f(t1[j]); }
                d0 = d0 + 1.0f; d1 = d1 + 1.0f;
#pragma unroll
                for (int j = 0; j < 4; ++j) { d0[j] = __builtin_amdgcn_rcpf(d0[j]); d1[j] = __builtin_amdgcn_rcpf(d1[j]); }
                const f32x4 h0 = (g0 * u0) * (d0 * c2), h1 = (g1 * u1) * (d1 * c2);
                if constexpr (OUT8) { typedef unsigned u32x2_ __attribute__((ext_vector_type(2)));
                    u32x2_ w; w.x = cvt_fp8x4(h0[0], h0[1], h0[2], h0[3]); w.y = cvt_fp8x4(h1[0], h1[1], h1[2], h1[3]);
                    PG8_ST64(w, rs, (row0 + ai * HALF + m * 16) * ldc + col0); }
                else {
                    u32x4 w; w.x = cvt_pk_bf16(h0[0], h0[1]); w.y = cvt_pk_bf16(h0[2], h0[3]); w.z = cvt_pk_bf16(h1[0], h1[1]); w.w = cvt_pk_bf16(h1[2], h1[3]);
                    PG8_ST128(w, rs, ((row0 + ai * HALF + m * 16) * ldc + col0) * 2); } }
    }
};
typedef EpiSwiGLUT<false> EpiSwiGLU; typedef EpiSwiGLUT<true> EpiSwiGLU8;
struct EpiBf16S {
    static constexpr bool PERM = true, AFTER_DRAIN = false;
    bf16_t* O; int ldc; float insc;
    __device__ __forceinline__ void operator()(const f32x4 (&acc)[2][2][4][2], const Unit& u, int wr, int wc, int fr, int fq) const {
        const int row0 = u.pm * BM + wr * 64 + fr; const int col0 = u.pn * BM + wc * 32 + 8 * fq; const auto rs = PG8_RSRC(O);
#pragma unroll
        for (int ai = 0; ai < 2; ++ai)
#pragma unroll
            for (int m = 0; m < 4; ++m) { const int off = ((row0 + ai * HALF + m * 16) * ldc + col0) * 2;
#pragma unroll
                for (int bj = 0; bj < 2; ++bj) { const f32x4 v0 = acc[ai][bj][m][0] * insc, v1 = acc[ai][bj][m][1] * insc;
                    u32x4 w; w.x = cvt_pk_bf16(v0[0], v0[1]); w.y = cvt_pk_bf16(v0[2], v0[3]); w.z = cvt_pk_bf16(v1[0], v1[1]); w.w = cvt_pk_bf16(v1[2], v1[3]);
                    PG8_ST128(w, rs, off + bj * HALF * 2); } }
    }
};

template <class Epi, class Sched, bool ALIGN_EPI = false, bool SP2 = false, int DT = 0>
__device__ __forceinline__ void gemm_phase(PG8_LAS unsigned char* lds, const Gemm g, const Sched& S, const Epi& E, int wave_s) {
    int lane_l; asm volatile("v_mbcnt_lo_u32_b32 %0, -1, 0\n\tv_mbcnt_hi_u32_b32 %0, -1, %0" : "=v"(lane_l));
    const int tid_l = wave_s * 64 + lane_l;
    const int tid = tid_l, wid = __builtin_amdgcn_readfirstlane(tid >> 6), lane = tid & 63, wr = wid >> 2, wc = wid & 3, fr = lane & 15, fq = lane >> 4;
    const int K = g.K, nt = K / BK;
    unsigned voffA[2], voffB[2];
#pragma unroll
    for (int i = 0; i < 2; ++i) { int R, C; stage_rc(tid * 16 + i * 8192, R, C); const int Rb = Epi::PERM ? ((R & ~31) + perm32(R & 31)) : R;
        voffA[i] = (unsigned)(R * K + C) * 2u; voffB[i] = (unsigned)(Rb * K + C) * 2u; }
    const size_t kstep = (size_t)(BK * 2);
    const size_t hstep = (size_t)HALF * K * 2;
    const size_t tstep = 2 * hstep;
    const unsigned ldsw = (unsigned)wid * 1024u;
    const int aoff = lds_byte(wr * 64 + fr, fq * 8), boff = lds_byte(wc * 32 + fr, fq * 8);
#define PG8_SA(b, h) (((b) * 2 + (h)) * HTB)
#define PG8_SB(b, h) ((4 + (b) * 2 + (h)) * HTB)
#define PG8_STAGE(bufoff, gbase, voff) do { _Pragma("unroll") for (int _i = 0; _i < 2; ++_i) \
        __builtin_amdgcn_global_load_lds((const unsigned*)((const char*)(gbase) + (voff)[_i]), (PG8_LAS unsigned*)(lds + (bufoff) + ldsw + _i * 8192), 16, 0, 0); } while (0)
#define PG8_LDA(dst, b, h) do { _Pragma("unroll") for (int m = 0; m < 4; ++m) { \
        if constexpr (DT == 1) { const pg8_i4 l0_ = *(const PG8_LAS pg8_i4*)(lds + PG8_SA(b, h) + aoff + m * 2048), l1_ = *(const PG8_LAS pg8_i4*)(lds + PG8_SA(b, h) + aoff + m * 2048 + 1024); dst##8[m] = __builtin_shufflevector(l0_, l1_, 0, 1, 2, 3, 4, 5, 6, 7); } \
        else { _Pragma("unroll") for (int k = 0; k < 2; ++k) dst[m][k] = *(const PG8_LAS bf16x8*)(lds + PG8_SA(b, h) + aoff + m * 2048 + k * 1024); } } } while (0)
#define PG8_LDB(dst, b, h) do { _Pragma("unroll") for (int n = 0; n < 2; ++n) { \
        if constexpr (DT == 1) { const pg8_i4 l0_ = *(const PG8_LAS pg8_i4*)(lds + PG8_SB(b, h) + boff + n * 2048), l1_ = *(const PG8_LAS pg8_i4*)(lds + PG8_SB(b, h) + boff + n * 2048 + 1024); dst##8[n] = __builtin_shufflevector(l0_, l1_, 0, 1, 2, 3, 4, 5, 6, 7); } \
        else { _Pragma("unroll") for (int k = 0; k < 2; ++k) dst[n][k] = *(const PG8_LAS bf16x8*)(lds + PG8_SB(b, h) + boff + n * 2048 + k * 1024); } } } while (0)
#define PG8_MMA(ai, bj, At, Bt) do { __builtin_amdgcn_s_setprio(1); \
        if constexpr (DT == 1) { asm volatile("s_nop 1" ::: ); _Pragma("unroll") for (int m = 0; m < 4; ++m) _Pragma("unroll") for (int n = 0; n < 2; ++n) \
            asm volatile("v_mfma_f32_16x16x128_f8f6f4 %0, %1, %2, %0" : "+v"(acc[ai][bj][m][n]) : "v"(Bt##8[n]), "v"(At##8[m])); } \
        else { _Pragma("unroll") for (int m = 0; m < 4; ++m) _Pragma("unroll") for (int n = 0; n < 2; ++n) _Pragma("unroll") for (int k = 0; k < 2; ++k) \
            acc[ai][bj][m][n] = __builtin_amdgcn_mfma_f32_16x16x32_bf16(Bt[n][k], At[m][k], acc[ai][bj][m][n], 0, 0, 0); } \
        __builtin_amdgcn_s_setprio(0); } while (0)
#define PG8_WAIT_V(n) asm volatile("s_waitcnt vmcnt(" #n ")" ::: "memory")
#define PG8_WAIT_L(n) asm volatile("s_waitcnt lgkmcnt(" #n ")" ::: "memory")
#define PG8_BAR __builtin_amdgcn_s_barrier()
#define PG8_SCHED __builtin_amdgcn_sched_barrier(0)
    Unit cur, nxt; int ui = 0;
    if (!S.next(0, cur)) return;
    f32x4 acc[2][2][4][2];
    float zl_ = 0.f; asm volatile("" : "+v"(zl_));
#pragma unroll
    for (int a = 0; a < 2; ++a)
#pragma unroll
        for (int b = 0; b < 2; ++b)
#pragma unroll
            for (int m = 0; m < 4; ++m)
#pragma unroll
                for (int n = 0; n < 2; ++n) acc[a][b][m][n] = (f32x4){zl_, zl_, zl_, zl_};
    typedef int pg8_i4 __attribute__((ext_vector_type(4))); typedef int pg8_i8 __attribute__((ext_vector_type(8)));
    bf16x8 At[4][2], B0[2][2], B1[2][2]; pg8_i8 At8[4], B08[2], B18[2];
    (void)At; (void)B0; (void)B1; (void)At8; (void)B08; (void)B18;
    const char* cA = (const char*)g.A + (size_t)cur.pm * tstep; const char* cB = (const char*)g.Bt + (size_t)cur.pb * tstep;
    S.a_ready(cur);
    if constexpr (SP2) {
        PG8_STAGE(PG8_SB(0, 0), cB, voffB); PG8_STAGE(PG8_SB(0, 1), cB + hstep, voffB); PG8_STAGE(PG8_SA(0, 0), cA, voffA); PG8_STAGE(PG8_SA(0, 1), cA + hstep, voffA);
        if (wr == 1) PG8_BAR;
        PG8_WAIT_V(2); PG8_BAR;
        PG8_STAGE(PG8_SB(1, 0), cB + kstep, voffB); PG8_STAGE(PG8_SA(1, 0), cA + kstep, voffA); PG8_STAGE(PG8_SB(1, 1), cB + hstep + kstep, voffB);
        PG8_WAIT_V(6); PG8_BAR;
    } else {
        PG8_STAGE(PG8_SB(0, 0), cB, voffB); PG8_STAGE(PG8_SA(0, 0), cA, voffA); PG8_STAGE(PG8_SB(0, 1), cB + hstep, voffB); PG8_STAGE(PG8_SA(0, 1), cA + hstep, voffA);
        if (wr == 1) PG8_BAR;
        PG8_WAIT_V(4); PG8_BAR;
        PG8_STAGE(PG8_SB(1, 0), cB + kstep, voffB); PG8_STAGE(PG8_SA(1, 0), cA + kstep, voffA); PG8_STAGE(PG8_SB(1, 1), cB + hstep + kstep, voffB);
        PG8_WAIT_V(6); PG8_BAR;
    }
    for (;;) {
        const bool has_next = S.next(ui + 1, nxt);
        const char* nA = has_next ? (const char*)g.A + (size_t)nxt.pm * tstep : cA; const char* nB = has_next ? (const char*)g.Bt + (size_t)nxt.pb * tstep : cB;
        for (int t = 0; t < nt; t += 2) {
            const bool last = (t == nt - 2);
            const char* a1 = cA + (size_t)(t + 1) * kstep;
            const char* a2 = last ? nA : cA + (size_t)(t + 2) * kstep; const char* b2 = last ? nB : cB + (size_t)(t + 2) * kstep;
            const char* a3 = a2 + kstep; const char* b3 = b2 + kstep;
            if (last && has_next) S.a_ready(nxt);
            if constexpr (SP2) {
            PG8_LDB(B0, 0, 0); PG8_LDB(B1, 0, 1); PG8_SCHED; PG8_LDA(At, 0, 0); PG8_STAGE(PG8_SA(1, 1), a1 + hstep, voffA);
            PG8_WAIT_V(8); PG8_WAIT_L(0); PG8_BAR; PG8_MMA(0, 0, At, B0); PG8_MMA(0, 1, At, B1); PG8_BAR; PG8_SCHED;
            PG8_LDA(At, 0, 1); PG8_STAGE(PG8_SB(0, 0), b2, voffB); PG8_STAGE(PG8_SB(0, 1), b2 + hstep, voffB); PG8_STAGE(PG8_SA(0, 0), a2, voffA);
            PG8_WAIT_V(8); PG8_WAIT_L(0); PG8_BAR; PG8_MMA(1, 0, At, B0); PG8_MMA(1, 1, At, B1); PG8_BAR; PG8_SCHED;
            PG8_LDB(B0, 1, 0); PG8_LDB(B1, 1, 1); PG8_SCHED; PG8_LDA(At, 1, 0); PG8_STAGE(PG8_SA(0, 1), a2 + hstep, voffA);
            PG8_WAIT_V(8); PG8_WAIT_L(0); PG8_BAR; PG8_MMA(0, 0, At, B0); PG8_MMA(0, 1, At, B1); PG8_BAR; PG8_SCHED;
            PG8_LDA(At, 1, 1); PG8_STAGE(PG8_SB(1, 0), b3, voffB); PG8_STAGE(PG8_SB(1, 1), b3 + hstep, voffB); PG8_STAGE(PG8_SA(1, 0), a3, voffA);
            PG8_WAIT_V(8); PG8_WAIT_L(0); PG8_BAR; PG8_MMA(1, 0, At, B0); PG8_MMA(1, 1, At, B1); PG8_BAR; PG8_SCHED;
            } else {
            PG8_LDB(B0, 0, 0); PG8_SCHED; PG8_LDA(At, 0, 0); PG8_STAGE(PG8_SA(1, 1), a1 + hstep, voffA);
            PG8_WAIT_L(8); PG8_BAR; PG8_WAIT_L(0); PG8_MMA(0, 0, At, B0); PG8_BAR; PG8_SCHED;
            PG8_LDB(B1, 0, 1); PG8_STAGE(PG8_SB(0, 0), b2, voffB);
            PG8_BAR; PG8_WAIT_L(0); PG8_MMA(0, 1, At, B1); PG8_BAR;
            PG8_LDA(At, 0, 1); PG8_STAGE(PG8_SA(0, 0), a2, voffA);
            PG8_BAR; PG8_WAIT_L(0); PG8_MMA(1, 0, At, B0); PG8_BAR; PG8_SCHED;
            PG8_STAGE(PG8_SB(0, 1), b2 + hstep, voffB);
            PG8_WAIT_V(6); PG8_BAR; PG8_MMA(1, 1, At, B1); PG8_BAR;
            PG8_LDB(B0, 1, 0); PG8_SCHED; PG8_LDA(At, 1, 0); PG8_STAGE(PG8_SA(0, 1), a2 + hstep, voffA);
            PG8_WAIT_L(8); PG8_BAR; PG8_WAIT_L(0); PG8_MMA(0, 0, At, B0); PG8_BAR; PG8_SCHED;
            PG8_LDB(B1, 1, 1); PG8_STAGE(PG8_SB(1, 0), b3, voffB);
            PG8_BAR; PG8_WAIT_L(0); PG8_MMA(0, 1, At, B1); PG8_BAR;
            PG8_LDA(At, 1, 1); PG8_STAGE(PG8_SA(1, 0), a3, voffA);
            PG8_BAR; PG8_WAIT_L(0); PG8_MMA(1, 0, At, B0); PG8_BAR; PG8_SCHED;
            PG8_STAGE(PG8_SB(1, 1), b3 + hstep, voffB);
            PG8_WAIT_V(6); PG8_BAR; PG8_MMA(1, 1, At, B1); PG8_BAR;
            }
        }
        if constexpr (DT == 1) asm volatile("s_nop 15\n\ts_nop 15" ::: );
        if constexpr (ALIGN_EPI) { if (wr == 0) PG8_BAR; }
        if constexpr (!Epi::AFTER_DRAIN) { E(acc, cur, wr, wc, fr, fq); S.done(cur); }
        if (!has_next) break;
        float zl2_ = 0.f; asm volatile("" : "+v"(zl2_));
#pragma unroll
        for (int a = 0; a < 2; ++a)
#pragma unroll
            for (int b = 0; b < 2; ++b)
#pragma unroll
                for (int m = 0; m < 4; ++m)
#pragma unroll
                    for (int n = 0; n < 2; ++n) acc[a][b][m][n] = (f32x4){zl2_, zl2_, zl2_, zl2_};
        cur = nxt; cA = nA; cB = nB; ++ui;
        if constexpr (ALIGN_EPI) { if (wr == 1) PG8_BAR; }
    }
    PG8_WAIT_V(0);
    if constexpr (!ALIGN_EPI) { if (wr == 0) PG8_BAR; }
    PG8_BAR;
    if constexpr (Epi::AFTER_DRAIN) { E.fused(acc, cur, wr, wc, fr, fq, lds, wid, lane); S.done(cur); }
#undef PG8_SA
#undef PG8_SB
#undef PG8_STAGE
#undef PG8_LDA
#undef PG8_LDB
#undef PG8_MMA
#undef PG8_WAIT_V
#undef PG8_WAIT_L
#undef PG8_BAR
#undef PG8_SCHED
}
}

constexpr int BATCH = 8, SEQ = 4096, D = 1024, M = BATCH * SEQ, DEPTH = 4;
constexpr int DPOOL = 512, NPG = 4, PGC = 128, DML = 512, NH = 4, DH = 128, CONVW = 4;
constexpr int DIN = 2568, NZ = 2560;
constexpr int ZQ = 512, ZK = 1024, ZV = 1536, ZO = 2048;
constexpr int FFD = 2816, NE = 8, FFE = 3584;
constexpr float ALPHA = 1.6817928305074290f;
constexpr float LN_EPS = 1e-5f;
constexpr float KSCALE = 0.08838834764831845f;
constexpr int NWAVES = 8, NTHR = 512;
constexpr float F8_WSC = 64.0f, F8_HSC = 8.0f, F8_DSC = 256.0f, F8_ASC = 8.0f;
constexpr int MAX_TILES = 2 * M / 256 + NE, PASS_TILES = MAX_TILES, NPASS = 1;
constexpr int NPH = 18, NPHASES = 1 + DEPTH * NPH;

constexpr size_t MiB = 1u << 20;
constexpr size_t WS_CTL = 0, CTL_ZERO_BYTES = 2 * MiB;
constexpr size_t WS_GATE = 2 * MiB;
constexpr size_t WS_PWT = 3 * MiB;
constexpr size_t WS_MOE = 4 * MiB;
constexpr size_t MOE_TOK_E = WS_MOE, MOE_TOK_POS = WS_MOE + 256 * 1024, MOE_TOK_W = WS_MOE + 512 * 1024, MOE_TOK_SLOT = WS_MOE + 768 * 1024,
                 MOE_BLK_CNT = WS_MOE + 1024 * 1024, MOE_TILE_E = MOE_BLK_CNT + 8192, MOE_META = MOE_TILE_E + 4096;
constexpr size_t WS_WIN = 8 * MiB, WS_WOUT = 28 * MiB, WS_WGU = 36 * MiB, WS_WD = 58 * MiB, WS_EGU = 70 * MiB, WS_ED = 182 * MiB;
constexpr size_t WS_T = 238 * MiB;
constexpr size_t WS_XB = 302 * MiB;
constexpr size_t WS_R2 = 366 * MiB;
constexpr size_t WS_R3 = 606 * MiB;
constexpr size_t WS_R4 = 738 * MiB;
constexpr size_t WS_END = 870 * MiB;
constexpr size_t IN_FLOATS = (size_t)M * D + (size_t)DEPTH * D * DIN + 32 + 16384 + 4096 + 262144 + 2048 + 2048 + (size_t)DEPTH * D * D + 4 * 4096 + 3 * (size_t)2 * D * FFD + 16384 + 16 + 3 * (size_t)2 * NE * D * FFE;
static_assert(WS_END <= IN_FLOATS * 4, "workspace map exceeds the guaranteed d_ws size");
static_assert(WS_WIN + (size_t)DEPTH * NZ * D * 2 <= WS_WOUT && WS_WOUT + (size_t)DEPTH * D * D * 2 <= WS_WGU && WS_WGU + (size_t)2 * 2 * FFD * D * 2 <= WS_WD && WS_WD + (size_t)2 * D * FFD * 2 <= WS_EGU, "ws map 1");
static_assert(WS_EGU + (size_t)NE * 2 * FFE * D * 2 <= WS_ED && WS_ED + (size_t)NE * D * FFE * 2 <= WS_T && WS_T + (size_t)M * D * 2 <= WS_XB && WS_XB + (size_t)M * D * 2 <= WS_R2, "ws map 2");
static_assert(WS_R2 + (size_t)M * FFD * 2 <= WS_R3 && WS_R2 + (size_t)M * NZ * 2 <= WS_R3 && WS_R2 + (size_t)MAX_TILES * 256 * FFE <= WS_R3, "ws map 3");
static_assert(WS_R3 + (size_t)(2 * M + NE * 256) * D * 2 <= WS_R4 && WS_R4 + (size_t)(2 * M + NE * 256) * D * 2 <= WS_END && (size_t)M * 1024 * 2 + (size_t)M * 512 * 4 <= WS_END - WS_R4, "ws map 4");
constexpr int CW_BAR = 4096;
constexpr int LDS_BYTES = 147456, RING_BYTES = 131072, MISC_OFF = LDS_BYTES - 256;

#define GAS __attribute__((address_space(1)))
#define LAS __attribute__((address_space(3)))
typedef unsigned short bf16;
typedef unsigned v4u __attribute__((ext_vector_type(4)));
typedef unsigned v2u __attribute__((ext_vector_type(2)));
typedef float f32x4 __attribute__((ext_vector_type(4)));
#define LDS_WAIT() asm volatile("s_waitcnt lgkmcnt(0)" ::: "memory")
__device__ __forceinline__ unsigned f2bf(float f) { unsigned u = __builtin_bit_cast(unsigned, f); return (u + 0x7fffu + ((u >> 16) & 1u)) >> 16; }
typedef __bf16 bf16x2_hw __attribute__((ext_vector_type(2)));
typedef float f32x2_hw __attribute__((ext_vector_type(2)));
__device__ __forceinline__ unsigned pk2(float lo, float hi) { const f32x2_hw v = {lo, hi}; return __builtin_bit_cast(unsigned, __builtin_convertvector(v, bf16x2_hw)); }
__device__ __forceinline__ unsigned f8x4(float a, float b, float c, float d) {
    a = fminf(fmaxf(a, -448.f), 448.f); b = fminf(fmaxf(b, -448.f), 448.f); c = fminf(fmaxf(c, -448.f), 448.f); d = fminf(fmaxf(d, -448.f), 448.f);
    int r = __builtin_amdgcn_cvt_pk_fp8_f32(a, b, 0, false); r = __builtin_amdgcn_cvt_pk_fp8_f32(c, d, r, true); return (unsigned)r; }
__device__ __forceinline__ float bf2f(unsigned short b) { return __builtin_bit_cast(float, (unsigned)b << 16); }
__device__ __forceinline__ float bflo(unsigned w) { return __builtin_bit_cast(float, w << 16); }
__device__ __forceinline__ float bfhi(unsigned w) { return __builtin_bit_cast(float, w & 0xffff0000u); }
__device__ __forceinline__ int lane_id_v() { int l; asm volatile("v_mbcnt_lo_u32_b32 %0, -1, 0\n\tv_mbcnt_hi_u32_b32 %0, -1, %0" : "=v"(l)); return l; }
__device__ __forceinline__ float my_shfl_xor(float v, int o) { const int l = lane_id_v(); return __builtin_bit_cast(float, __builtin_amdgcn_ds_bpermute((l ^ o) << 2, __builtin_bit_cast(int, v))); }
__device__ __forceinline__ float my_shfl_up(float v, int o) { const int l = lane_id_v(); const int s = (l - o) < 0 ? l : (l - o); return __builtin_bit_cast(float, __builtin_amdgcn_ds_bpermute(s << 2, __builtin_bit_cast(int, v))); }
__device__ __forceinline__ int my_shfl_up(int v, int o) { const int l = lane_id_v(); const int s = (l - o) < 0 ? l : (l - o); return __builtin_amdgcn_ds_bpermute(s << 2, v); }
#define __shfl_xor(v, o) my_shfl_xor((v), (o))
#define __shfl_up(v, o) my_shfl_up((v), (o))
__device__ __forceinline__ float wave_sum(float v) {
#pragma unroll
    for (int o = 1; o < 64; o <<= 1) v += __shfl_xor(v, o);
    return v;
}
__device__ __forceinline__ float sigmoid_f(float x) { return 1.0f / (1.0f + __expf(-x)); }
#define XB_TMO      128
#define XB_XCNT(j)  (256  + 64 * (j))
#define XB_XSUB(j)  (1280 + 64 * (j))
#define XB_XGEN(j)  (2304 + 64 * (j))
#define XB_TOP      3328
#define XB_TOPGEN   3392
#define XCD_BAR_WORDS 3456
#define XB_SPIN_CAP (1u << 18)

__device__ __forceinline__ unsigned xb_ld(unsigned* p)              { return __hip_atomic_load(p, __ATOMIC_RELAXED, __HIP_MEMORY_SCOPE_AGENT); }
__device__ __forceinline__ unsigned xb_add(unsigned* p, unsigned v) { return __hip_atomic_fetch_add(p, v, __ATOMIC_RELAXED, __HIP_MEMORY_SCOPE_AGENT); }
__device__ __forceinline__ unsigned xb_xcc_id() { return (unsigned)__builtin_amdgcn_s_getreg((3 << 11) | 20) & 0xFu; }
#define XB_SPIN(cond, bar) do { unsigned _sp = 0; while (cond) { __builtin_amdgcn_s_sleep(1); \
    if ((++_sp & 255u) == 0u) { if (xb_ld(&(bar)[XB_TMO])) break; if (_sp > XB_SPIN_CAP) { atomicAdd(&(bar)[XB_TMO], 1u); break; } } } } while (0)

struct XcdBarrier {
    unsigned* bar; unsigned x;
    volatile LAS unsigned* st;
};

__device__ __forceinline__ XcdBarrier xcd_barrier_post(unsigned* bar, volatile LAS unsigned* st) {
    XcdBarrier b; b.bar = bar; b.x = xb_xcc_id(); b.st = st;
    if (threadIdx.x == 0) (void)xb_add(&bar[XB_XCNT(b.x)], 1u);
    return b;
}
__device__ __forceinline__ void xcd_barrier_complete(unsigned* bar, unsigned x, unsigned& nloc, unsigned& nx) {
    const unsigned G = gridDim.x * gridDim.y * gridDim.z;
    unsigned sum, cnt, mine, sp = 0u;
    for (;;) {
        sum = 0u; cnt = 0u; mine = 0u;
#pragma unroll
        for (unsigned j = 0; j < 16; ++j) { const unsigned c = xb_ld(&bar[XB_XCNT(j)]); sum += c; cnt += (c > 0u) ? 1u : 0u; mine = (j == x) ? c : mine; }
        if (sum == G) break;
        __builtin_amdgcn_s_sleep(1);
        if ((++sp & 255u) == 0u) { if (xb_ld(&bar[XB_TMO])) break; if (sp > XB_SPIN_CAP) { atomicAdd(&bar[XB_TMO], 1u); break; } }
    }
    nloc = mine > 0u ? mine : 1u; nx = cnt > 0u ? cnt : 1u;
}

__device__ __forceinline__ void xcd_barrier(const XcdBarrier& b) {
    asm volatile("s_waitcnt vmcnt(0)" ::: "memory");
    __syncthreads();
    if (threadIdx.x == 0) {
        unsigned* bar = b.bar;
        __builtin_amdgcn_s_waitcnt(0);
        unsigned nloc = b.st[0], nx = b.st[1];
        if (nloc == 0u) { xcd_barrier_complete(bar, b.x, nloc, nx); b.st[0] = nloc; b.st[1] = nx; }
        const unsigned old = xb_add(&bar[XB_XSUB(b.x)], 1u);
        const unsigned gen = old / nloc;
        if (old + 1u == (gen + 1u) * nloc) {
            __builtin_amdgcn_fence(__ATOMIC_RELEASE, "agent");
            asm volatile("s_waitcnt vmcnt(0)" ::: "memory");
            const unsigned og = xb_add(&bar[XB_TOP], 1u);
            const unsigned tgt = (og / nx + 1u) * nx;
            if (og + 1u != tgt) XB_SPIN(xb_ld(&bar[XB_TOP]) < tgt, bar);
            xb_add(&bar[XB_XGEN(b.x)], 1u);
            __builtin_amdgcn_fence(__ATOMIC_ACQUIRE, "agent");
            asm volatile("s_waitcnt vmcnt(0)" ::: "memory");
        } else {
            XB_SPIN(xb_ld(&bar[XB_XGEN(b.x)]) == gen, bar);
            __builtin_amdgcn_fence(__ATOMIC_ACQUIRE, "agent");
            asm volatile("s_waitcnt vmcnt(0)" ::: "memory");
        }
    }
    __syncthreads();
}

struct Args { const float* in[21]; float* out; unsigned char* ws; int ph_lo, ph_hi, li, pad; };
static_assert(sizeof(Args) == 21 * 8 + 8 + 8 + 16, "Args has no padding");
typedef const __attribute__((address_space(4))) Args* ArgsP;
struct Ctx {
    LAS unsigned char* lds; int tid, lane, wave, G, bid;
    ArgsP Ap;
};
__device__ __forceinline__ Ctx make_ctx(unsigned char* lds_raw, int wave_s) {
    const int tid = wave_s * 64 + lane_id_v();
    ArgsP ap = (ArgsP)__builtin_amdgcn_kernarg_segment_ptr(); asm volatile("" : "+s"(ap));
    int G = (int)gridDim.x, bid = (int)blockIdx.x; asm volatile("" : "+s"(G), "+s"(bid));
    Ctx C{(LAS unsigned char*)lds_raw, tid, tid & 63, wave_s, G, bid, ap};
    return C;
}
enum { I_X = 0, I_WIN, I_BG, I_CW, I_CB, I_PW, I_PS, I_MG, I_WOUT, I_L1G, I_L1B, I_L2G, I_L2B, I_WGD, I_WUD, I_WDD, I_WR, I_BR, I_WGE, I_WUE, I_WDE };
#define WSP(T, off) ((T*)(C.Ap->ws + (off)))

template <bool F8 = false> __device__ __forceinline__ void cvt_item(const float* W, int ldw, int K, int k0, int nsrc0, bf16* WT, int drow0, LAS float* scr, int lane, float fsc = 1.0f) {
    f32x4 t[16];
#pragma unroll
    for (int i = 0; i < 16; ++i) t[i] = *(const f32x4*)(W + (size_t)(k0 + (lane >> 4) + 4 * i) * ldw + nsrc0 + 4 * (lane & 15));
#pragma unroll
    for (int i = 0; i < 16; ++i) { LAS float* p = scr + ((lane >> 4) + 4 * i) * 65 + 4 * (lane & 15); p[0] = t[i].x; p[1] = t[i].y; p[2] = t[i].z; p[3] = t[i].w; }
    LDS_WAIT(); asm volatile("" ::: "memory");
    const int c = lane & 7;
#pragma unroll
    for (int j = 0; j < 8; ++j) { const int n = (lane >> 3) + 8 * j; const LAS float* s = scr + (8 * c) * 65 + n;
        if constexpr (F8) { v2u o; o.x = f8x4(s[0 * 65] * fsc, s[1 * 65] * fsc, s[2 * 65] * fsc, s[3 * 65] * fsc); o.y = f8x4(s[4 * 65] * fsc, s[5 * 65] * fsc, s[6 * 65] * fsc, s[7 * 65] * fsc);
            *(v2u*)((unsigned char*)WT + (size_t)(drow0 + n) * K + k0 + 8 * c) = o; }
        else { v4u o; o.x = pk2(s[0 * 65], s[1 * 65]); o.y = pk2(s[2 * 65], s[3 * 65]); o.z = pk2(s[4 * 65], s[5 * 65]); o.w = pk2(s[6 * 65], s[7 * 65]);
            *(v4u*)(WT + (size_t)(drow0 + n) * K + k0 + 8 * c) = o; } }
    LDS_WAIT(); asm volatile("" ::: "memory");
}
template <int MODE, bool F8 = false> __device__ __forceinline__ void cvt_mat(const float* W, int ldw, int K, int ncols, bf16* WT, int item, LAS float* scr, int lane, float fsc = 1.0f) {
    const int nblk = ncols / 64, kb = item / nblk, nb = item % nblk, n0 = 64 * nb;
    const int drow0 = MODE == 0 ? n0 : ((n0 >> 7) * 256 + (n0 & 127) + (MODE == 2 ? 128 : 0));
    cvt_item<F8>(W, ldw, K, 64 * kb, n0, WT, drow0, scr, lane, fsc);
}
constexpr int CVT_SCR = 64 * 65 * 4;
constexpr int IT_WIN = (D / 64) * (NZ / 64), IT_WOUT = (D / 64) * (D / 64), IT_G = (D / 64) * (FFD / 64), IT_DD = (FFD / 64) * (D / 64), IT_EG = (D / 64) * (FFE / 64), IT_ED = (FFE / 64) * (D / 64);
static_assert(8 * CVT_SCR <= MISC_OFF && NZ % 64 == 0 && FFD % 64 == 0 && FFE % 64 == 0, "converter tiles");
__device__ __forceinline__ void convert_experts(Ctx& C, int j) {
    LAS float* scr = (LAS float*)(C.lds + C.wave * CVT_SCR);
    const int gw = C.bid * NWAVES + C.wave, NGW = C.G * NWAVES;
    static_assert(IT_EG == IT_ED, "expert item counts");
    for (int it = gw; it < 3 * NE * IT_EG; it += NGW) {
        const int kind = it / (NE * IT_EG), e = (it / IT_EG) % NE, r = it % IT_EG;
        if (kind == 0) cvt_mat<1, true>(C.Ap->in[I_WGE] + (size_t)(j * NE + e) * D * FFE, FFE, D, FFE, (bf16*)(WSP(unsigned char, WS_EGU) + (size_t)e * 2 * FFE * D), r, scr, C.lane, F8_WSC);
        else if (kind == 1) cvt_mat<2, true>(C.Ap->in[I_WUE] + (size_t)(j * NE + e) * D * FFE, FFE, D, FFE, (bf16*)(WSP(unsigned char, WS_EGU) + (size_t)e * 2 * FFE * D), r, scr, C.lane, F8_WSC);
        else cvt_mat<0, true>(C.Ap->in[I_WDE] + (size_t)(j * NE + e) * FFE * D, D, FFE, D, (bf16*)(WSP(unsigned char, WS_ED) + (size_t)e * D * FFE), r, scr, C.lane, F8_DSC);
    }
}
__device__ __forceinline__ void load_w8(Ctx& C, LAS float* wl, const float* W, int ldw, int coff) {
    for (int k = C.tid; k < D; k += NTHR) { const float* p = W + (size_t)k * ldw + coff;
#pragma unroll
        for (int g = 0; g < 8; ++g) wl[g * 1024 + k] = p[g]; }
}
__device__ __forceinline__ int colof(int j, int lane) { return (j >> 1) * 512 + 8 * lane + (j & 1) * 4; }
__device__ __forceinline__ void load_vec_f32(const float* p, f32x4 (&v)[4], int lane) {
#pragma unroll
    for (int j = 0; j < 4; ++j) v[j] = *(const f32x4*)(p + colof(j, lane));
}
__device__ __forceinline__ void store_row_f32(float* row, const f32x4 (&v)[4], int lane) {
#pragma unroll
    for (int j = 0; j < 4; ++j) *(f32x4*)(row + colof(j, lane)) = v[j];
}
__device__ __forceinline__ void load_row_bf16(const bf16* row, f32x4 (&v)[4], int lane) {
    const v4u a = *(const v4u*)(row + 8 * lane), b = *(const v4u*)(row + 512 + 8 * lane);
    v[0] = (f32x4){bflo(a.x), bfhi(a.x), bflo(a.y), bfhi(a.y)}; v[1] = (f32x4){bflo(a.z), bfhi(a.z), bflo(a.w), bfhi(a.w)};
    v[2] = (f32x4){bflo(b.x), bfhi(b.x), bflo(b.y), bfhi(b.y)}; v[3] = (f32x4){bflo(b.z), bfhi(b.z), bflo(b.w), bfhi(b.w)};
}
__device__ __forceinline__ void store_row_bf16(bf16* row, const f32x4 (&v)[4], int lane) {
    v4u a, b; a.x = pk2(v[0].x, v[0].y); a.y = pk2(v[0].z, v[0].w); a.z = pk2(v[1].x, v[1].y); a.w = pk2(v[1].z, v[1].w);
    b.x = pk2(v[2].x, v[2].y); b.y = pk2(v[2].z, v[2].w); b.z = pk2(v[3].x, v[3].y); b.w = pk2(v[3].z, v[3].w);
    *(v4u*)(row + 8 * lane) = a; *(v4u*)(row + 512 + 8 * lane) = b;
}
__device__ __forceinline__ void load_row_res(const bf16* trow, const bf16* xrow, f32x4 (&v)[4], int lane) {
    f32x4 t[4], x[4]; load_row_bf16(trow, t, lane); load_row_bf16(xrow, x, lane);
#pragma unroll
    for (int j = 0; j < 4; ++j) v[j] = x[j] * ALPHA + t[j];
}
__device__ __forceinline__ float dot8(const f32x4 (&v)[4], const LAS float* wl, int lane) {
    float a[8];
#pragma unroll
    for (int g = 0; g < 8; ++g) { float s = 0.f;
#pragma unroll
        for (int j = 0; j < 4; ++j) { const f32x4 w = *(const LAS f32x4*)(wl + g * 1024 + colof(j, lane)); s += (v[j].x * w.x + v[j].y * w.y) + (v[j].z * w.z + v[j].w * w.w); }
        a[g] = s; }
    float b4[4], b2[2], b1;
    { const bool hi = (lane & 32) != 0;
#pragma unroll
      for (int i = 0; i < 4; ++i) { const float keep = hi ? a[i + 4] : a[i], send = hi ? a[i] : a[i + 4]; b4[i] = keep + __shfl_xor(send, 32); } }
    { const bool hi = (lane & 16) != 0;
#pragma unroll
      for (int i = 0; i < 2; ++i) { const float keep = hi ? b4[i + 2] : b4[i], send = hi ? b4[i] : b4[i + 2]; b2[i] = keep + __shfl_xor(send, 16); } }
    { const bool hi = (lane & 8) != 0; const float keep = hi ? b2[1] : b2[0], send = hi ? b2[0] : b2[1]; b1 = keep + __shfl_xor(send, 8); }
    b1 += __shfl_xor(b1, 4); b1 += __shfl_xor(b1, 2); b1 += __shfl_xor(b1, 1);
    return b1;
}
__device__ __forceinline__ void write_gates(Ctx& C, int lnext, int m, const f32x4 (&v)[4], const LAS float* wl) {
    const float val = dot8(v, wl, C.lane);
    if ((C.lane & 7) == 0) WSP(float, WS_GATE)[(size_t)m * 8 + (C.lane >> 3)] = val + C.Ap->in[I_BG][lnext * 8 + (C.lane >> 3)];
}

__device__ __forceinline__ void phase_prologue(Ctx& C) {
    LAS float* scr = (LAS float*)(C.lds + C.wave * CVT_SCR);
    const int gw = C.bid * NWAVES + C.wave, NGW = C.G * NWAVES;
    constexpr int IT_PW = (PGC / 64) * (PGC / 64);
    constexpr int NI = 4 * IT_WIN + 4 * IT_WOUT + 4 * IT_G + 2 * IT_DD + DEPTH * NPG * IT_PW;
    for (int it = gw; it < NI; it += NGW) {
        int r = it;
        if (r < 4 * IT_WIN) { const int l = r / IT_WIN; cvt_mat<0>(C.Ap->in[I_WIN] + (size_t)l * D * DIN, DIN, D, NZ, WSP(bf16, WS_WIN) + (size_t)l * NZ * D, r % IT_WIN, scr, C.lane); continue; } r -= 4 * IT_WIN;
        if (r < 4 * IT_WOUT) { const int l = r / IT_WOUT; cvt_mat<0>(C.Ap->in[I_WOUT] + (size_t)l * D * D, D, D, D, WSP(bf16, WS_WOUT) + (size_t)l * D * D, r % IT_WOUT, scr, C.lane); continue; } r -= 4 * IT_WOUT;
        if (r < 2 * IT_G) { const int j = r / IT_G; cvt_mat<1>(C.Ap->in[I_WGD] + (size_t)j * D * FFD, FFD, D, FFD, WSP(bf16, WS_WGU) + (size_t)j * 2 * FFD * D, r % IT_G, scr, C.lane); continue; } r -= 2 * IT_G;
        if (r < 2 * IT_G) { const int j = r / IT_G; cvt_mat<2>(C.Ap->in[I_WUD] + (size_t)j * D * FFD, FFD, D, FFD, WSP(bf16, WS_WGU) + (size_t)j * 2 * FFD * D, r % IT_G, scr, C.lane); continue; } r -= 2 * IT_G;
        if (r < 2 * IT_DD) { const int j = r / IT_DD; cvt_mat<0, true>(C.Ap->in[I_WDD] + (size_t)j * FFD * D, D, FFD, D, (bf16*)(WSP(unsigned char, WS_WD) + (size_t)j * D * FFD), r % IT_DD, scr, C.lane, F8_DSC); continue; } r -= 2 * IT_DD;
        { const int lg = r / IT_PW; cvt_mat<0>(C.Ap->in[I_PW] + (size_t)lg * PGC * PGC, PGC, PGC, PGC, WSP(bf16, WS_PWT) + (size_t)lg * PGC * PGC, r % IT_PW, scr, C.lane); }
    }
    convert_experts(C, 0);
    __syncthreads();
    LAS float* wl = (LAS float*)C.lds;
    load_w8(C, wl, C.Ap->in[I_WIN], DIN, NZ);
    __syncthreads();
    for (int m = gw; m < M; m += NGW) {
        f32x4 v[4]; load_vec_f32(C.Ap->in[I_X] + (size_t)m * D, v, C.lane);
        store_row_bf16(WSP(bf16, WS_XB) + (size_t)m * D, v, C.lane);
        write_gates(C, 0, m, v, wl);
    }
}

__device__ __forceinline__ void phase_conv(Ctx& C, int l) {
    const bf16* Z = WSP(bf16, WS_R2); bf16* QK = WSP(bf16, WS_R4);
    const int c8 = (C.tid & 127) * 8; const float sc = c8 >= 512 ? KSCALE : 1.0f;
    const float* cw = C.Ap->in[I_CW] + (size_t)l * CONVW * 1024 + c8; const float* cb = C.Ap->in[I_CB] + (size_t)l * 1024 + c8;
    float w[CONVW][8], bias[8];
#pragma unroll
    for (int j = 0; j < CONVW; ++j) { const f32x4 a = *(const f32x4*)(cw + j * 1024), b2 = *(const f32x4*)(cw + j * 1024 + 4);
        w[j][0] = a.x; w[j][1] = a.y; w[j][2] = a.z; w[j][3] = a.w; w[j][4] = b2.x; w[j][5] = b2.y; w[j][6] = b2.z; w[j][7] = b2.w; }
    { const f32x4 a = *(const f32x4*)cb, b2 = *(const f32x4*)(cb + 4); bias[0] = a.x; bias[1] = a.y; bias[2] = a.z; bias[3] = a.w; bias[4] = b2.x; bias[5] = b2.y; bias[6] = b2.z; bias[7] = b2.w; }
    const int tg0 = C.bid * (NTHR / 128) + (C.tid >> 7), TGS = C.G * (NTHR / 128);
    for (int tg = tg0; tg < M / 4; tg += TGS) {
        const int m0 = tg * 4, t0 = m0 & (SEQ - 1);
        v4u zr[7];
#pragma unroll
        for (int r = 0; r < 7; ++r) { zr[r] = (v4u){0u, 0u, 0u, 0u}; if (t0 - 3 + r >= 0) zr[r] = *(const v4u*)(Z + (size_t)(m0 - 3 + r) * NZ + ZQ + c8); }
#pragma unroll
        for (int i = 0; i < 4; ++i) { float a[8];
#pragma unroll
            for (int e = 0; e < 8; ++e) a[e] = bias[e];
#pragma unroll
            for (int j = 0; j < CONVW; ++j) { const v4u zz = zr[i + j];
                a[0] += w[j][0] * bflo(zz.x); a[1] += w[j][1] * bfhi(zz.x); a[2] += w[j][2] * bflo(zz.y); a[3] += w[j][3] * bfhi(zz.y);
                a[4] += w[j][4] * bflo(zz.z); a[5] += w[j][5] * bfhi(zz.z); a[6] += w[j][6] * bflo(zz.w); a[7] += w[j][7] * bfhi(zz.w); }
#pragma unroll
            for (int e = 0; e < 8; ++e) a[e] = a[e] * sigmoid_f(a[e]) * sc;
            v4u o; o.x = pk2(a[0], a[1]); o.y = pk2(a[2], a[3]); o.z = pk2(a[4], a[5]); o.w = pk2(a[6], a[7]);
            *(v4u*)(QK + (size_t)(m0 + i) * 1024 + c8) = o; }
    }
}

__device__ __forceinline__ void phase_pool(Ctx& C, int l) {
    typedef short bf16x8 __attribute__((ext_vector_type(8)));
    const bf16* Z = WSP(bf16, WS_R2); bf16* YC = WSP(bf16, WS_R3); const bf16* PWT = WSP(bf16, WS_PWT) + (size_t)l * NPG * PGC * PGC;
    constexpr int UROW = 272, DOFF = 80 * UROW, USZ = DOFF + 64 * UROW;
    static_assert(2 * USZ <= MISC_OFF, "pool LDS");
    LAS unsigned char* L = C.lds;
    const int tid = C.tid, lane = C.lane, w = C.wave, lr = lane & 15, lg = lane >> 4;
    const int NU = (M / 64) * NPG;
    int gprev[2] = {-1, -1}; bf16x8 xw[2][4]; f32x4 sc[2];
#pragma unroll
    for (int s = 0; s < 2; ++s) { sc[s] = (f32x4){0.f, 0.f, 0.f, 0.f};
#pragma unroll
        for (int ks = 0; ks < 4; ++ks) xw[s][ks] = (bf16x8){0, 0, 0, 0, 0, 0, 0, 0}; }
    v4u pu[2][3];
#define PL_LOAD(s_, u_) do { if ((u_) < NU) { const int g_ = (u_) & 3, m0_ = ((u_) >> 2) * 64, t0_ = m0_ & (SEQ - 1); _Pragma("unroll") for (int i_ = 0; i_ < 3; ++i_) { const int p_ = tid + NTHR * i_, r_ = p_ >> 4, ch_ = p_ & 15; \
        pu[s_][i_] = (v4u){0u, 0u, 0u, 0u}; if (r_ < 79 && t0_ - 15 + r_ >= 0) pu[s_][i_] = *(const v4u*)(Z + (size_t)(m0_ - 15 + r_) * NZ + g_ * PGC + ch_ * 8); } } } while (0)
#define PL_STORE(s_) do { _Pragma("unroll") for (int i_ = 0; i_ < 3; ++i_) { const int p_ = tid + NTHR * i_, r_ = p_ >> 4, ch_ = p_ & 15; if (r_ < 79) *(LAS v4u*)(L + (s_) * USZ + r_ * UROW + ch_ * 16) = pu[s_][i_]; } } while (0)
    PL_LOAD(0, C.bid); PL_LOAD(1, C.bid + C.G);
    for (int u0 = C.bid; u0 < NU; u0 += 2 * C.G) {
        const int nu = (u0 + C.G < NU) ? 2 : 1;
        __syncthreads();
        PL_STORE(0); if (nu > 1) PL_STORE(1);
#pragma unroll
        for (int s = 0; s < 2; ++s) { const int g = (u0 + s * C.G) & 3;
            if (s < nu && g != gprev[s]) { gprev[s] = g;
#pragma unroll
                for (int ks = 0; ks < 4; ++ks) xw[s][ks] = *(const bf16x8*)(PWT + (size_t)(g * PGC + 16 * w + lr) * PGC + 32 * ks + 8 * lg);
                sc[s] = *(const f32x4*)(C.Ap->in[I_PS] + (size_t)l * DPOOL + g * PGC + 16 * w + 4 * lg); } }
        __syncthreads();
        PL_LOAD(0, u0 + 2 * C.G); PL_LOAD(1, u0 + 3 * C.G);
#pragma unroll
        for (int s = 0; s < 2; ++s) if (s < nu) { const int u = u0 + s * C.G, g = u & 3, t0 = ((u >> 2) * 64) & (SEQ - 1);
          LAS unsigned char* Ls = L + s * USZ;
          const int cp = tid & 63, r0 = 8 * w, wn = 2 << g;
          float s0 = 0.f, s1 = 0.f;
          for (int j = 0; j < wn; ++j) { const unsigned x = *(const LAS unsigned*)(Ls + (r0 + 15 - j) * UROW + cp * 4); s0 += bflo(x); s1 += bfhi(x); }
#pragma unroll
          for (int i = 0; i < 8; ++i) { const int r = r0 + i, t = t0 + r;
              const unsigned xc = *(const LAS unsigned*)(Ls + (r + 15) * UROW + cp * 4);
              if (i > 0) { const unsigned xo = *(const LAS unsigned*)(Ls + (r + 15 - wn) * UROW + cp * 4); s0 += bflo(xc) - bflo(xo); s1 += bfhi(xc) - bfhi(xo); }
              const float inv = 1.0f / (float)((t + 1) < wn ? (t + 1) : wn);
              *(LAS unsigned*)(Ls + DOFF + r * UROW + cp * 4) = pk2(s0 * inv - bflo(xc), s1 * inv - bfhi(xc)); } }
        __syncthreads();
#pragma unroll
        for (int s = 0; s < 2; ++s) if (s < nu) { const int u = u0 + s * C.G, g = u & 3, m0 = (u >> 2) * 64;
#pragma unroll
          for (int rt = 0; rt < 4; ++rt) { f32x4 acc = {0.f, 0.f, 0.f, 0.f};
#pragma unroll
            for (int ks = 0; ks < 4; ++ks) { const bf16x8 y = *(const LAS bf16x8*)(L + s * USZ + DOFF + (16 * rt + lr) * UROW + (32 * ks + 8 * lg) * 2); acc = __builtin_amdgcn_mfma_f32_16x16x32_bf16(xw[s][ks], y, acc, 0, 0, 0); }
            acc = acc * sc[s]; v2u o; o.x = pk2(acc[0], acc[1]); o.y = pk2(acc[2], acc[3]);
            *(v2u*)(YC + (size_t)(m0 + 16 * rt + lr) * D + g * PGC + 16 * w + 4 * lg) = o; } }
    }
#undef PL_LOAD
#undef PL_STORE
}

__device__ __forceinline__ void ln_apply(f32x4 (&v)[4], const f32x4 (&g)[4], const f32x4 (&b)[4]) {
    float s = 0.f;
#pragma unroll
    for (int j = 0; j < 4; ++j) s += (v[j].x + v[j].y) + (v[j].z + v[j].w);
    const float mean = wave_sum(s) * (1.0f / D); float s2 = 0.f;
#pragma unroll
    for (int j = 0; j < 4; ++j) { v[j] = v[j] - mean; s2 += (v[j].x * v[j].x + v[j].y * v[j].y) + (v[j].z * v[j].z + v[j].w * v[j].w); }
    const float rstd = 1.0f / sqrtf(wave_sum(s2) * (1.0f / D) + LN_EPS);
#pragma unroll
    for (int j = 0; j < 4; ++j) v[j] = v[j] * rstd * g[j] + b[j];
}

template <bool MOE> __device__ __forceinline__ void phase_ln1(Ctx& C, int l) {
    const bf16* T = WSP(bf16, WS_T); bf16* XB = WSP(bf16, WS_XB);
    f32x4 g[4], b[4]; load_vec_f32(C.Ap->in[I_L1G] + (size_t)l * D, g, C.lane); load_vec_f32(C.Ap->in[I_L1B] + (size_t)l * D, b, C.lane);
    if constexpr (!MOE) {
        const int gw = C.bid * NWAVES + C.wave, NGW = C.G * NWAVES;
        f32x4 v[4]; if (gw < M) load_row_res(T + (size_t)gw * D, XB + (size_t)gw * D, v, C.lane);
        for (int m = gw; m < M; m += NGW) {
            f32x4 vn[4]; if (m + NGW < M) load_row_res(T + (size_t)(m + NGW) * D, XB + (size_t)(m + NGW) * D, vn, C.lane);
            ln_apply(v, g, b);
            store_row_bf16(XB + (size_t)m * D, v, C.lane);
#pragma unroll
            for (int j = 0; j < 4; ++j) v[j] = vn[j];
        }
    } else {
        const int jm = l >> 1;
        LAS float* wl = (LAS float*)C.lds;
        LAS int* sel = (LAS int*)(C.lds + 32768);
        LAS int* cnth = sel + 128;
        int* tok_e = WSP(int, MOE_TOK_E); int* tok_pos = WSP(int, MOE_TOK_POS); float* tok_w = WSP(float, MOE_TOK_W); int* blk_cnt = WSP(int, MOE_BLK_CNT);
        load_w8(C, wl, C.Ap->in[I_WR] + (size_t)jm * D * NE, NE, 0);
        __syncthreads();
        const float brl = C.Ap->in[I_BR][jm * NE + (C.lane >> 3)];
        for (int rg = C.bid; rg < M / 128; rg += C.G) {
            f32x4 v[4]; load_row_res(T + (size_t)(rg * 128 + C.wave * 16) * D, XB + (size_t)(rg * 128 + C.wave * 16) * D, v, C.lane);
            for (int i = 0; i < 16; ++i) {
                const int rl = C.wave * 16 + i, m = rg * 128 + rl;
                f32x4 vn[4]; if (i + 1 < 16) load_row_res(T + (size_t)(m + 1) * D, XB + (size_t)(m + 1) * D, vn, C.lane);
                ln_apply(v, g, b);
                store_row_bf16(XB + (size_t)m * D, v, C.lane);
                const float lgt = dot8(v, wl, C.lane) + brl;
                float lg[8];
#pragma unroll
                for (int e = 0; e < 8; ++e) lg[e] = __builtin_bit_cast(float, __builtin_amdgcn_readlane(__builtin_bit_cast(int, lgt), 8 * e));
                int e0 = 0; float v0 = lg[0];
#pragma unroll
                for (int e = 1; e < 8; ++e) if (lg[e] > v0) { v0 = lg[e]; e0 = e; }
                int e1 = -1; float v1 = -3.0e38f;
#pragma unroll
                for (int e = 0; e < 8; ++e) if (e != e0 && lg[e] > v1) { v1 = lg[e]; e1 = e; }
                const float ex = __expf(v1 - v0), w0 = 1.0f / (1.0f + ex), w1 = ex * w0;
                if (C.lane == 0) { sel[rl] = e0 | (e1 << 8); tok_w[(size_t)m * 2] = w0; tok_w[(size_t)m * 2 + 1] = w1; }
#pragma unroll
                for (int j = 0; j < 4; ++j) v[j] = vn[j];
            }
            __syncthreads();
            int e0 = 0, e1 = 0, pos0 = 0, pos1 = 0;
            if (C.tid < 128) {
                const int s = sel[C.tid]; e0 = s & 255; e1 = s >> 8;
                const unsigned long long lt = (1ull << C.lane) - 1ull;
                int cnt8[8];
#pragma unroll
                for (int e = 0; e < 8; ++e) { const unsigned long long m0 = __ballot(e0 == e), m1 = __ballot(e1 == e);
                    if (e0 == e) pos0 = __popcll(m0 & lt); if (e1 == e) pos1 = __popcll(m0) + __popcll(m1 & lt);
                    cnt8[e] = __popcll(m0) + __popcll(m1); }
                if (C.lane == 0) {
#pragma unroll
                    for (int e = 0; e < 8; ++e) cnth[C.wave * 8 + e] = cnt8[e]; }
            }
            __syncthreads();
            if (C.tid < 128) {
                if (C.wave == 1) { pos0 += cnth[e0]; pos1 += cnth[e1]; }
                const int m = rg * 128 + C.tid;
                tok_e[(size_t)m * 2] = e0; tok_e[(size_t)m * 2 + 1] = e1; tok_pos[(size_t)m * 2] = pos0; tok_pos[(size_t)m * 2 + 1] = pos1;
                if (C.tid < 8) blk_cnt[rg * 8 + C.tid] = cnth[C.tid] + cnth[8 + C.tid];
            }
            __syncthreads();
        }
    }
}

__device__ __forceinline__ void phase_moe_prep(Ctx& C) {
    LAS int* cin = (LAS int*)C.lds;
    LAS int* off = cin + 2048;
    LAS int* tot = off + 2048;
    LAS int* base = tot + 8;
    const int* blk_cnt = WSP(int, MOE_BLK_CNT); const int* tok_e = WSP(int, MOE_TOK_E); const int* tok_pos = WSP(int, MOE_TOK_POS);
    int* tok_slot = WSP(int, MOE_TOK_SLOT); int* tile_e = WSP(int, MOE_TILE_E); int* meta = WSP(int, MOE_META);
    for (int i = C.tid; i < 2048; i += NTHR) cin[i] = blk_cnt[i];
    __syncthreads();
    { const int e = C.wave, i = C.lane;
      const int s0 = cin[(4 * i) * 8 + e], s1 = cin[(4 * i + 1) * 8 + e], s2 = cin[(4 * i + 2) * 8 + e], s3 = cin[(4 * i + 3) * 8 + e];
      const int t = s0 + s1 + s2 + s3; int inc = t;
#pragma unroll
      for (int o = 1; o < 64; o <<= 1) { const int y = __shfl_up(inc, o); if (i >= o) inc += y; }
      const int ex = inc - t;
      off[(4 * i) * 8 + e] = ex; off[(4 * i + 1) * 8 + e] = ex + s0; off[(4 * i + 2) * 8 + e] = ex + s0 + s1; off[(4 * i + 3) * 8 + e] = ex + s0 + s1 + s2;
      if (i == 63) tot[e] = inc; }
    __syncthreads();
    if (C.tid == 0) { int bs = 0;
        for (int e = 0; e < 8; ++e) { base[e] = bs; bs += ((tot[e] + 255) >> 8) << 8; }
        base[8] = bs;
        if (C.bid == 0) meta[0] = bs >> 8; }
    __syncthreads();
    if (C.bid == 0) { const int nt = base[8] >> 8;
        for (int rt = C.tid; rt < nt; rt += NTHR) { int e = 0;
#pragma unroll
            for (int k = 1; k < 8; ++k) e += (rt >= (base[k] >> 8)) ? 1 : 0;
            tile_e[rt] = e; } }
    const int gw = C.bid * NWAVES + C.wave, NGW = C.G * NWAVES;
    const bf16* XB = WSP(bf16, WS_XB); unsigned char* HS = WSP(unsigned char, WS_R3);
    for (int m = gw; m < M; m += NGW) {
        const int rg = m >> 7;
        const v4u r0 = *(const v4u*)(XB + (size_t)m * D + 16 * C.lane), r1 = *(const v4u*)(XB + (size_t)m * D + 16 * C.lane + 8);
        v4u o;
        o.x = f8x4(bflo(r0.x) * F8_HSC, bfhi(r0.x) * F8_HSC, bflo(r0.y) * F8_HSC, bfhi(r0.y) * F8_HSC); o.y = f8x4(bflo(r0.z) * F8_HSC, bfhi(r0.z) * F8_HSC, bflo(r0.w) * F8_HSC, bfhi(r0.w) * F8_HSC);
        o.z = f8x4(bflo(r1.x) * F8_HSC, bfhi(r1.x) * F8_HSC, bflo(r1.y) * F8_HSC, bfhi(r1.y) * F8_HSC); o.w = f8x4(bflo(r1.z) * F8_HSC, bfhi(r1.z) * F8_HSC, bflo(r1.w) * F8_HSC, bfhi(r1.w) * F8_HSC);
#pragma unroll
        for (int k = 0; k < 2; ++k) {
            const int e = tok_e[(size_t)m * 2 + k], pos = tok_pos[(size_t)m * 2 + k];
            const int slot = base[e] + off[rg * 8 + e] + pos;
            *(v4u*)(HS + (size_t)slot * D + 16 * C.lane) = o;
            if (C.lane == 0) tok_slot[(size_t)m * 2 + k] = slot;
        }
    }
}

template <bool MOE> __device__ __forceinline__ void phase_ln2(Ctx& C, int l, size_t dummy_off = 0) {
    const bf16* T = WSP(bf16, WS_T); bf16* XB = WSP(bf16, WS_XB); bf16* XBo = dummy_off ? (bf16*)(C.Ap->ws + dummy_off) : XB;
    float* outf = dummy_off ? (float*)(C.Ap->ws + dummy_off) : C.Ap->out;
    LAS float* wl = (LAS float*)C.lds;
    if (l + 1 < DEPTH) { load_w8(C, wl, C.Ap->in[I_WIN] + (size_t)(l + 1) * D * DIN, DIN, NZ); }
    __syncthreads();
    f32x4 g[4], b[4]; load_vec_f32(C.Ap->in[I_L2G] + (size_t)l * D, g, C.lane); load_vec_f32(C.Ap->in[I_L2B] + (size_t)l * D, b, C.lane);
    const int gw = C.bid * NWAVES + C.wave, NGW = C.G * NWAVES;
    const bf16* Y2 = WSP(bf16, WS_R4); const int* tok_slot = WSP(int, MOE_TOK_SLOT); const float* tok_w = WSP(float, MOE_TOK_W);
    struct Raw { v4u a[2], b[2], c[2]; };
    struct Idx { int s0, s1; float w0, w1; };
    auto ld_idx = [&](int m, Idx& I) { if constexpr (MOE) { const v2u s = *(const v2u*)(tok_slot + (size_t)m * 2); const f32x2_hw w = *(const f32x2_hw*)(tok_w + (size_t)m * 2); I.s0 = (int)s.x; I.s1 = (int)s.y; I.w0 = w[0]; I.w1 = w[1]; } };
    auto ld_raw = [&](int m, const Idx& I, Raw& R) {
        const bf16* xr = XB + (size_t)m * D; R.a[0] = *(const v4u*)(xr + 8 * C.lane); R.a[1] = *(const v4u*)(xr + 512 + 8 * C.lane);
        if constexpr (MOE) { const bf16* p0 = Y2 + (size_t)I.s0 * D; const bf16* p1 = Y2 + (size_t)I.s1 * D;
            R.b[0] = *(const v4u*)(p0 + 8 * C.lane); R.b[1] = *(const v4u*)(p0 + 512 + 8 * C.lane); R.c[0] = *(const v4u*)(p1 + 8 * C.lane); R.c[1] = *(const v4u*)(p1 + 512 + 8 * C.lane); }
        else { const bf16* tr = T + (size_t)m * D; R.b[0] = *(const v4u*)(tr + 8 * C.lane); R.b[1] = *(const v4u*)(tr + 512 + 8 * C.lane); } };
    auto unp = [&](const v4u (&r)[2], f32x4 (&o)[4]) { o[0] = (f32x4){bflo(r[0].x), bfhi(r[0].x), bflo(r[0].y), bfhi(r[0].y)}; o[1] = (f32x4){bflo(r[0].z), bfhi(r[0].z), bflo(r[0].w), bfhi(r[0].w)};
        o[2] = (f32x4){bflo(r[1].x), bfhi(r[1].x), bflo(r[1].y), bfhi(r[1].y)}; o[3] = (f32x4){bflo(r[1].z), bfhi(r[1].z), bflo(r[1].w), bfhi(r[1].w)}; };
    Idx I0{}, I1{}, I2{}; Raw R1{};
    if (gw < M) { ld_idx(gw, I0); ld_raw(gw, I0, R1); I1 = I0; }
    if (gw + NGW < M) ld_idx(gw + NGW, I2);
    for (int m = gw; m < M; m += NGW) {
        const Raw R0 = R1; const Idx Ic = I1;
        I1 = I2;
        if (m + NGW < M) ld_raw(m + NGW, I1, R1);
        if (m + 2 * NGW < M) ld_idx(m + 2 * NGW, I2);
        f32x4 v[4], x[4], ya[4]; unp(R0.a, x); unp(R0.b, ya);
        if constexpr (MOE) { f32x4 yb[4]; unp(R0.c, yb);
#pragma unroll
            for (int j = 0; j < 4; ++j) v[j] = x[j] * ALPHA + (ya[j] * Ic.w0 + yb[j] * Ic.w1);
        } else {
#pragma unroll
            for (int j = 0; j < 4; ++j) v[j] = x[j] * ALPHA + ya[j];
        }
        ln_apply(v, g, b);
        if (l + 1 < DEPTH) { store_row_bf16(XBo + (size_t)m * D, v, C.lane); write_gates(C, l + 1, m, v, wl); }
        else store_row_f32(outf + (size_t)m * D, v, C.lane);
    }
}


typedef short bf16x8 __attribute__((ext_vector_type(8)));
typedef short s16x4 __attribute__((ext_vector_type(4)));
#define MFMA16(X, Y, ACC) __builtin_amdgcn_mfma_f32_16x16x32_bf16((X), (Y), (ACC), 0, 0, 0)
#define LBAR() do { asm volatile("s_waitcnt lgkmcnt(0)" ::: "memory"); __builtin_amdgcn_s_barrier(); asm volatile("" ::: "memory"); } while (0)
__device__ __forceinline__ unsigned off_b(unsigned row, unsigned ch) { return 256u * row + 16u * (ch ^ (((row & 3u) << 2) | ((row >> 2) & 3u))); }
__device__ __forceinline__ unsigned row_addr16(unsigned lane, unsigned rb, unsigned s) { return off_b((lane & 15u) + 16u * rb, 4u * s + (lane >> 4)); }
__device__ __forceinline__ unsigned tr_addr16(unsigned lane, unsigned c, unsigned ks, unsigned t) {
    const unsigned g = lane >> 4, q = (lane & 15u) >> 2, p = lane & 3u;
    return off_b(32u * ks + 8u * g + 4u * t + q, 2u * c + (p >> 1)) + 8u * (p & 1u);
}
__device__ __forceinline__ s16x4 ds_tr16(const LAS unsigned char* p) { return __builtin_bit_cast(s16x4, __builtin_amdgcn_ds_read_tr16_b64_v4i16((LAS s16x4*)p)); }
__device__ __forceinline__ float logsigmoid_f(float x) { return fminf(x, 0.f) - log1pf(__expf(-fabsf(x))); }
#include <type_traits>

namespace m2 {
constexpr int QI = 0, KI0 = 16384, VI0 = 49152, WI = 81920, WROW = 144, TBL = WI + 64 * WROW;
constexpr int T_R = TBL, T_B = TBL + 2048, T_PM = TBL + 4096, T_M = TBL + 6144, T_EM = TBL + 8192, T_SI = TBL + 10240, T_WL = TBL + 12288, T_GC = TBL + 14336, T_PC = T_GC + 64, T_SOLD = T_GC + 128,
              STAT = T_GC + 256, STATP = 26 * 64 * 4, NV = STAT + 2 * STATP, END = NV + 512;
static_assert(END <= MISC_OFF, "mLSTM LDS map");
constexpr size_t SEG_STATE = WS_R4 + 64 * MiB;
constexpr size_t SEG_ITEM_BYTES = 65536 + 8192;
constexpr size_t SEG_SCAL = SEG_STATE + 256 * SEG_ITEM_BYTES;
}
__device__ __forceinline__ void m2_tables(Ctx& C, const float* GT, size_t m0, int h) {
    using namespace m2;
    LAS float* tr = (LAS float*)(C.lds + T_R); LAS float* tb = (LAS float*)(C.lds + T_B); LAS float* tpm = (LAS float*)(C.lds + T_PM);
    LAS float* gc = (LAS float*)(C.lds + T_GC); LAS float* pc = (LAS float*)(C.lds + T_PC);
    const int w = C.wave, lane = C.lane; const size_t m = m0 + (size_t)w * 64 + lane;
    const float ip = GT[m * 8 + h], fp = GT[m * 8 + 4 + h];
    float bt = logsigmoid_f(fp);
#pragma unroll
    for (int o = 1; o < 64; o <<= 1) { const float y = __shfl_up(bt, o); if (lane >= o) bt += y; }
    const float r = ip - bt; float pm = r;
#pragma unroll
    for (int o = 1; o < 64; o <<= 1) { const float y = __shfl_up(pm, o); if (lane >= o) pm = fmaxf(pm, y); }
    tr[w * 64 + lane] = r; tb[w * 64 + lane] = bt; tpm[w * 64 + lane] = pm;
    if (lane == 63) { gc[w] = bt; pc[w] = pm; }
}
__device__ __forceinline__ float m2_chain(Ctx& C, float m_in) {
    using namespace m2;
    LAS float* gc = (LAS float*)(C.lds + T_GC); LAS float* pc = (LAS float*)(C.lds + T_PC); LAS float* so = (LAS float*)(C.lds + T_SOLD);
    const int w = C.wave, lane = C.lane;
    float m = m_in, mprev = m_in, m63 = 0.f;
#pragma unroll
    for (int c = 0; c < 8; ++c) { const float g = gc[c], P = pc[c]; const float M63 = fmaxf(P, m); if (c == w) { mprev = m; m63 = M63; } m = g + M63; }
    unsigned a0 = (unsigned)(T_R + 4 * (w * 64 + lane)); asm volatile("" : "+v"(a0)); LAS float* t0 = (LAS float*)(C.lds + a0);
#define M2T(T) t0[((T) - T_R) / 4]
    const float Mt = fmaxf(M2T(T_PM), mprev);
    M2T(T_M) = Mt; M2T(T_EM) = __expf(-(M2T(T_B) + Mt)); M2T(T_SI) = __expf(mprev - Mt); M2T(T_WL) = __expf(M2T(T_R) - m63);
#undef M2T
    if (lane == 0) so[w] = __expf(mprev - m63);
    return m;
}
struct M2Lane { unsigned trA0[2], trK[2], rowB, rowK, qlB, qhB; };
__device__ __forceinline__ M2Lane m2_lane(unsigned lane) {
    const unsigned lr = lane & 15u, g = lane >> 4, q = lr >> 2, p = lane & 3u; M2Lane K;
#pragma unroll
    for (unsigned t = 0; t < 2; ++t) { const unsigned F = (q << 2) | ((2u * g + t) & 3u), b = p >> 1;
        K.trA0[t] = 256u * (8u * g + 4u * t + q) + 16u * (b ^ (F & 1u)) + 8u * (p & 1u); K.trK[t] = F >> 1; }
    const unsigned Fr = ((lr & 3u) << 2) | ((lr >> 2) & 3u);
    K.rowB = 256u * lr + 16u * (g ^ (Fr & 3u)); K.rowK = Fr >> 2;
    K.qlB = 256u * lr + 16u * ((g >> 1) ^ (Fr & 3u)) + 8u * (g & 1u);
    K.qhB = 256u * lr + 16u * ((2u | (g >> 1)) ^ (Fr & 3u)) + 8u * (g & 1u);
    return K;
}
#define M2_LAUNDER(K) asm volatile("" : "+v"((K).trA0[0]), "+v"((K).trA0[1]), "+v"((K).trK[0]), "+v"((K).trK[1]), "+v"((K).rowB), "+v"((K).rowK), "+v"((K).qlB), "+v"((K).qhB))
__device__ __forceinline__ unsigned tr_addr_f(const M2Lane& K, unsigned c, unsigned ks, unsigned t) { return K.trA0[t] + 8192u * ks + 32u * (c ^ K.trK[t]); }
__device__ __forceinline__ unsigned row_addr_f(const M2Lane& K, unsigned rb, unsigned s) { return K.rowB + 4096u * rb + 64u * (s ^ K.rowK); }
__device__ __forceinline__ unsigned qlo_addr_f(const M2Lane& K, unsigned tq, unsigned ks) { return K.qlB + 4096u * tq + 64u * (ks ^ K.rowK); }
__device__ __forceinline__ unsigned qhi_addr_f(const M2Lane& K, unsigned tq, unsigned ks) { return K.qhB + 4096u * tq + 64u * (ks ^ K.rowK); }
struct M2Stage { v4u q[2], k[2], v[2]; };
__device__ __forceinline__ v4u ldg16(const void* ubase, unsigned toff) { return *(const v4u*)((const char*)ubase + toff); }
template <bool WITH_Q> __device__ __forceinline__ void m2_load(M2Stage& S, const bf16* QK, const bf16* Z, size_t m0c, int h, int tid) {
    const unsigned tq = (unsigned)(((tid >> 4) * 1024 + (tid & 15) * 8) * 2), tz = (unsigned)(((tid >> 4) * NZ + (tid & 15) * 8) * 2);
    const bf16* qb = QK + m0c * 1024 + h * DH; const bf16* zb = Z + m0c * NZ + ZV + h * DH;
#pragma unroll
    for (int i = 0; i < 2; ++i) {
        if (WITH_Q) S.q[i] = ldg16(qb + (size_t)i * 32 * 1024, tq);
        S.k[i] = ldg16(qb + 512 + (size_t)i * 32 * 1024, tq);
        S.v[i] = ldg16(zb + (size_t)i * 32 * NZ, tz); }
}
template <bool WITH_Q> __device__ __forceinline__ void m2_store(const M2Stage& S, LAS unsigned char* L, int buf, int tid) {
    using namespace m2;
    const unsigned o = off_b((unsigned)(tid >> 4), (unsigned)(tid & 15));
#pragma unroll
    for (int i = 0; i < 2; ++i) {
        if (WITH_Q) *(LAS v4u*)(L + QI + i * 8192 + o) = S.q[i];
        *(LAS v4u*)(L + KI0 + buf * 16384 + i * 8192 + o) = S.k[i]; *(LAS v4u*)(L + VI0 + buf * 16384 + i * 8192 + o) = S.v[i]; }
}
__device__ __forceinline__ void m2_update(LAS unsigned char* L, int buf, int c, unsigned lane, const M2Lane& LK, int w, f32x4 (&Dst)[8], f32x4& Dn) {
    using namespace m2;
    const int lr = lane & 15, lg = lane >> 4;
    LAS float* twl = (LAS float*)(L + T_WL); LAS float* so = (LAS float*)(L + T_SOLD);
    bf16x8 yv[2], ya[2];
#pragma unroll
    for (int ks = 0; ks < 2; ++ks) {
        const s16x4 a0 = ds_tr16(L + VI0 + buf * 16384 + tr_addr_f(LK, (unsigned)w, ks, 0)), a1 = ds_tr16(L + VI0 + buf * 16384 + tr_addr_f(LK, (unsigned)w, ks, 1));
        const f32x4 w0 = *(const LAS f32x4*)(twl + c * 64 + 32 * ks + 8 * lg), w1 = *(const LAS f32x4*)(twl + c * 64 + 32 * ks + 8 * lg + 4);
        v4u pv, pa;
        pv.x = pk2(bf2f((unsigned short)a0[0]) * w0[0], bf2f((unsigned short)a0[1]) * w0[1]); pv.y = pk2(bf2f((unsigned short)a0[2]) * w0[2], bf2f((unsigned short)a0[3]) * w0[3]);
        pv.z = pk2(bf2f((unsigned short)a1[0]) * w1[0], bf2f((unsigned short)a1[1]) * w1[1]); pv.w = pk2(bf2f((unsigned short)a1[2]) * w1[2], bf2f((unsigned short)a1[3]) * w1[3]);
        pa.x = pk2(w0[0], w0[1]); pa.y = pk2(w0[2], w0[3]); pa.z = pk2(w1[0], w1[1]); pa.w = pk2(w1[2], w1[3]);
        if (lr != 0) pa = (v4u){0u, 0u, 0u, 0u};
        yv[ks] = __builtin_bit_cast(bf16x8, pv); ya[ks] = __builtin_bit_cast(bf16x8, pa); }
    const float sold = so[c];
#pragma unroll
    for (int j = 0; j < 8; ++j) Dst[j] = Dst[j] * sold;
    Dn = Dn * sold;
#pragma unroll
    for (int jh = 0; jh < 2; ++jh) {
        s16x4 a0[4][2], a1[4][2];
#pragma unroll
        for (int jj = 0; jj < 4; ++jj)
#pragma unroll
            for (int ks = 0; ks < 2; ++ks) { a0[jj][ks] = ds_tr16(L + KI0 + buf * 16384 + tr_addr_f(LK, (unsigned)(4 * jh + jj), ks, 0)); a1[jj][ks] = ds_tr16(L + KI0 + buf * 16384 + tr_addr_f(LK, (unsigned)(4 * jh + jj), ks, 1)); }
        __builtin_amdgcn_sched_barrier(0);
#pragma unroll
        for (int jj = 0; jj < 4; ++jj)
#pragma unroll
            for (int ks = 0; ks < 2; ++ks) { const bf16x8 x = __builtin_shufflevector(a0[jj][ks], a1[jj][ks], 0, 1, 2, 3, 4, 5, 6, 7);
                Dst[4 * jh + jj] = MFMA16(x, yv[ks], Dst[4 * jh + jj]);
                if (4 * jh + jj == w) Dn = MFMA16(x, ya[ks], Dn); }
    }
}

__device__ __forceinline__ void phase_mlstm_x(Ctx& C, int l) {
    using namespace m2;
    const bf16* Z = WSP(bf16, WS_R2); const bf16* QK = WSP(bf16, WS_R4); const float* GT = WSP(float, WS_GATE);
    LAS unsigned char* L = C.lds; const unsigned lane = (unsigned)C.lane; const int w = C.wave, tid = C.tid; (void)l;
    for (int item = C.bid; item < BATCH * NH * 8; item += C.G) {
        const int bh = item >> 3, sg = item & 7, b = bh >> 2, h = bh & 3; const size_t m0 = (size_t)b * SEQ + (size_t)sg * 512;
        __syncthreads();
        m2_tables(C, GT, m0, h);
        M2Stage S; m2_load<false>(S, QK, Z, m0, h, tid);
        __syncthreads();
        const float mfin = m2_chain(C, -1.0e30f);
        m2_store<false>(S, L, 0, tid);
        f32x4 Dst[8], Dn = {0.f, 0.f, 0.f, 0.f};
#pragma unroll
        for (int j = 0; j < 8; ++j) Dst[j] = (f32x4){0.f, 0.f, 0.f, 0.f};
        M2Lane LK = m2_lane(lane);
        __syncthreads();
        for (int c = 0; c < 8; ++c) {
            const int buf = c & 1;
            M2_LAUNDER(LK);
            if (c + 1 < 8) m2_load<false>(S, QK, Z, m0 + (size_t)(c + 1) * 64, h, tid);
            m2_update(L, buf, c, lane, LK, w, Dst, Dn);
            if (c + 1 < 8) m2_store<false>(S, L, buf ^ 1, tid);
            LBAR();
        }
        float* st = (float*)(C.Ap->ws + SEG_STATE + (size_t)item * SEG_ITEM_BYTES);
#pragma unroll
        for (int j = 0; j < 8; ++j) *(f32x4*)((char*)(st + (size_t)(w * 8 + j) * 256) + lane * 16u) = Dst[j];
        *(f32x4*)((char*)(st + 16384 + (size_t)w * 256) + lane * 16u) = Dn;
        if (tid == 0) { LAS float* gc = (LAS float*)(L + T_GC); float G = 0.f;
#pragma unroll
            for (int c = 0; c < 8; ++c) G += gc[c];
            float* sc = (float*)(C.Ap->ws + SEG_SCAL) + (size_t)item * 32; sc[0] = mfin; sc[1] = G; }
    }
}

__device__ __forceinline__ void phase_mlstm_y(Ctx& C, int l) {
    using namespace m2;
    const bf16* Z = WSP(bf16, WS_R2); const bf16* QK = WSP(bf16, WS_R4); const float* GT = WSP(float, WS_GATE); bf16* YC = WSP(bf16, WS_R3);
    LAS unsigned char* L = C.lds; const int w = C.wave, tid0 = C.tid;
    LAS float* tm = (LAS float*)(L + T_M); LAS float* tem = (LAS float*)(L + T_EM); LAS float* tsi = (LAS float*)(L + T_SI); LAS float* trr = (LAS float*)(L + T_R);
    LAS float* stat = (LAS float*)(L + STAT); LAS float* nv = (LAS float*)(L + NV);
    for (int item = C.bid; item < BATCH * NH * 8; item += C.G) {
        const int bh = item >> 3, sg = item & 7, b = bh >> 2, h = bh & 3; const size_t m0 = (size_t)b * SEQ + (size_t)sg * 512;
        __syncthreads();
        m2_tables(C, GT, m0, h);
        float coef[7]; float m_in = 0.f;
        { const float* sc = (const float*)(C.Ap->ws + SEG_SCAL) + (size_t)(bh * 8) * 32;
#pragma unroll
          for (int s2 = 0; s2 < 7; ++s2) { coef[s2] = 0.f;
              if (s2 < sg) { const float ms = sc[s2 * 32], G = sc[s2 * 32 + 1]; const float mn = fmaxf(G + m_in, ms), dec = __expf(G + m_in - mn);
#pragma unroll
                  for (int s3 = 0; s3 < 7; ++s3) if (s3 < s2) coef[s3] *= dec;
                  coef[s2] = __expf(ms - mn); m_in = mn; } } }
        f32x4 Dst[8], Dn = {0.f, 0.f, 0.f, 0.f};
#pragma unroll
        for (int j = 0; j < 8; ++j) Dst[j] = (f32x4){0.f, 0.f, 0.f, 0.f};
        { f32x4 ld[9]; const unsigned lane_c = (unsigned)(tid0 & 63);
#define M2_SEGLOAD(s2_) do { const float* st_ = (const float*)(C.Ap->ws + SEG_STATE + (size_t)(bh * 8 + (s2_)) * SEG_ITEM_BYTES); \
              _Pragma("unroll") for (int j = 0; j < 8; ++j) ld[j] = *(const f32x4*)((const char*)(st_ + (size_t)(w * 8 + j) * 256) + lane_c * 16u); \
              ld[8] = *(const f32x4*)((const char*)(st_ + 16384 + (size_t)w * 256) + lane_c * 16u); } while (0)
          if (sg > 0) M2_SEGLOAD(0);
          for (int s2 = 0; s2 < sg; ++s2) { float cf = coef[0];
#pragma unroll
              for (int s3 = 1; s3 < 7; ++s3) cf = (s2 == s3) ? coef[s3] : cf;
              f32x4 cur[9];
#pragma unroll
              for (int j = 0; j < 9; ++j) cur[j] = ld[j];
              if (s2 + 1 < sg) M2_SEGLOAD(s2 + 1);
#pragma unroll
              for (int j = 0; j < 8; ++j) Dst[j] = Dst[j] + cur[j] * cf;
              Dn = Dn + cur[8] * cf; }
#undef M2_SEGLOAD
        }
        int tid = tid0; asm volatile("" : "+v"(tid));
        const unsigned lane_i = (unsigned)(tid & 63); const int lr_i = (int)(lane_i & 15u), lg_i = (int)(lane_i >> 4);
        const f32x4 gn = *(const f32x4*)(C.Ap->in[I_MG] + (size_t)l * DML + h * DH + 16 * w + 4 * lg_i);
        const unsigned tog = (unsigned)((lr_i * NZ + 4 * lg_i) * 2), tyc = (unsigned)((lr_i * D + 4 * lg_i) * 2);
        const unsigned lane_y = lane_i; M2Lane LK = m2_lane(lane_y);
        unsigned qa0 = off_b(lane_y, 2u * (unsigned)w), qa1 = off_b(lane_y, 2u * (unsigned)w + 1u);
        M2Stage S; m2_load<true>(S, QK, Z, m0, h, tid);
        __syncthreads();
        (void)m2_chain(C, m_in);
        m2_store<true>(S, L, 0, tid);
        if (lr_i == 0) *(LAS f32x4*)(nv + 16 * w + 4 * lg_i) = Dn;
        bf16x8 xin[4];
#pragma unroll
        for (int ks = 0; ks < 4; ++ks) { v4u p; p.x = pk2(Dst[2 * ks][0], Dst[2 * ks][1]); p.y = pk2(Dst[2 * ks][2], Dst[2 * ks][3]); p.z = pk2(Dst[2 * ks + 1][0], Dst[2 * ks + 1][1]); p.w = pk2(Dst[2 * ks + 1][2], Dst[2 * ks + 1][3]); xin[ks] = __builtin_bit_cast(bf16x8, p); }
        __syncthreads();
        const int tt = w >> 1, jt = w & 1;
        for (int c = 0; c < 8; ++c) {
            const int buf = c & 1, par = c & 1; const size_t mc = m0 + (size_t)c * 64;
            M2_LAUNDER(LK);
            unsigned lane = lane_y; asm volatile("" : "+v"(lane), "+v"(qa0), "+v"(qa1));
            const int lr = (int)(lane & 15u), lg = (int)(lane >> 4);
            LAS float* dens = stat + par * (26 * 64); LAS float* nqs = dens + 2 * 64; LAS float* lns = dens + 10 * 64; LAS float* lnq = dens + 18 * 64;
            if (c + 1 < 8) m2_load<true>(S, QK, Z, mc + 64, h, tid);
            v2u og[4];
#pragma unroll
            for (int tq = 0; tq < 4; ++tq) og[tq] = *(const v2u*)((const char*)(Z + (mc + 16 * tq) * NZ + ZO + h * DH + 16 * w) + tog);
            { bf16x8 yq[4], xa[4], xb[4];
#pragma unroll
              for (int s4 = 0; s4 < 4; ++s4) { yq[s4] = *(const LAS bf16x8*)(L + QI + row_addr_f(LK, tt, s4));
                  xa[s4] = *(const LAS bf16x8*)(L + KI0 + buf * 16384 + row_addr_f(LK, 2 * jt, s4)); xb[s4] = *(const LAS bf16x8*)(L + KI0 + buf * 16384 + row_addr_f(LK, 2 * jt + 1, s4)); }
              const int t = 16 * tt + lr, s0a = 32 * jt + 4 * lg, s0b = s0a + 16; const float Mt = tm[c * 64 + t];
              const f32x4 rsa = *(const LAS f32x4*)(trr + c * 64 + s0a), rsb = *(const LAS f32x4*)(trr + c * 64 + s0b);
              const v4u q0 = *(const LAS v4u*)(L + QI + qa0), q1 = *(const LAS v4u*)(L + QI + qa1);
              const f32x4 n0 = *(const LAS f32x4*)(nv + 16 * w), n1 = *(const LAS f32x4*)(nv + 16 * w + 4), n2 = *(const LAS f32x4*)(nv + 16 * w + 8), n3 = *(const LAS f32x4*)(nv + 16 * w + 12);
              __builtin_amdgcn_sched_barrier(0);
              f32x4 acca = {0.f, 0.f, 0.f, 0.f}, accb = {0.f, 0.f, 0.f, 0.f};
#pragma unroll
              for (int s4 = 0; s4 < 4; ++s4) { acca = MFMA16(xa[s4], yq[s4], acca); accb = MFMA16(xb[s4], yq[s4], accb); }
              const float nqp = (bflo(q0.x) * n0[0] + bfhi(q0.x) * n0[1] + bflo(q0.y) * n0[2] + bfhi(q0.y) * n0[3]) + (bflo(q0.z) * n1[0] + bfhi(q0.z) * n1[1] + bflo(q0.w) * n1[2] + bfhi(q0.w) * n1[3])
                              + (bflo(q1.x) * n2[0] + bfhi(q1.x) * n2[1] + bflo(q1.y) * n2[2] + bfhi(q1.y) * n2[3]) + (bflo(q1.z) * n3[0] + bfhi(q1.z) * n3[1] + bflo(q1.w) * n3[2] + bfhi(q1.w) * n3[3]);
              nqs[w * 64 + lane] = nqp;
              float wa[4], wb[4]; float rsum = 0.f;
#pragma unroll
              for (int r = 0; r < 4; ++r) { wa[r] = (s0a + r <= t) ? acca[r] * __expf(fminf(rsa[r] - Mt, 0.f)) : 0.f; wb[r] = (s0b + r <= t) ? accb[r] * __expf(fminf(rsb[r] - Mt, 0.f)) : 0.f; }
              v2u oa, ob; oa.x = pk2(wa[0], wa[1]); oa.y = pk2(wa[2], wa[3]); ob.x = pk2(wb[0], wb[1]); ob.y = pk2(wb[2], wb[3]);
              rsum = (bflo(oa.x) + bfhi(oa.x)) + (bflo(oa.y) + bfhi(oa.y)) + (bflo(ob.x) + bfhi(ob.x)) + (bflo(ob.y) + bfhi(ob.y));
              rsum += __shfl_xor(rsum, 16); rsum += __shfl_xor(rsum, 32);
              if (lg == 0) dens[jt * 64 + t] = rsum;
              *(LAS v2u*)(L + WI + t * WROW + s0a * 2) = oa; *(LAS v2u*)(L + WI + t * WROW + s0b * 2) = ob; }
            LBAR();
            f32x4 hv[4];
            { bf16x8 xv[2];
#pragma unroll
              for (int ks = 0; ks < 2; ++ks) { const s16x4 a0 = ds_tr16(L + VI0 + buf * 16384 + tr_addr_f(LK, (unsigned)w, ks, 0)), a1 = ds_tr16(L + VI0 + buf * 16384 + tr_addr_f(LK, (unsigned)w, ks, 1));
                  xv[ks] = __builtin_shufflevector(a0, a1, 0, 1, 2, 3, 4, 5, 6, 7); }
#pragma unroll
              for (int th = 0; th < 2; ++th) {
                  bf16x8 yw[2][2]; s16x4 ql[2][4], qh[2][4];
#pragma unroll
                  for (int u = 0; u < 2; ++u) { const int tq = 2 * th + u;
#pragma unroll
                      for (int ks = 0; ks < 2; ++ks) yw[u][ks] = *(const LAS bf16x8*)(L + WI + (16 * tq + lr) * WROW + (32 * ks + 8 * lg) * 2);
#pragma unroll
                      for (int ks = 0; ks < 4; ++ks) { ql[u][ks] = *(const LAS s16x4*)(L + QI + qlo_addr_f(LK, tq, ks));
                          qh[u][ks] = *(const LAS s16x4*)(L + QI + qhi_addr_f(LK, tq, ks)); } }
                  __builtin_amdgcn_sched_barrier(0);
#pragma unroll
                  for (int u = 0; u < 2; ++u) { const int tq = 2 * th + u, t = 16 * tq + lr; f32x4 accI = {0.f, 0.f, 0.f, 0.f}, accE = {0.f, 0.f, 0.f, 0.f};
#pragma unroll
                      for (int ks = 0; ks < 2; ++ks) accI = MFMA16(xv[ks], yw[u][ks], accI);
#pragma unroll
                      for (int ks = 0; ks < 4; ++ks) { const bf16x8 y = __builtin_shufflevector(ql[u][ks], qh[u][ks], 0, 1, 2, 3, 4, 5, 6, 7); accE = MFMA16(xin[ks], y, accE); }
                      const float sI = tsi[c * 64 + t]; const float nqt = ((nqs[t] + nqs[64 + t]) + (nqs[128 + t] + nqs[192 + t])) + ((nqs[256 + t] + nqs[320 + t]) + (nqs[384 + t] + nqs[448 + t]));
                      const float den = (dens[t] + dens[64 + t]) + sI * nqt; const float inv = 1.0f / fmaxf(fabsf(den), tem[c * 64 + t]);
                      hv[tq] = (accI + accE * sI) * inv;
                      float s1 = (hv[tq][0] + hv[tq][1]) + (hv[tq][2] + hv[tq][3]), s2 = (hv[tq][0] * hv[tq][0] + hv[tq][1] * hv[tq][1]) + (hv[tq][2] * hv[tq][2] + hv[tq][3] * hv[tq][3]);
                      s1 += __shfl_xor(s1, 16); s1 += __shfl_xor(s1, 32); s2 += __shfl_xor(s2, 16); s2 += __shfl_xor(s2, 32);
                      if (lg == 0) { lns[w * 64 + t] = s1; lnq[w * 64 + t] = s2; } }
              } }
            LBAR();
#pragma unroll
            for (int tq = 0; tq < 4; ++tq) { const int t = 16 * tq + lr;
                const float ls = ((lns[t] + lns[64 + t]) + (lns[128 + t] + lns[192 + t])) + ((lns[256 + t] + lns[320 + t]) + (lns[384 + t] + lns[448 + t]));
                const float lq = ((lnq[t] + lnq[64 + t]) + (lnq[128 + t] + lnq[192 + t])) + ((lnq[256 + t] + lnq[320 + t]) + (lnq[384 + t] + lnq[448 + t]));
                const float mean = ls * (1.0f / DH); const float var = fmaxf(lq * (1.0f / DH) - mean * mean, 0.f); const float rstd = 1.0f / sqrtf(var + LN_EPS);
                const float o0 = bflo(og[tq].x), o1 = bfhi(og[tq].x), o2 = bflo(og[tq].y), o3 = bfhi(og[tq].y);
                const float y0 = sigmoid_f(o0) * ((hv[tq][0] - mean) * rstd * gn[0]), y1 = sigmoid_f(o1) * ((hv[tq][1] - mean) * rstd * gn[1]);
                const float y2 = sigmoid_f(o2) * ((hv[tq][2] - mean) * rstd * gn[2]), y3 = sigmoid_f(o3) * ((hv[tq][3] - mean) * rstd * gn[3]);
                v2u o; o.x = pk2(y0, y1); o.y = pk2(y2, y3);
                *(v2u*)((char*)(YC + (mc + 16 * tq) * D + DPOOL + h * DH + 16 * w) + tyc) = o; }
            LBAR();
            if (c + 1 < 8) {
                m2_update(L, buf, c, lane, LK, w, Dst, Dn);
#pragma unroll
                for (int ks = 0; ks < 4; ++ks) { v4u p; p.x = pk2(Dst[2 * ks][0], Dst[2 * ks][1]); p.y = pk2(Dst[2 * ks][2], Dst[2 * ks][3]); p.z = pk2(Dst[2 * ks + 1][0], Dst[2 * ks + 1][1]); p.w = pk2(Dst[2 * ks + 1][2], Dst[2 * ks + 1][3]); xin[ks] = __builtin_bit_cast(bf16x8, p); }
                if (lr == 0) *(LAS f32x4*)(nv + 16 * w + 4 * lg) = Dn;
                m2_store<true>(S, L, buf ^ 1, tid);
            }
            LBAR();
        }
    }
}

enum { PH_INPROJ = 0, PH_CONV = 1, PH_MLSTM = 2, PH_POOLFIN = 3, PH_OUTPROJ = 4, PH_LN1 = 5, PH_F0 = 6, PH_F1 = 7, PH_F2 = 8, PH_LN2M = 17 };
__global__ void __launch_bounds__(NTHR, 2) fwd(Args args) {
    extern __shared__ __attribute__((aligned(16))) unsigned char lds_raw[];
    const int wave_s = __builtin_amdgcn_readfirstlane((int)(threadIdx.x >> 6));
    { Ctx C = make_ctx(lds_raw, wave_s);
      for (int u = C.tid; u < (LDS_BYTES - MISC_OFF) / 4; u += NTHR) ((LAS unsigned*)(C.lds + MISC_OFF))[u] = 0u;
      __syncthreads();
      (void)xcd_barrier_post((unsigned*)(C.Ap->ws + WS_CTL) + CW_BAR + C.Ap->li * XCD_BAR_WORDS, (volatile LAS unsigned*)(C.lds + MISC_OFF) + 8); }
    const int lo = args.ph_lo, hi = args.ph_hi; (void)args;
#ifndef DUP_MASK
#define DUP_MASK 0
#endif
#define DUPB(bit) ((((DUP_MASK) >> (bit)) & 1) != 0)
#ifndef DUP_N
#define DUP_N 1
#endif
#define REP(bit) for (int rep_ = 0; rep_ < (((DUP_MASK) >> (bit)) & 1) * (DUP_N) + 1; ++rep_)
#define IN(k) (lo <= (k) && (k) < hi)
#define SEAM(k) do { if (hi > (k) + 1) { Ctx Cb = make_ctx(lds_raw, wave_s); XcdBarrier bar; bar.bar = (unsigned*)(Cb.Ap->ws + WS_CTL) + CW_BAR + Cb.Ap->li * XCD_BAR_WORDS; bar.x = xb_xcc_id(); \
        bar.st = (volatile LAS unsigned*)(Cb.lds + MISC_OFF) + 8; xcd_barrier(bar); if (DUPB(15)) xcd_barrier(bar); } } while (0)
#define PHASE(k, body) do { if (IN(k)) { Ctx C = make_ctx(lds_raw, wave_s); { Ctx C = make_ctx(lds_raw, wave_s); body } SEAM(k); } } while (0)

    if (IN(0)) { Ctx C = make_ctx(lds_raw, wave_s); REP(13) phase_prologue(C); SEAM(0); }
#pragma nounroll
    for (int l = 0; l < DEPTH; ++l) {
        const int pb = 1 + l * NPH; const int jj = l >> 1; const bool moe = (l & 1) != 0;
        if (IN(pb + PH_INPROJ)) { Ctx C = make_ctx(lds_raw, wave_s);
            pg8::Gemm g{WSP(bf16, WS_XB), WSP(bf16, WS_WIN) + (size_t)l * NZ * D, M, NZ, D}; pg8::StaticOrder S; S.init(M, NZ, C.G, C.bid);
            REP(0) { pg8::EpiBf16 E{WSP(bf16, WS_R2), NZ, (DUPB(16) && rep_ == 0) ? 1 : 0};
            pg8::gemm_phase<pg8::EpiBf16, pg8::StaticOrder, true, true>(C.lds, g, S, E, C.wave); }
            SEAM(pb + PH_INPROJ);
        }
        if (IN(pb + PH_CONV)) { Ctx C = make_ctx(lds_raw, wave_s); REP(1) { phase_conv(C, l); phase_pool(C, l); } SEAM(pb + PH_CONV); }
        if (IN(pb + PH_MLSTM)) { Ctx C = make_ctx(lds_raw, wave_s); REP(2) phase_mlstm_x(C, l); SEAM(pb + PH_MLSTM); }
        if (IN(pb + PH_POOLFIN)) { Ctx C = make_ctx(lds_raw, wave_s); REP(3) phase_mlstm_y(C, l); if (l == 2) { __syncthreads(); Ctx C2 = make_ctx(lds_raw, wave_s); REP(14) convert_experts(C2, 1); } SEAM(pb + PH_POOLFIN); }
        if (IN(pb + PH_OUTPROJ)) { Ctx C = make_ctx(lds_raw, wave_s);
            pg8::Gemm g{WSP(bf16, WS_R3), WSP(bf16, WS_WOUT) + (size_t)l * D * D, M, D, D}; pg8::StaticOrder S; S.init(M, D, C.G, C.bid);
            pg8::EpiBf16 E{WSP(bf16, WS_T), D};
            REP(4) pg8::gemm_phase<pg8::EpiBf16, pg8::StaticOrder, true, true>(C.lds, g, S, E, C.wave);
            SEAM(pb + PH_OUTPROJ);
        }
        if (!moe) {
            if (IN(pb + PH_LN1)) { Ctx C = make_ctx(lds_raw, wave_s); REP(5) phase_ln1<false>(C, l); SEAM(pb + PH_LN1); }
            if (IN(pb + PH_F0)) { Ctx C = make_ctx(lds_raw, wave_s);
                pg8::Gemm g{WSP(bf16, WS_XB), WSP(bf16, WS_WGU) + (size_t)jj * 2 * FFD * D, M, 2 * FFD, D}; pg8::StaticOrder S; S.init(M, 2 * FFD, C.G, C.bid);
                pg8::EpiSwiGLU8 E{WSP(bf16, WS_R2), FFD, 1.0f, F8_ASC};
                REP(6) pg8::gemm_phase<pg8::EpiSwiGLU8, pg8::StaticOrder, true, true>(C.lds, g, S, E, C.wave);
                SEAM(pb + PH_F0);
            }
            if (IN(pb + PH_F1)) { Ctx C = make_ctx(lds_raw, wave_s);
                pg8::Gemm g{WSP(bf16, WS_R2), (const bf16*)(WSP(unsigned char, WS_WD) + (size_t)jj * D * FFD), M, D, FFD / 2}; pg8::StaticOrder S; S.init(M, D, C.G, C.bid);
                pg8::EpiBf16S E{WSP(bf16, WS_T), D, 1.0f / (F8_DSC * F8_ASC)};
                REP(7) pg8::gemm_phase<pg8::EpiBf16S, pg8::StaticOrder, true, true, 1>(C.lds, g, S, E, C.wave);
                SEAM(pb + PH_F1);
            }
            if (IN(pb + PH_F2)) { Ctx C = make_ctx(lds_raw, wave_s); REP(8) phase_ln2<false>(C, l); SEAM(pb + PH_F2); }
        } else {
            if (IN(pb + PH_LN1)) { Ctx C = make_ctx(lds_raw, wave_s); REP(5) phase_ln1<true>(C, l); SEAM(pb + PH_LN1); }
            if (IN(pb + PH_F0)) { Ctx C = make_ctx(lds_raw, wave_s); REP(9) phase_moe_prep(C); SEAM(pb + PH_F0); }
#pragma nounroll
            for (int p = 0; p < NPASS; ++p) {
                const int rt0 = p * PASS_TILES;
                if (IN(pb + PH_F1 + 2 * p)) { Ctx C = make_ctx(lds_raw, wave_s);
                    const int NT = __builtin_amdgcn_readfirstlane(WSP(int, MOE_META)[0]); int ntp = NT - rt0; if (p + 1 < NPASS) ntp = ntp > PASS_TILES ? PASS_TILES : ntp;
                    if (ntp > 0) {
                        pg8::Gemm g{(const bf16*)(WSP(unsigned char, WS_R3) + (size_t)rt0 * 256 * D), WSP(bf16, WS_EGU), ntp * 256, 2 * FFE, D / 2};
                        pg8::GroupedOrder S; S.init(ntp, 2 * FFE, C.G, C.bid, rt0, WSP(int, MOE_TILE_E));
                        pg8::EpiSwiGLU8 E{WSP(bf16, WS_R2), FFE, 1.0f / (F8_WSC * F8_HSC), F8_ASC};
                        REP(10) pg8::gemm_phase<pg8::EpiSwiGLU8, pg8::GroupedOrder, true, true, 1>(C.lds, g, S, E, C.wave);
                    }
                    SEAM(pb + PH_F1 + 2 * p);
                }
                if (IN(pb + PH_F2 + 2 * p)) { Ctx C = make_ctx(lds_raw, wave_s);
                    const int NT = __builtin_amdgcn_readfirstlane(WSP(int, MOE_META)[0]); int ntp = NT - rt0; if (p + 1 < NPASS) ntp = ntp > PASS_TILES ? PASS_TILES : ntp;
                    if (ntp > 0) {
                        pg8::Gemm g{WSP(bf16, WS_R2), WSP(bf16, WS_ED), ntp * 256, D, FFE / 2}; pg8::GroupedOrder S; S.init(ntp, D, C.G, C.bid, rt0, WSP(int, MOE_TILE_E));
                        pg8::EpiBf16S E{WSP(bf16, WS_R4) + (size_t)rt0 * 256 * D, D, 1.0f / (F8_DSC * F8_ASC)};
                        REP(11) pg8::gemm_phase<pg8::EpiBf16S, pg8::GroupedOrder, true, true, 1>(C.lds, g, S, E, C.wave);
                    }
                    SEAM(pb + PH_F2 + 2 * p);
                }
            }
            if (IN(pb + PH_LN2M)) { Ctx C = make_ctx(lds_raw, wave_s); REP(12) phase_ln2<true>(C, l, (DUPB(12) && rep_ == 0) ? WS_R2 : 0); SEAM(pb + PH_LN2M); }
        }
    }
#undef IN
#undef SEAM
}

static bool phase_exists(int id) { if (id == 0) return true; const int l = (id - 1) / NPH, k = (id - 1) % NPH; return (l & 1) ? true : (k <= PH_F2); }
extern "C" void kernel_launch(void* const* d_in, const int* in_sizes, int n_in, void* d_out, int out_size, void* d_ws, size_t ws_size, hipStream_t stream) {
    static int grid = 0;
    if (grid == 0) {
        if (n_in != 21 || out_size != M * D || ws_size < WS_END) { fprintf(stderr, "kernel_launch: unexpected shapes (n_in %d, out %d, ws %zu)\n", n_in, out_size, ws_size); grid = -1; return; }
        int dev = 0, cus = 0, per_cu = 0;
        if (hipGetDevice(&dev) != hipSuccess || hipDeviceGetAttribute(&cus, hipDeviceAttributeMultiprocessorCount, dev) != hipSuccess) { grid = -1; return; }
        if (hipFuncSetAttribute((const void*)fwd, hipFuncAttributeMaxDynamicSharedMemorySize, LDS_BYTES) != hipSuccess) { fprintf(stderr, "kernel_launch: hipFuncSetAttribute failed\n"); grid = -1; return; }
        if (hipOccupancyMaxActiveBlocksPerMultiprocessor(&per_cu, (const void*)fwd, NTHR, LDS_BYTES) != hipSuccess || per_cu < 1) { fprintf(stderr, "kernel_launch: occupancy query says %d blocks per CU\n", per_cu); (void)hipGetLastError(); if (per_cu < 1) { grid = -1; return; } }
        grid = cus;
    }
    if (grid < 0) return;
    (void)in_sizes;
    if (hipMemsetAsync((char*)d_ws + WS_CTL, 0, CTL_ZERO_BYTES, stream) != hipSuccess) return;
    Args a{};
    for (int i = 0; i < 21; ++i) a.in[i] = (const float*)d_in[i];
    a.out = (float*)d_out; a.ws = (unsigned char*)d_ws; a.pad = 0;
#if MK_ONE_LAUNCH
    a.ph_lo = 0; a.ph_hi = NPHASES; a.li = 0;
    hipLaunchKernelGGL(fwd, dim3(grid), dim3(NTHR), LDS_BYTES, stream, a);
#else
    for (int id = 0; id < NPHASES; ++id) { if (!phase_exists(id)) continue;
        a.ph_lo = id; a.ph_hi = id + 1; a.li = id;
        hipLaunchKernelGGL(fwd, dim3(grid), dim3(NTHR), LDS_BYTES, stream, a); }
#endif
}
```

```cpp
#include <hip/hip_runtime.h>
#include <cstdio>
#include <cstdint>
#ifndef MK_ONE_LAUNCH
#define MK_ONE_LAUNCH 1
#endif
namespace pg8 {
#define PG8_LAS __attribute__((address_space(3)))
typedef unsigned short bf16_t;
typedef short bf16x8 __attribute__((ext_vector_type(8)));
typedef float f32x4 __attribute__((ext_vector_type(4)));
typedef unsigned u32x4 __attribute__((ext_vector_type(4)));
constexpr int BM = 256, BK = 64, HALF = 128, HTB = HALF * BK * 2  , STAGE_BYTES = 8 * HTB, NXCD = 8, WGM = 8;

__host__ __device__ __forceinline__ int lds_byte(int r, int c) { const int st = (r >> 4) * 2 + (c >> 5), rr = r & 15, cc = c & 31, ob = rr * 64 + cc * 2; return st * 1024 + (ob ^ (((ob >> 9) & 1) << 5)); }
__host__ __device__ __forceinline__ void stage_rc(int b, int& R, int& C) { const int st = b / 1024, sb = b % 1024, swz = sb ^ (((sb >> 9) & 1) << 5); R = (st >> 1) * 16 + swz / 64; C = (st & 1) * 32 + (swz % 64) / 2; }
__host__ __device__ __forceinline__ int perm32(int rho) { const int n = rho >> 4, i = rho & 15; return 8 * (i >> 2) + 4 * n + (i & 3); }

struct Unit { int pm, pn, pb; };
struct Gemm { const bf16_t* A; const bf16_t* Bt; int M, N, K; };

struct StaticOrder {
    int nM, nN, nwg, G, c;
    __host__ __device__ void init(int M, int N, int G_, int c_) { nM = M / BM; nN = N / BM; nwg = nM * nN; G = G_; c = c_; }
    __host__ __device__ bool next(int i, Unit& u) const {
        const long L = (long)i * G + c; if (L >= nwg) return false;
        int wgid = (int)L; { const int q = nwg / NXCD, r = nwg % NXCD, xcd = wgid % NXCD, off = wgid / NXCD; wgid = (xcd < r ? xcd * (q + 1) : r * (q + 1) + (xcd - r) * q) + off; }
        const int nig = WGM * nN, gid = wgid / nig, fm = gid * WGM, gsz = (nM - fm) < WGM ? (nM - fm) : WGM;
        u.pm = fm + ((wgid % nig) % gsz); u.pn = (wgid % nig) / gsz; u.pb = u.pn; return true;
    }
    __device__ __forceinline__ void a_ready(const Unit&) const {}
    __device__ __forceinline__ void done(const Unit&) const {}
};
struct GroupedOrder {
    StaticOrder so; int rt0; const int* tile_e;
    __device__ void init(int ntp, int N, int G_, int c_, int rt0_, const int* te) { so.init(ntp * BM, N, G_, c_); rt0 = rt0_; tile_e = te; }
    __device__ bool next(int i, Unit& u) const {
        if (!so.next(i, u)) return false;
        const int e = __builtin_amdgcn_readfirstlane(tile_e[rt0 + u.pm]); u.pb = e * so.nN + u.pn; return true;
    }
    __device__ __forceinline__ void a_ready(const Unit&) const {}
    __device__ __forceinline__ void done(const Unit&) const {}
};

#ifndef PG8_ST_AUX
#define PG8_ST_AUX 0
#endif
#define PG8_RSRC(p) __builtin_amdgcn_make_buffer_rsrc((void*)(p), 0, 0x7fffffff, 0x00020000)
#define PG8_ST128(w, rs, off) __builtin_amdgcn_raw_buffer_store_b128((w), (rs), (off), 0, PG8_ST_AUX)
#define PG8_ST64(w, rs, off) __builtin_amdgcn_raw_buffer_store_b64((w), (rs), (off), 0, PG8_ST_AUX)
__device__ __forceinline__ unsigned cvt_pk_bf16(float lo, float hi) { unsigned r; asm volatile("v_cvt_pk_bf16_f32 %0, %1, %2" : "=v"(r) : "v"(lo), "v"(hi)); return r; }

struct EpiBf16 {
    static constexpr bool PERM = true, AFTER_DRAIN = false;
    bf16_t* O; int ldc; int nostore = 0;
    __device__ __forceinline__ void operator()(const f32x4 (&acc)[2][2][4][2], const Unit& u, int wr, int wc, int fr, int fq) const {
        const int row0 = u.pm * BM + wr * 64 + fr; const int col0 = u.pn * BM + wc * 32 + 8 * fq; const auto rs = PG8_RSRC(O);
#pragma unroll
        for (int ai = 0; ai < 2; ++ai)
#pragma unroll
            for (int m = 0; m < 4; ++m) { const int off = ((row0 + ai * HALF + m * 16) * ldc + col0) * 2;
#pragma unroll
                for (int bj = 0; bj < 2; ++bj) { const f32x4 v0 = acc[ai][bj][m][0], v1 = acc[ai][bj][m][1];
                    u32x4 w; w.x = cvt_pk_bf16(v0[0], v0[1]); w.y = cvt_pk_bf16(v0[2], v0[3]); w.z = cvt_pk_bf16(v1[0], v1[1]); w.w = cvt_pk_bf16(v1[2], v1[3]);
                    if (!nostore || w.x == 0x12345678u) PG8_ST128(w, rs, off + bj * HALF * 2); } }
    }
};
__device__ __forceinline__ float silu_f(float g) { return g * __builtin_amdgcn_rcpf(1.0f + __expf(-g)); }
__device__ __forceinline__ unsigned cvt_fp8x4(float a, float b, float c, float d) {
    a = fminf(fmaxf(a, -448.f), 448.f); b = fminf(fmaxf(b, -448.f), 448.f); c = fminf(fmaxf(c, -448.f), 448.f); d = fminf(fmaxf(d, -448.f), 448.f);
    int r = __builtin_amdgcn_cvt_pk_fp8_f32(a, b, 0, false); r = __builtin_amdgcn_cvt_pk_fp8_f32(c, d, r, true); return (unsigned)r; }
template <bool OUT8> struct EpiSwiGLUT {
    static constexpr bool PERM = true, AFTER_DRAIN = false;
    bf16_t* O; int ldc; float insc = 1.0f; float outsc = 1.0f;
    __device__ __forceinline__ void operator()(const f32x4 (&acc)[2][2][4][2], const Unit& u, int wr, int wc, int fr, int fq) const {
        const int row0 = u.pm * BM + wr * 64 + fr; const int col0 = u.pn * HALF + wc * 32 + 8 * fq;
        const float c1 = -1.4426950408889634f * insc, c2 = insc * insc * outsc; const auto rs = PG8_RSRC(O);
#pragma unroll
        for (int ai = 0; ai < 2; ++ai)
#pragma unroll
            for (int m = 0; m < 4; ++m) {
                const f32x4 g0 = acc[ai][0][m][0], g1 = acc[ai][0][m][1], u0 = acc[ai][1][m][0], u1 = acc[ai][1][m][1];
                const f32x4 t0 = g0 * c1, t1 = g1 * c1; f32x4 d0, d1;
#pragma unroll
                for (int j = 0; j < 4; ++j) { d0[j] = __builtin_amdgcn_exp2f(t0[j]); d1[j] = __builtin_amdgcn_exp2f(t1[j]); }
                d0 = d0 + 1.0f; d1 = d1 + 1.0f;
#pragma unroll
                for (int j = 0; j < 4; ++j) { d0[j] = __builtin_amdgcn_rcpf(d0[j]); d1[j] = __builtin_amdgcn_rcpf(d1[j]); }
                const f32x4 h0 = (g0 * u0) * (d0 * c2), h1 = (g1 * u1) * (d1 * c2);
                if constexpr (OUT8) { typedef unsigned u32x2_ __attribute__((ext_vector_type(2)));
                    u32x2_ w; w.x = cvt_fp8x4(h0[0], h0[1], h0[2], h0[3]); w.y = cvt_fp8x4(h1[0], h1[1], h1[2], h1[3]);
                    PG8_ST64(w, rs, (row0 + ai * HALF + m * 16) * ldc + col0); }
                else {
                    u32x4 w; w.x = cvt_pk_bf16(h0[0], h0[1]); w.y = cvt_pk_bf16(h0[2], h0[3]); w.z = cvt_pk_bf16(h1[0], h1[1]); w.w = cvt_pk_bf16(h1[2], h1[3]);
                    PG8_ST128(w, rs, ((row0 + ai * HALF + m * 16) * ldc + col0) * 2); } }
    }
};
typedef EpiSwiGLUT<false> EpiSwiGLU; typedef EpiSwiGLUT<true> EpiSwiGLU8;
struct EpiBf16S {
    static constexpr bool PERM = true, AFTER_DRAIN = false;
    bf16_t* O; int ldc; float insc;
    __device__ __forceinline__ void operator()(const f32x4 (&acc)[2][2][4][2], const Unit& u, int wr, int wc, int fr, int fq) const {
        const int row0 = u.pm * BM + wr * 64 + fr; const int col0 = u.pn * BM + wc * 32 + 8 * fq; const auto rs = PG8_RSRC(O);
#pragma unroll
        for (int ai = 0; ai < 2; ++ai)
#pragma unroll
            for (int m = 0; m < 4; ++m) { const int off = ((row0 + ai * HALF + m * 16) * ldc + col0) * 2;
#pragma unroll
                for (int bj = 0; bj < 2; ++bj) { const f32x4 v0 = acc[ai][bj][m][0] * insc, v1 = acc[ai][bj][m][1] * insc;
                    u32x4 w; w.x = cvt_pk_bf16(v0[0], v0[1]); w.y = cvt_pk_bf16(v0[2], v0[3]); w.z = cvt_pk_bf16(v1[0], v1[1]); w.w = cvt_pk_bf16(v1[2], v1[3]);
                    PG8_ST128(w, rs, off + bj * HALF * 2); } }
    }
};

template <class Epi, class Sched, bool ALIGN_EPI = false, bool SP2 = false, int DT = 0>
__device__ __forceinline__ void gemm_phase(PG8_LAS unsigned char* lds, const Gemm g, const Sched& S, const Epi& E, int wave_s) {
    int lane_l; asm volatile("v_mbcnt_lo_u32_b32 %0, -1, 0\n\tv_mbcnt_hi_u32_b32 %0, -1, %0" : "=v"(lane_l));
    const int tid_l = wave_s * 64 + lane_l;
    const int tid = tid_l, wid = __builtin_amdgcn_readfirstlane(tid >> 6), lane = tid & 63, wr = wid >> 2, wc = wid & 3, fr = lane & 15, fq = lane >> 4;
    const int K = g.K, nt = K / BK;
    unsigned voffA[2], voffB[2];
#pragma unroll
    for (int i = 0; i < 2; ++i) { int R, C; stage_rc(tid * 16 + i * 8192, R, C); const int Rb = Epi::PERM ? ((R & ~31) + perm32(R & 31)) : R;
        voffA[i] = (unsigned)(R * K + C) * 2u; voffB[i] = (unsigned)(Rb * K + C) * 2u; }
    const size_t kstep = (size_t)(BK * 2);
    const size_t hstep = (size_t)HALF * K * 2;
    const size_t tstep = 2 * hstep;
    const unsigned ldsw = (unsigned)wid * 1024u;
    const int aoff = lds_byte(wr * 64 + fr, fq * 8), boff = lds_byte(wc * 32 + fr, fq * 8);
#define PG8_SA(b, h) (((b) * 2 + (h)) * HTB)
#define PG8_SB(b, h) ((4 + (b) * 2 + (h)) * HTB)
#define PG8_STAGE(bufoff, gbase, voff) do { _Pragma("unroll") for (int _i = 0; _i < 2; ++_i) \
        __builtin_amdgcn_global_load_lds((const unsigned*)((const char*)(gbase) + (voff)[_i]), (PG8_LAS unsigned*)(lds + (bufoff) + ldsw + _i * 8192), 16, 0, 0); } while (0)
#define PG8_LDA(dst, b, h) do { _Pragma("unroll") for (int m = 0; m < 4; ++m) { \
        if constexpr (DT == 1) { const pg8_i4 l0_ = *(const PG8_LAS pg8_i4*)(lds + PG8_SA(b, h) + aoff + m * 2048), l1_ = *(const PG8_LAS pg8_i4*)(lds + PG8_SA(b, h) + aoff + m * 2048 + 1024); dst##8[m] = __builtin_shufflevector(l0_, l1_, 0, 1, 2, 3, 4, 5, 6, 7); } \
        else { _Pragma("unroll") for (int k = 0; k < 2; ++k) dst[m][k] = *(const PG8_LAS bf16x8*)(lds + PG8_SA(b, h) + aoff + m * 2048 + k * 1024); } } } while (0)
#define PG8_LDB(dst, b, h) do { _Pragma("unroll") for (int n = 0; n < 2; ++n) { \
        if constexpr (DT == 1) { const pg8_i4 l0_ = *(const PG8_LAS pg8_i4*)(lds + PG8_SB(b, h) + boff + n * 2048), l1_ = *(const PG8_LAS pg8_i4*)(lds + PG8_SB(b, h) + boff + n * 2048 + 1024); dst##8[n] = __builtin_shufflevector(l0_, l1_, 0, 1, 2, 3, 4, 5, 6, 7); } \
        else { _Pragma("unroll") for (int k = 0; k < 2; ++k) dst[n][k] = *(const PG8_LAS bf16x8*)(lds + PG8_SB(b, h) + boff + n * 2048 + k * 1024); } } } while (0)
#define PG8_MMA(ai, bj, At, Bt) do { __builtin_amdgcn_s_setprio(1); \
        if constexpr (DT == 1) { asm volatile("s_nop 1" ::: ); _Pragma("unroll") for (int m = 0; m < 4; ++m) _Pragma("unroll") for (int n = 0; n < 2; ++n) \
            asm volatile("v_mfma_f32_16x16x128_f8f6f4 %0, %1, %2, %0" : "+v"(acc[ai][bj][m][n]) : "v"(Bt##8[n]), "v"(At##8[m])); } \
        else { _Pragma("unroll") for (int m = 0; m < 4; ++m) _Pragma("unroll") for (int n = 0; n < 2; ++n) _Pragma("unroll") for (int k = 0; k < 2; ++k) \
            acc[ai][bj][m][n] = __builtin_amdgcn_mfma_f32_16x16x32_bf16(Bt[n][k], At[m][k], acc[ai][bj][m][n], 0, 0, 0); } \
        __builtin_amdgcn_s_setprio(0); } while (0)
#define PG8_WAIT_V(n) asm volatile("s_waitcnt vmcnt(" #n ")" ::: "memory")
#define PG8_WAIT_L(n) asm volatile("s_waitcnt lgkmcnt(" #n ")" ::: "memory")
#define PG8_BAR __builtin_amdgcn_s_barrier()
#define PG8_SCHED __builtin_amdgcn_sched_barrier(0)
    Unit cur, nxt; int ui = 0;
    if (!S.next(0, cur)) return;
    f32x4 acc[2][2][4][2];
    float zl_ = 0.f; asm volatile("" : "+v"(zl_));
#pragma unroll
    for (int a = 0; a < 2; ++a)
#pragma unroll
        for (int b = 0; b < 2; ++b)
#pragma unroll
            for (int m = 0; m < 4; ++m)
#pragma unroll
                for (int n = 0; n < 2; ++n) acc[a][b][m][n] = (f32x4){zl_, zl_, zl_, zl_};
    typedef int pg8_i4 __attribute__((ext_vector_type(4))); typedef int pg8_i8 __attribute__((ext_vector_type(8)));
    bf16x8 At[4][2], B0[2][2], B1[2][2]; pg8_i8 At8[4], B08[2], B18[2];
    (void)At; (void)B0; (void)B1; (void)At8; (void)B08; (void)B18;
    const char* cA = (const char*)g.A + (size_t)cur.pm * tstep; const char* cB = (const char*)g.Bt + (size_t)cur.pb * tstep;
    S.a_ready(cur);
    if constexpr (SP2) {
        PG8_STAGE(PG8_SB(0, 0), cB, voffB); PG8_STAGE(PG8_SB(0, 1), cB + hstep, voffB); PG8_STAGE(PG8_SA(0, 0), cA, voffA); PG8_STAGE(PG8_SA(0, 1), cA + hstep, voffA);
        if (wr == 1) PG8_BAR;
        PG8_WAIT_V(2); PG8_BAR;
        PG8_STAGE(PG8_SB(1, 0), cB + kstep, voffB); PG8_STAGE(PG8_SA(1, 0), cA + kstep, voffA); PG8_STAGE(PG8_SB(1, 1), cB + hstep + kstep, voffB);
        PG8_WAIT_V(6); PG8_BAR;
    } else {
        PG8_STAGE(PG8_SB(0, 0), cB, voffB); PG8_STAGE(PG8_SA(0, 0), cA, voffA); PG8_STAGE(PG8_SB(0, 1), cB + hstep, voffB); PG8_STAGE(PG8_SA(0, 1), cA + hstep, voffA);
        if (wr == 1) PG8_BAR;
        PG8_WAIT_V(4); PG8_BAR;
        PG8_STAGE(PG8_SB(1, 0), cB + kstep, voffB); PG8_STAGE(PG8_SA(1, 0), cA + kstep, voffA); PG8_STAGE(PG8_SB(1, 1), cB + hstep + kstep, voffB);
        PG8_WAIT_V(6); PG8_BAR;
    }
    for (;;) {
        const bool has_next = S.next(ui + 1, nxt);
        const char* nA = has_next ? (const char*)g.A + (size_t)nxt.pm * tstep : cA; const char* nB = has_next ? (const char*)g.Bt + (size_t)nxt.pb * tstep : cB;
        for (int t = 0; t < nt; t += 2) {
            const bool last = (t == nt - 2);
            const char* a1 = cA + (size_t)(t + 1) * kstep;
            const char* a2 = last ? nA : cA + (size_t)(t + 2) * kstep; const char* b2 = last ? nB : cB + (size_t)(t + 2) * kstep;
            const char* a3 = a2 + kstep; const char* b3 = b2 + kstep;
            if (last && has_next) S.a_ready(nxt);
            if constexpr (SP2) {
            PG8_LDB(B0, 0, 0); PG8_LDB(B1, 0, 1); PG8_SCHED; PG8_LDA(At, 0, 0); PG8_STAGE(PG8_SA(1, 1), a1 + hstep, voffA);
            PG8_WAIT_V(8); PG8_WAIT_L(0); PG8_BAR; PG8_MMA(0, 0, At, B0); PG8_MMA(0, 1, At, B1); PG8_BAR; PG8_SCHED;
            PG8_LDA(At, 0, 1); PG8_STAGE(PG8_SB(0, 0), b2, voffB); PG8_STAGE(PG8_SB(0, 1), b2 + hstep, voffB); PG8_STAGE(PG8_SA(0, 0), a2, voffA);
            PG8_WAIT_V(8); PG8_WAIT_L(0); PG8_BAR; PG8_MMA(1, 0, At, B0); PG8_MMA(1, 1, At, B1); PG8_BAR; PG8_SCHED;
            PG8_LDB(B0, 1, 0); PG8_LDB(B1, 1, 1); PG8_SCHED; PG8_LDA(At, 1, 0); PG8_STAGE(PG8_SA(0, 1), a2 + hstep, voffA);
            PG8_WAIT_V(8); PG8_WAIT_L(0); PG8_BAR; PG8_MMA(0, 0, At, B0); PG8_MMA(0, 1, At, B1); PG8_BAR; PG8_SCHED;
            PG8_LDA(At, 1, 1); PG8_STAGE(PG8_SB(1, 0), b3, voffB); PG8_STAGE(PG8_SB(1, 1), b3 + hstep, voffB); PG8_STAGE(PG8_SA(1, 0), a3, voffA);
            PG8_WAIT_V(8); PG8_WAIT_L(0); PG8_BAR; PG8_MMA(1, 0, At, B0); PG8_MMA(1, 1, At, B1); PG8_BAR; PG8_SCHED;
            } else {
            PG8_LDB(B0, 0, 0); PG8_SCHED; PG8_LDA(At, 0, 0); PG8_STAGE(PG8_SA(1, 1), a1 + hstep, voffA);
            PG8_WAIT_L(8); PG8_BAR; PG8_WAIT_L(0); PG8_MMA(0, 0, At, B0); PG8_BAR; PG8_SCHED;
            PG8_LDB(B1, 0, 1); PG8_STAGE(PG8_SB(0, 0), b2, voffB);
            PG8_BAR; PG8_WAIT_L(0); PG8_MMA(0, 1, At, B1); PG8_BAR;
            PG8_LDA(At, 0, 1); PG8_STAGE(PG8_SA(0, 0), a2, voffA);
            PG8_BAR; PG8_WAIT_L(0); PG8_MMA(1, 0, At, B0); PG8_BAR; PG8_SCHED;
            PG8_STAGE(PG8_SB(0, 1), b2 + hstep, voffB);
            PG8_WAIT_V(6); PG8_BAR; PG8_MMA(1, 1, At, B1); PG8_BAR;
            PG8_LDB(B0, 1, 0); PG8_SCHED; PG8_LDA(At, 1, 0); PG8_STAGE(PG8_SA(0, 1), a2 + hstep, voffA);
            PG8_WAIT_L(8); PG8_BAR; PG8_WAIT_L(0); PG8_MMA(0, 0, At, B0); PG8_BAR; PG8_SCHED;
            PG8_LDB(B1, 1, 1); PG8_STAGE(PG8_SB(1, 0), b3, voffB);
            PG8_BAR; PG8_WAIT_L(0); PG8_MMA(0, 1, At, B1); PG8_BAR;
            PG8_LDA(At, 1, 1); PG8_STAGE(PG8_SA(1, 0), a3, voffA);
            PG8_BAR; PG8_WAIT_L(0); PG8_MMA(1, 0, At, B0); PG8_BAR; PG8_SCHED;
            PG8_STAGE(PG8_SB(1, 1), b3 + hstep, voffB);
            PG8_WAIT_V(6); PG8_BAR; PG8_MMA(1, 1, At, B1); PG8_BAR;
            }
        }
        if constexpr (DT == 1) asm volatile("s_nop 15\n\ts_nop 15" ::: );
        if constexpr (ALIGN_EPI) { if (wr == 0) PG8_BAR; }
        if constexpr (!Epi::AFTER_DRAIN) { E(acc, cur, wr, wc, fr, fq); S.done(cur); }
        if (!has_next) break;
        float zl2_ = 0.f; asm volatile("" : "+v"(zl2_));
#pragma unroll
        for (int a = 0; a < 2; ++a)
#pragma unroll
            for (int b = 0; b < 2; ++b)
#pragma unroll
                for (int m = 0; m < 4; ++m)
#pragma unroll
                    for (int n = 0; n < 2; ++n) acc[a][b][m][n] = (f32x4){zl2_, zl2_, zl2_, zl2_};
        cur = nxt; cA = nA; cB = nB; ++ui;
        if constexpr (ALIGN_EPI) { if (wr == 1) PG8_BAR; }
    }
    PG8_WAIT_V(0);
    if constexpr (!ALIGN_EPI) { if (wr == 0) PG8_BAR; }
    PG8_BAR;
    if constexpr (Epi::AFTER_DRAIN) { E.fused(acc, cur, wr, wc, fr, fq, lds, wid, lane); S.done(cur); }
#undef PG8_SA
#undef PG8_SB
#undef PG8_STAGE
#undef PG8_LDA
#undef PG8_LDB
#undef PG8_MMA
#undef PG8_WAIT_V
#undef PG8_WAIT_L
#undef PG8_BAR
#undef PG8_SCHED
}
}

constexpr int BATCH = 8, SEQ = 4096, D = 1024, M = BATCH * SEQ, DEPTH = 4;
constexpr int DPOOL = 512, NPG = 4, PGC = 128, DML = 512, NH = 4, DH = 128, CONVW = 4;
constexpr int DIN = 2568, NZ = 2560;
constexpr int ZQ = 512, ZK = 1024, ZV = 1536, ZO = 2048;
constexpr int FFD = 2816, NE = 8, FFE = 3584;
constexpr float ALPHA = 1.6817928305074290f;
constexpr float LN_EPS = 1e-5f;
constexpr float KSCALE = 0.08838834764831845f;
constexpr int NWAVES = 8, NTHR = 512;
constexpr float F8_WSC = 64.0f, F8_HSC = 8.0f, F8_DSC = 256.0f, F8_ASC = 8.0f;
constexpr int MAX_TILES = 2 * M / 256 + NE, PASS_TILES = MAX_TILES, NPASS = 1;
constexpr int NPH = 18, NPHASES = 1 + DEPTH * NPH;

constexpr size_t MiB = 1u << 20;
constexpr size_t WS_CTL = 0, CTL_ZERO_BYTES = 2 * MiB;
constexpr size_t WS_GATE = 2 * MiB;
constexpr size_t WS_PWT = 3 * MiB;
constexpr size_t WS_MOE = 4 * MiB;
constexpr size_t MOE_TOK_E = WS_MOE, MOE_TOK_POS = WS_MOE + 256 * 1024, MOE_TOK_W = WS_MOE + 512 * 1024, MOE_TOK_SLOT = WS_MOE + 768 * 1024,
                 MOE_BLK_CNT = WS_MOE + 1024 * 1024, MOE_TILE_E = MOE_BLK_CNT + 8192, MOE_META = MOE_TILE_E + 4096;
constexpr size_t WS_WIN = 8 * MiB, WS_WOUT = 28 * MiB, WS_WGU = 36 * MiB, WS_WD = 58 * MiB, WS_EGU = 70 * MiB, WS_ED = 182 * MiB;
constexpr size_t WS_T = 238 * MiB;
constexpr size_t WS_XB = 302 * MiB;
constexpr size_t WS_R2 = 366 * MiB;
constexpr size_t WS_R3 = 606 * MiB;
constexpr size_t WS_R4 = 738 * MiB;
constexpr size_t WS_END = 870 * MiB;
constexpr size_t IN_FLOATS = (size_t)M * D + (size_t)DEPTH * D * DIN + 32 + 16384 + 4096 + 262144 + 2048 + 2048 + (size_t)DEPTH * D * D + 4 * 4096 + 3 * (size_t)2 * D * FFD + 16384 + 16 + 3 * (size_t)2 * NE * D * FFE;
static_assert(WS_END <= IN_FLOATS * 4, "workspace map exceeds the guaranteed d_ws size");
static_assert(WS_WIN + (size_t)DEPTH * NZ * D * 2 <= WS_WOUT && WS_WOUT + (size_t)DEPTH * D * D * 2 <= WS_WGU && WS_WGU + (size_t)2 * 2 * FFD * D * 2 <= WS_WD && WS_WD + (size_t)2 * D * FFD * 2 <= WS_EGU, "ws map 1");
static_assert(WS_EGU + (size_t)NE * 2 * FFE * D * 2 <= WS_ED && WS_ED + (size_t)NE * D * FFE * 2 <= WS_T && WS_T + (size_t)M * D * 2 <= WS_XB && WS_XB + (size_t)M * D * 2 <= WS_R2, "ws map 2");
static_assert(WS_R2 + (size_t)M * FFD * 2 <= WS_R3 && WS_R2 + (size_t)M * NZ * 2 <= WS_R3 && WS_R2 + (size_t)MAX_TILES * 256 * FFE <= WS_R3, "ws map 3");
static_assert(WS_R3 + (size_t)(2 * M + NE * 256) * D * 2 <= WS_R4 && WS_R4 + (size_t)(2 * M + NE * 256) * D * 2 <= WS_END && (size_t)M * 1024 * 2 + (size_t)M * 512 * 4 <= WS_END - WS_R4, "ws map 4");
constexpr int CW_BAR = 4096;
constexpr int LDS_BYTES = 147456, RING_BYTES = 131072, MISC_OFF = LDS_BYTES - 256;

#define GAS __attribute__((address_space(1)))
#define LAS __attribute__((address_space(3)))
typedef unsigned short bf16;
typedef unsigned v4u __attribute__((ext_vector_type(4)));
typedef unsigned v2u __attribute__((ext_vector_type(2)));
typedef float f32x4 __attribute__((ext_vector_type(4)));
#define LDS_WAIT() asm volatile("s_waitcnt lgkmcnt(0)" ::: "memory")
__device__ __forceinline__ unsigned f2bf(float f) { unsigned u = __builtin_bit_cast(unsigned, f); return (u + 0x7fffu + ((u >> 16) & 1u)) >> 16; }
typedef __bf16 bf16x2_hw __attribute__((ext_vector_type(2)));
typedef float f32x2_hw __attribute__((ext_vector_type(2)));
__device__ __forceinline__ unsigned pk2(float lo, float hi) { const f32x2_hw v = {lo, hi}; return __builtin_bit_cast(unsigned, __builtin_convertvector(v, bf16x2_hw)); }
__device__ __forceinline__ unsigned f8x4(float a, float b, float c, float d) {
    a = fminf(fmaxf(a, -448.f), 448.f); b = fminf(fmaxf(b, -448.f), 448.f); c = fminf(fmaxf(c, -448.f), 448.f); d = fminf(fmaxf(d, -448.f), 448.f);
    int r = __builtin_amdgcn_cvt_pk_fp8_f32(a, b, 0, false); r = __builtin_amdgcn_cvt_pk_fp8_f32(c, d, r, true); return (unsigned)r; }
__device__ __forceinline__ float bf2f(unsigned short b) { return __builtin_bit_cast(float, (unsigned)b << 16); }
__device__ __forceinline__ float bflo(unsigned w) { return __builtin_bit_cast(float, w << 16); }
__device__ __forceinline__ float bfhi(unsigned w) { return __builtin_bit_cast(float, w & 0xffff0000u); }
__device__ __forceinline__ int lane_id_v() { int l; asm volatile("v_mbcnt_lo_u32_b32 %0, -1, 0\n\tv_mbcnt_hi_u32_b32 %0, -1, %0" : "=v"(l)); return l; }
__device__ __forceinline__ float my_shfl_xor(float v, int o) { const int l = lane_id_v(); return __builtin_bit_cast(float, __builtin_amdgcn_ds_bpermute((l ^ o) << 2, __builtin_bit_cast(int, v))); }
__device__ __forceinline__ float my_shfl_up(float v, int o) { const int l = lane_id_v(); const int s = (l - o) < 0 ? l : (l - o); return __builtin_bit_cast(float, __builtin_amdgcn_ds_bpermute(s << 2, __builtin_bit_cast(int, v))); }
__device__ __forceinline__ int my_shfl_up(int v, int o) { const int l = lane_id_v(); const int s = (l - o) < 0 ? l : (l - o); return __builtin_amdgcn_ds_bpermute(s << 2, v); }
#define __shfl_xor(v, o) my_shfl_xor((v), (o))
#define __shfl_up(v, o) my_shfl_up((v), (o))
__device__ __forceinline__ float wave_sum(float v) {
#pragma unroll
    for (int o = 1; o < 64; o <<= 1) v += __shfl_xor(v, o);
    return v;
}
__device__ __forceinline__ float sigmoid_f(float x) { return 1.0f / (1.0f + __expf(-x)); }
#define XB_TMO      128
#define XB_XCNT(j)  (256  + 64 * (j))
#define XB_XSUB(j)  (1280 + 64 * (j))
#define XB_XGEN(j)  (2304 + 64 * (j))
#define XB_TOP      3328
#define XB_TOPGEN   3392
#define XCD_BAR_WORDS 3456
#define XB_SPIN_CAP (1u << 18)

__device__ __forceinline__ unsigned xb_ld(unsigned* p)              { return __hip_atomic_load(p, __ATOMIC_RELAXED, __HIP_MEMORY_SCOPE_AGENT); }
__device__ __forceinline__ unsigned xb_add(unsigned* p, unsigned v) { return __hip_atomic_fetch_add(p, v, __ATOMIC_RELAXED, __HIP_MEMORY_SCOPE_AGENT); }
__device__ __forceinline__ unsigned xb_xcc_id() { return (unsigned)__builtin_amdgcn_s_getreg((3 << 11) | 20) & 0xFu; }
#define XB_SPIN(cond, bar) do { unsigned _sp = 0; while (cond) { __builtin_amdgcn_s_sleep(1); \
    if ((++_sp & 255u) == 0u) { if (xb_ld(&(bar)[XB_TMO])) break; if (_sp > XB_SPIN_CAP) { atomicAdd(&(bar)[XB_TMO], 1u); break; } } } } while (0)

struct XcdBarrier {
    unsigned* bar; unsigned x;
    volatile LAS unsigned* st;
};

__device__ __forceinline__ XcdBarrier xcd_barrier_post(unsigned* bar, volatile LAS unsigned* st) {
    XcdBarrier b; b.bar = bar; b.x = xb_xcc_id(); b.st = st;
    if (threadIdx.x == 0) (void)xb_add(&bar[XB_XCNT(b.x)], 1u);
    return b;
}
__device__ __forceinline__ void xcd_barrier_complete(unsigned* bar, unsigned x, unsigned& nloc, unsigned& nx) {
    const unsigned G = gridDim.x * gridDim.y * gridDim.z;
    unsigned sum, cnt, mine, sp = 0u;
    for (;;) {
        sum = 0u; cnt = 0u; mine = 0u;
#pragma unroll
        for (unsigned j = 0; j < 16; ++j) { const unsigned c = xb_ld(&bar[XB_XCNT(j)]); sum += c; cnt += (c > 0u) ? 1u : 0u; mine = (j == x) ? c : mine; }
        if (sum == G) break;
        __builtin_amdgcn_s_sleep(1);
        if ((++sp & 255u) == 0u) { if (xb_ld(&bar[XB_TMO])) break; if (sp > XB_SPIN_CAP) { atomicAdd(&bar[XB_TMO], 1u); break; } }
    }
    nloc = mine > 0u ? mine : 1u; nx = cnt > 0u ? cnt : 1u;
}

__device__ __forceinline__ void xcd_barrier(const XcdBarrier& b) {
    asm volatile("s_waitcnt vmcnt(0)" ::: "memory");
    __syncthreads();
    if (threadIdx.x == 0) {
        unsigned* bar = b.bar;
        __builtin_amdgcn_s_waitcnt(0);
        unsigned nloc = b.st[0], nx = b.st[1];
        if (nloc == 0u) { xcd_barrier_complete(bar, b.x, nloc, nx); b.st[0] = nloc; b.st[1] = nx; }
        const unsigned old = xb_add(&bar[XB_XSUB(b.x)], 1u);
        const unsigned gen = old / nloc;
        if (old + 1u == (gen + 1u) * nloc) {
            __builtin_amdgcn_fence(__ATOMIC_RELEASE, "agent");
            asm volatile("s_waitcnt vmcnt(0)" ::: "memory");
            const unsigned og = xb_add(&bar[XB_TOP], 1u);
            const unsigned tgt = (og / nx + 1u) * nx;
            if (og + 1u != tgt) XB_SPIN(xb_ld(&bar[XB_TOP]) < tgt, bar);
            xb_add(&bar[XB_XGEN(b.x)], 1u);
            __builtin_amdgcn_fence(__ATOMIC_ACQUIRE, "agent");
            asm volatile("s_waitcnt vmcnt(0)" ::: "memory");
        } else {
            XB_SPIN(xb_ld(&bar[XB_XGEN(b.x)]) == gen, bar);
            __builtin_amdgcn_fence(__ATOMIC_ACQUIRE, "agent");
            asm volatile("s_waitcnt vmcnt(0)" ::: "memory");
        }
    }
    __syncthreads();
}

struct Args { const float* in[21]; float* out; unsigned char* ws; int ph_lo, ph_hi, li, pad; };
static_assert(sizeof(Args) == 21 * 8 + 8 + 8 + 16, "Args has no padding");
typedef const __attribute__((address_space(4))) Args* ArgsP;
struct Ctx {
    LAS unsigned char* lds; int tid, lane, wave, G, bid;
    ArgsP Ap;
};
__device__ __forceinline__ Ctx make_ctx(unsigned char* lds_raw, int wave_s) {
    const int tid = wave_s * 64 + lane_id_v();
    ArgsP ap = (ArgsP)__builtin_amdgcn_kernarg_segment_ptr(); asm volatile("" : "+s"(ap));
    int G = (int)gridDim.x, bid = (int)blockIdx.x; asm volatile("" : "+s"(G), "+s"(bid));
    Ctx C{(LAS unsigned char*)lds_raw, tid, tid & 63, wave_s, G, bid, ap};
    return C;
}
enum { I_X = 0, I_WIN, I_BG, I_CW, I_CB, I_PW, I_PS, I_MG, I_WOUT, I_L1G, I_L1B, I_L2G, I_L2B, I_WGD, I_WUD, I_WDD, I_WR, I_BR, I_WGE, I_WUE, I_WDE };
#define WSP(T, off) ((T*)(C.Ap->ws + (off)))

template <bool F8 = false> __device__ __forceinline__ void cvt_item(const float* W, int ldw, int K, int k0, int nsrc0, bf16* WT, int drow0, LAS float* scr, int lane, float fsc = 1.0f) {
    f32x4 t[16];
#pragma unroll
    for (int i = 0; i < 16; ++i) t[i] = *(const f32x4*)(W + (size_t)(k0 + (lane >> 4) + 4 * i) * ldw + nsrc0 + 4 * (lane & 15));
#pragma unroll
    for (int i = 0; i < 16; ++i) { LAS float* p = scr + ((lane >> 4) + 4 * i) * 65 + 4 * (lane & 15); p[0] = t[i].x; p[1] = t[i].y; p[2] = t[i].z; p[3] = t[i].w; }
    LDS_WAIT(); asm volatile("" ::: "memory");
    const int c = lane & 7;
#pragma unroll
    for (int j = 0; j < 8; ++j) { const int n = (lane >> 3) + 8 * j; const LAS float* s = scr + (8 * c) * 65 + n;
        if constexpr (F8) { v2u o; o.x = f8x4(s[0 * 65] * fsc, s[1 * 65] * fsc, s[2 * 65] * fsc, s[3 * 65] * fsc); o.y = f8x4(s[4 * 65] * fsc, s[5 * 65] * fsc, s[6 * 65] * fsc, s[7 * 65] * fsc);
            *(v2u*)((unsigned char*)WT + (size_t)(drow0 + n) * K + k0 + 8 * c) = o; }
        else { v4u o; o.x = pk2(s[0 * 65], s[1 * 65]); o.y = pk2(s[2 * 65], s[3 * 65]); o.z = pk2(s[4 * 65], s[5 * 65]); o.w = pk2(s[6 * 65], s[7 * 65]);
            *(v4u*)(WT + (size_t)(drow0 + n) * K + k0 + 8 * c) = o; } }
    LDS_WAIT(); asm volatile("" ::: "memory");
}
template <int MODE, bool F8 = false> __device__ __forceinline__ void cvt_mat(const float* W, int ldw, int K, int ncols, bf16* WT, int item, LAS float* scr, int lane, float fsc = 1.0f) {
    const int nblk = ncols / 64, kb = item / nblk, nb = item % nblk, n0 = 64 * nb;
    const int drow0 = MODE == 0 ? n0 : ((n0 >> 7) * 256 + (n0 & 127) + (MODE == 2 ? 128 : 0));
    cvt_item<F8>(W, ldw, K, 64 * kb, n0, WT, drow0, scr, lane, fsc);
}
constexpr int CVT_SCR = 64 * 65 * 4;
constexpr int IT_WIN = (D / 64) * (NZ / 64), IT_WOUT = (D / 64) * (D / 64), IT_G = (D / 64) * (FFD / 64), IT_DD = (FFD / 64) * (D / 64), IT_EG = (D / 64) * (FFE / 64), IT_ED = (FFE / 64) * (D / 64);
static_assert(8 * CVT_SCR <= MISC_OFF && NZ % 64 == 0 && FFD % 64 == 0 && FFE % 64 == 0, "converter tiles");
__device__ __forceinline__ void convert_experts(Ctx& C, int j) {
    LAS float* scr = (LAS float*)(C.lds + C.wave * CVT_SCR);
    const int gw = C.bid * NWAVES + C.wave, NGW = C.G * NWAVES;
    static_assert(IT_EG == IT_ED, "expert item counts");
    for (int it = gw; it < 3 * NE * IT_EG; it += NGW) {
        const int kind = it / (NE * IT_EG), e = (it / IT_EG) % NE, r = it % IT_EG;
        if (kind == 0) cvt_mat<1, true>(C.Ap->in[I_WGE] + (size_t)(j * NE + e) * D * FFE, FFE, D, FFE, (bf16*)(WSP(unsigned char, WS_EGU) + (size_t)e * 2 * FFE * D), r, scr, C.lane, F8_WSC);
        else if (kind == 1) cvt_mat<2, true>(C.Ap->in[I_WUE] + (size_t)(j * NE + e) * D * FFE, FFE, D, FFE, (bf16*)(WSP(unsigned char, WS_EGU) + (size_t)e * 2 * FFE * D), r, scr, C.lane, F8_WSC);
        else cvt_mat<0, true>(C.Ap->in[I_WDE] + (size_t)(j * NE + e) * FFE * D, D, FFE, D, (bf16*)(WSP(unsigned char, WS_ED) + (size_t)e * D * FFE), r, scr, C.lane, F8_DSC);
    }
}
__device__ __forceinline__ void load_w8(Ctx& C, LAS float* wl, const float* W, int ldw, int coff) {
    for (int k = C.tid; k < D; k += NTHR) { const float* p = W + (size_t)k * ldw + coff;
#pragma unroll
        for (int g = 0; g < 8; ++g) wl[g * 1024 + k] = p[g]; }
}
__device__ __forceinline__ int colof(int j, int lane) { return (j >> 1) * 512 + 8 * lane + (j & 1) * 4; }
__device__ __forceinline__ void load_vec_f32(const float* p, f32x4 (&v)[4], int lane) {
#pragma unroll
    for (int j = 0; j < 4; ++j) v[j] = *(const f32x4*)(p + colof(j, lane));
}
__device__ __forceinline__ void store_row_f32(float* row, const f32x4 (&v)[4], int lane) {
#pragma unroll
    for (int j = 0; j < 4; ++j) *(f32x4*)(row + colof(j, lane)) = v[j];
}
__device__ __forceinline__ void load_row_bf16(const bf16* row, f32x4 (&v)[4], int lane) {
    const v4u a = *(const v4u*)(row + 8 * lane), b = *(const v4u*)(row + 512 + 8 * lane);
    v[0] = (f32x4){bflo(a.x), bfhi(a.x), bflo(a.y), bfhi(a.y)}; v[1] = (f32x4){bflo(a.z), bfhi(a.z), bflo(a.w), bfhi(a.w)};
    v[2] = (f32x4){bflo(b.x), bfhi(b.x), bflo(b.y), bfhi(b.y)}; v[3] = (f32x4){bflo(b.z), bfhi(b.z), bflo(b.w), bfhi(b.w)};
}
__device__ __forceinline__ void store_row_bf16(bf16* row, const f32x4 (&v)[4], int lane) {
    v4u a, b; a.x = pk2(v[0].x, v[0].y); a.y = pk2(v[0].z, v[0].w); a.z = pk2(v[1].x, v[1].y); a.w = pk2(v[1].z, v[1].w);
    b.x = pk2(v[2].x, v[2].y); b.y = pk2(v[2].z, v[2].w); b.z = pk2(v[3].x, v[3].y); b.w = pk2(v[3].z, v[3].w);
    *(v4u*)(row + 8 * lane) = a; *(v4u*)(row + 512 + 8 * lane) = b;
}
__device__ __forceinline__ void load_row_res(const bf16* trow, const bf16* xrow, f32x4 (&v)[4], int lane) {
    f32x4 t[4], x[4]; load_row_bf16(trow, t, lane); load_row_bf16(xrow, x, lane);
#pragma unroll
    for (int j = 0; j < 4; ++j) v[j] = x[j] * ALPHA + t[j];
}
__device__ __forceinline__ float dot8(const f32x4 (&v)[4], const LAS float* wl, int lane) {
    float a[8];
#pragma unroll
    for (int g = 0; g < 8; ++g) { float s = 0.f;
#pragma unroll
        for (int j = 0; j < 4; ++j) { const f32x4 w = *(const LAS f32x4*)(wl + g * 1024 + colof(j, lane)); s += (v[j].x * w.x + v[j].y * w.y) + (v[j].z * w.z + v[j].w * w.w); }
        a[g] = s; }
    float b4[4], b2[2], b1;
    { const bool hi = (lane & 32) != 0;
#pragma unroll
      for (int i = 0; i < 4; ++i) { const float keep = hi ? a[i + 4] : a[i], send = hi ? a[i] : a[i + 4]; b4[i] = keep + __shfl_xor(send, 32); } }
    { const bool hi = (lane & 16) != 0;
#pragma unroll
      for (int i = 0; i < 2; ++i) { const float keep = hi ? b4[i + 2] : b4[i], send = hi ? b4[i] : b4[i + 2]; b2[i] = keep + __shfl_xor(send, 16); } }
    { const bool hi = (lane & 8) != 0; const float keep = hi ? b2[1] : b2[0], send = hi ? b2[0] : b2[1]; b1 = keep + __shfl_xor(send, 8); }
    b1 += __shfl_xor(b1, 4); b1 += __shfl_xor(b1, 2); b1 += __shfl_xor(b1, 1);
    return b1;
}
__device__ __forceinline__ void write_gates(Ctx& C, int lnext, int m, const f32x4 (&v)[4], const LAS float* wl) {
    const float val = dot8(v, wl, C.lane);
    if ((C.lane & 7) == 0) WSP(float, WS_GATE)[(size_t)m * 8 + (C.lane >> 3)] = val + C.Ap->in[I_BG][lnext * 8 + (C.lane >> 3)];
}

__device__ __forceinline__ void phase_prologue(Ctx& C) {
    LAS float* scr = (LAS float*)(C.lds + C.wave * CVT_SCR);
    const int gw = C.bid * NWAVES + C.wave, NGW = C.G * NWAVES;
    constexpr int IT_PW = (PGC / 64) * (PGC / 64);
    constexpr int NI = 4 * IT_WIN + 4 * IT_WOUT + 4 * IT_G + 2 * IT_DD + DEPTH * NPG * IT_PW;
    for (int it = gw; it < NI; it += NGW) {
        int r = it;
        if (r < 4 * IT_WIN) { const int l = r / IT_WIN; cvt_mat<0>(C.Ap->in[I_WIN] + (size_t)l * D * DIN, DIN, D, NZ, WSP(bf16, WS_WIN) + (size_t)l * NZ * D, r % IT_WIN, scr, C.lane); continue; } r -= 4 * IT_WIN;
        if (r < 4 * IT_WOUT) { const int l = r / IT_WOUT; cvt_mat<0>(C.Ap->in[I_WOUT] + (size_t)l * D * D, D, D, D, WSP(bf16, WS_WOUT) + (size_t)l * D * D, r % IT_WOUT, scr, C.lane); continue; } r -= 4 * IT_WOUT;
        if (r < 2 * IT_G) { const int j = r / IT_G; cvt_mat<1>(C.Ap->in[I_WGD] + (size_t)j * D * FFD, FFD, D, FFD, WSP(bf16, WS_WGU) + (size_t)j * 2 * FFD * D, r % IT_G, scr, C.lane); continue; } r -= 2 * IT_G;
        if (r < 2 * IT_G) { const int j = r / IT_G; cvt_mat<2>(C.Ap->in[I_WUD] + (size_t)j * D * FFD, FFD, D, FFD, WSP(bf16, WS_WGU) + (size_t)j * 2 * FFD * D, r % IT_G, scr, C.lane); continue; } r -= 2 * IT_G;
        if (r < 2 * IT_DD) { const int j = r / IT_DD; cvt_mat<0, true>(C.Ap->in[I_WDD] + (size_t)j * FFD * D, D, FFD, D, (bf16*)(WSP(unsigned char, WS_WD) + (size_t)j * D * FFD), r % IT_DD, scr, C.lane, F8_DSC); continue; } r -= 2 * IT_DD;
        { const int lg = r / IT_PW; cvt_mat<0>(C.Ap->in[I_PW] + (size_t)lg * PGC * PGC, PGC, PGC, PGC, WSP(bf16, WS_PWT) + (size_t)lg * PGC * PGC, r % IT_PW, scr, C.lane); }
    }
    convert_experts(C, 0);
    __syncthreads();
    LAS float* wl = (LAS float*)C.lds;
    load_w8(C, wl, C.Ap->in[I_WIN], DIN, NZ);
    __syncthreads();
    f32x4 vnx[4]; if (gw < M) load_vec_f32(C.Ap->in[I_X] + (size_t)gw * D, vnx, C.lane);
    for (int m = gw; m < M; m += NGW) {
        f32x4 v[4];
#pragma unroll
        for (int j = 0; j < 4; ++j) v[j] = vnx[j];
        if (m + NGW < M) load_vec_f32(C.Ap->in[I_X] + (size_t)(m + NGW) * D, vnx, C.lane);
        store_row_bf16(WSP(bf16, WS_XB) + (size_t)m * D, v, C.lane);
        write_gates(C, 0, m, v, wl);
    }
}

__device__ __forceinline__ void phase_conv(Ctx& C, int l) {
    const bf16* Z = WSP(bf16, WS_R2); bf16* QK = WSP(bf16, WS_R4);
    const int c8 = (C.tid & 127) * 8; const float sc = c8 >= 512 ? KSCALE : 1.0f;
    const float* cw = C.Ap->in[I_CW] + (size_t)l * CONVW * 1024 + c8; const float* cb = C.Ap->in[I_CB] + (size_t)l * 1024 + c8;
    float w[CONVW][8], bias[8];
#pragma unroll
    for (int j = 0; j < CONVW; ++j) { const f32x4 a = *(const f32x4*)(cw + j * 1024), b2 = *(const f32x4*)(cw + j * 1024 + 4);
        w[j][0] = a.x; w[j][1] = a.y; w[j][2] = a.z; w[j][3] = a.w; w[j][4] = b2.x; w[j][5] = b2.y; w[j][6] = b2.z; w[j][7] = b2.w; }
    { const f32x4 a = *(const f32x4*)cb, b2 = *(const f32x4*)(cb + 4); bias[0] = a.x; bias[1] = a.y; bias[2] = a.z; bias[3] = a.w; bias[4] = b2.x; bias[5] = b2.y; bias[6] = b2.z; bias[7] = b2.w; }
    const int tg0 = C.bid * (NTHR / 128) + (C.tid >> 7), TGS = C.G * (NTHR / 128);
    for (int tg = tg0; tg < M / 4; tg += TGS) {
        const int m0 = tg * 4, t0 = m0 & (SEQ - 1);
        v4u zr[7];
#pragma unroll
        for (int r = 0; r < 7; ++r) { zr[r] = (v4u){0u, 0u, 0u, 0u}; if (t0 - 3 + r >= 0) zr[r] = *(const v4u*)(Z + (size_t)(m0 - 3 + r) * NZ + ZQ + c8); }
#pragma unroll
        for (int i = 0; i < 4; ++i) { float a[8];
#pragma unroll
            for (int e = 0; e < 8; ++e) a[e] = bias[e];
#pragma unroll
            for (int j = 0; j < CONVW; ++j) { const v4u zz = zr[i + j];
                a[0] += w[j][0] * bflo(zz.x); a[1] += w[j][1] * bfhi(zz.x); a[2] += w[j][2] * bflo(zz.y); a[3] += w[j][3] * bfhi(zz.y);
                a[4] += w[j][4] * bflo(zz.z); a[5] += w[j][5] * bfhi(zz.z); a[6] += w[j][6] * bflo(zz.w); a[7] += w[j][7] * bfhi(zz.w); }
#pragma unroll
            for (int e = 0; e < 8; ++e) a[e] = a[e] * sigmoid_f(a[e]) * sc;
            v4u o; o.x = pk2(a[0], a[1]); o.y = pk2(a[2], a[3]); o.z = pk2(a[4], a[5]); o.w = pk2(a[6], a[7]);
            *(v4u*)(QK + (size_t)(m0 + i) * 1024 + c8) = o; }
    }
}

__device__ __forceinline__ void phase_pool(Ctx& C, int l) {
    typedef short bf16x8 __attribute__((ext_vector_type(8)));
    const bf16* Z = WSP(bf16, WS_R2); bf16* YC = WSP(bf16, WS_R3); const bf16* PWT = WSP(bf16, WS_PWT) + (size_t)l * NPG * PGC * PGC;
    constexpr int UROW = 272, DOFF = 80 * UROW, USZ = DOFF + 64 * UROW;
    static_assert(2 * USZ <= MISC_OFF, "pool LDS");
    LAS unsigned char* L = C.lds;
    const int tid = C.tid, lane = C.lane, w = C.wave, lr = lane & 15, lg = lane >> 4;
    const int NU = (M / 64) * NPG;
    int gprev[2] = {-1, -1}; bf16x8 xw[2][4]; f32x4 sc[2];
#pragma unroll
    for (int s = 0; s < 2; ++s) { sc[s] = (f32x4){0.f, 0.f, 0.f, 0.f};
#pragma unroll
        for (int ks = 0; ks < 4; ++ks) xw[s][ks] = (bf16x8){0, 0, 0, 0, 0, 0, 0, 0}; }
    v4u pu[2][3];
#define PL_LOAD(s_, u_) do { if ((u_) < NU) { const int g_ = (u_) & 3, m0_ = ((u_) >> 2) * 64, t0_ = m0_ & (SEQ - 1); _Pragma("unroll") for (int i_ = 0; i_ < 3; ++i_) { const int p_ = tid + NTHR * i_, r_ = p_ >> 4, ch_ = p_ & 15; \
        pu[s_][i_] = (v4u){0u, 0u, 0u, 0u}; if (r_ < 79 && t0_ - 15 + r_ >= 0) pu[s_][i_] = *(const v4u*)(Z + (size_t)(m0_ - 15 + r_) * NZ + g_ * PGC + ch_ * 8); } } } while (0)
#define PL_STORE(s_) do { _Pragma("unroll") for (int i_ = 0; i_ < 3; ++i_) { const int p_ = tid + NTHR * i_, r_ = p_ >> 4, ch_ = p_ & 15; if (r_ < 79) *(LAS v4u*)(L + (s_) * USZ + r_ * UROW + ch_ * 16) = pu[s_][i_]; } } while (0)
    PL_LOAD(0, C.bid); PL_LOAD(1, C.bid + C.G);
    for (int u0 = C.bid; u0 < NU; u0 += 2 * C.G) {
        const int nu = (u0 + C.G < NU) ? 2 : 1;
        __syncthreads();
        PL_STORE(0); if (nu > 1) PL_STORE(1);
#pragma unroll
        for (int s = 0; s < 2; ++s) { const int g = (u0 + s * C.G) & 3;
            if (s < nu && g != gprev[s]) { gprev[s] = g;
#pragma unroll
                for (int ks = 0; ks < 4; ++ks) xw[s][ks] = *(const bf16x8*)(PWT + (size_t)(g * PGC + 16 * w + lr) * PGC + 32 * ks + 8 * lg);
                sc[s] = *(const f32x4*)(C.Ap->in[I_PS] + (size_t)l * DPOOL + g * PGC + 16 * w + 4 * lg); } }
        __syncthreads();
        PL_LOAD(0, u0 + 2 * C.G); PL_LOAD(1, u0 + 3 * C.G);
#pragma unroll
        for (int s = 0; s < 2; ++s) if (s < nu) { const int u = u0 + s * C.G, g = u & 3, t0 = ((u >> 2) * 64) & (SEQ - 1);
          LAS unsigned char* Ls = L + s * USZ;
          const int cp = tid & 63, r0 = 8 * w, wn = 2 << g;
          float s0 = 0.f, s1 = 0.f;
          for (int j = 0; j < wn; ++j) { const unsigned x = *(const LAS unsigned*)(Ls + (r0 + 15 - j) * UROW + cp * 4); s0 += bflo(x); s1 += bfhi(x); }
#pragma unroll
          for (int i = 0; i < 8; ++i) { const int r = r0 + i, t = t0 + r;
              const unsigned xc = *(const LAS unsigned*)(Ls + (r + 15) * UROW + cp * 4);
              if (i > 0) { const unsigned xo = *(const LAS unsigned*)(Ls + (r + 15 - wn) * UROW + cp * 4); s0 += bflo(xc) - bflo(xo); s1 += bfhi(xc) - bfhi(xo); }
              const float inv = 1.0f / (float)((t + 1) < wn ? (t + 1) : wn);
              *(LAS unsigned*)(Ls + DOFF + r * UROW + cp * 4) = pk2(s0 * inv - bflo(xc), s1 * inv - bfhi(xc)); } }
        __syncthreads();
#pragma unroll
        for (int s = 0; s < 2; ++s) if (s < nu) { const int u = u0 + s * C.G, g = u & 3, m0 = (u >> 2) * 64;
#pragma unroll
          for (int rt = 0; rt < 4; ++rt) { f32x4 acc = {0.f, 0.f, 0.f, 0.f};
#pragma unroll
            for (int ks = 0; ks < 4; ++ks) { const bf16x8 y = *(const LAS bf16x8*)(L + s * USZ + DOFF + (16 * rt + lr) * UROW + (32 * ks + 8 * lg) * 2); acc = __builtin_amdgcn_mfma_f32_16x16x32_bf16(xw[s][ks], y, acc, 0, 0, 0); }
            acc = acc * sc[s]; v2u o; o.x = pk2(acc[0], acc[1]); o.y = pk2(acc[2], acc[3]);
            *(v2u*)(YC + (size_t)(m0 + 16 * rt + lr) * D + g * PGC + 16 * w + 4 * lg) = o; } }
    }
#undef PL_LOAD
#undef PL_STORE
}

__device__ __forceinline__ void ln_apply(f32x4 (&v)[4], const f32x4 (&g)[4], const f32x4 (&b)[4]) {
    float s = 0.f;
#pragma unroll
    for (int j = 0; j < 4; ++j) s += (v[j].x + v[j].y) + (v[j].z + v[j].w);
    const float mean = wave_sum(s) * (1.0f / D); float s2 = 0.f;
#pragma unroll
    for (int j = 0; j < 4; ++j) { v[j] = v[j] - mean; s2 += (v[j].x * v[j].x + v[j].y * v[j].y) + (v[j].z * v[j].z + v[j].w * v[j].w); }
    const float rstd = 1.0f / sqrtf(wave_sum(s2) * (1.0f / D) + LN_EPS);
#pragma unroll
    for (int j = 0; j < 4; ++j) v[j] = v[j] * rstd * g[j] + b[j];
}

template <bool MOE> __device__ __forceinline__ void phase_ln1(Ctx& C, int l) {
    const bf16* T = WSP(bf16, WS_T); bf16* XB = WSP(bf16, WS_XB);
    f32x4 g[4], b[4]; load_vec_f32(C.Ap->in[I_L1G] + (size_t)l * D, g, C.lane); load_vec_f32(C.Ap->in[I_L1B] + (size_t)l * D, b, C.lane);
    if constexpr (!MOE) {
        const int gw = C.bid * NWAVES + C.wave, NGW = C.G * NWAVES;
        f32x4 v[4]; if (gw < M) load_row_res(T + (size_t)gw * D, XB + (size_t)gw * D, v, C.lane);
        for (int m = gw; m < M; m += NGW) {
            f32x4 vn[4]; if (m + NGW < M) load_row_res(T + (size_t)(m + NGW) * D, XB + (size_t)(m + NGW) * D, vn, C.lane);
            ln_apply(v, g, b);
            store_row_bf16(XB + (size_t)m * D, v, C.lane);
#pragma unroll
            for (int j = 0; j < 4; ++j) v[j] = vn[j];
        }
    } else {
        const int jm = l >> 1;
        LAS float* wl = (LAS float*)C.lds;
        LAS int* sel = (LAS int*)(C.lds + 32768);
        LAS int* cnth = sel + 128;
        int* tok_e = WSP(int, MOE_TOK_E); int* tok_pos = WSP(int, MOE_TOK_POS); float* tok_w = WSP(float, MOE_TOK_W); int* blk_cnt = WSP(int, MOE_BLK_CNT);
        load_w8(C, wl, C.Ap->in[I_WR] + (size_t)jm * D * NE, NE, 0);
        __syncthreads();
        const float brl = C.Ap->in[I_BR][jm * NE + (C.lane >> 3)];
        for (int rg = C.bid; rg < M / 128; rg += C.G) {
            f32x4 v[4]; load_row_res(T + (size_t)(rg * 128 + C.wave * 16) * D, XB + (size_t)(rg * 128 + C.wave * 16) * D, v, C.lane);
            for (int i = 0; i < 16; ++i) {
                const int rl = C.wave * 16 + i, m = rg * 128 + rl;
                f32x4 vn[4]; if (i + 1 < 16) load_row_res(T + (size_t)(m + 1) * D, XB + (size_t)(m + 1) * D, vn, C.lane);
                ln_apply(v, g, b);
                store_row_bf16(XB + (size_t)m * D, v, C.lane);
                const float lgt = dot8(v, wl, C.lane) + brl;
                float lg[8];
#pragma unroll
                for (int e = 0; e < 8; ++e) lg[e] = __builtin_bit_cast(float, __builtin_amdgcn_readlane(__builtin_bit_cast(int, lgt), 8 * e));
                int e0 = 0; float v0 = lg[0];
#pragma unroll
                for (int e = 1; e < 8; ++e) if (lg[e] > v0) { v0 = lg[e]; e0 = e; }
                int e1 = -1; float v1 = -3.0e38f;
#pragma unroll
                for (int e = 0; e < 8; ++e) if (e != e0 && lg[e] > v1) { v1 = lg[e]; e1 = e; }
                const float ex = __expf(v1 - v0), w0 = 1.0f / (1.0f + ex), w1 = ex * w0;
                if (C.lane == 0) { sel[rl] = e0 | (e1 << 8); tok_w[(size_t)m * 2] = w0; tok_w[(size_t)m * 2 + 1] = w1; }
#pragma unroll
                for (int j = 0; j < 4; ++j) v[j] = vn[j];
            }
            __syncthreads();
            int e0 = 0, e1 = 0, pos0 = 0, pos1 = 0;
            if (C.tid < 128) {
                const int s = sel[C.tid]; e0 = s & 255; e1 = s >> 8;
                const unsigned long long lt = (1ull << C.lane) - 1ull;
                int cnt8[8];
#pragma unroll
                for (int e = 0; e < 8; ++e) { const unsigned long long m0 = __ballot(e0 == e), m1 = __ballot(e1 == e);
                    if (e0 == e) pos0 = __popcll(m0 & lt); if (e1 == e) pos1 = __popcll(m0) + __popcll(m1 & lt);
                    cnt8[e] = __popcll(m0) + __popcll(m1); }
                if (C.lane == 0) {
#pragma unroll
                    for (int e = 0; e < 8; ++e) cnth[C.wave * 8 + e] = cnt8[e]; }
            }
            __syncthreads();
            if (C.tid < 128) {
                if (C.wave == 1) { pos0 += cnth[e0]; pos1 += cnth[e1]; }
                const int m = rg * 128 + C.tid;
                tok_e[(size_t)m * 2] = e0; tok_e[(size_t)m * 2 + 1] = e1; tok_pos[(size_t)m * 2] = pos0; tok_pos[(size_t)m * 2 + 1] = pos1;
                if (C.tid < 8) blk_cnt[rg * 8 + C.tid] = cnth[C.tid] + cnth[8 + C.tid];
            }
            __syncthreads();
        }
    }
}

__device__ __forceinline__ void phase_moe_prep(Ctx& C) {
    LAS int* cin = (LAS int*)C.lds;
    LAS int* off = cin + 2048;
    LAS int* tot = off + 2048;
    LAS int* base = tot + 8;
    const int* blk_cnt = WSP(int, MOE_BLK_CNT); const int* tok_e = WSP(int, MOE_TOK_E); const int* tok_pos = WSP(int, MOE_TOK_POS);
    int* tok_slot = WSP(int, MOE_TOK_SLOT); int* tile_e = WSP(int, MOE_TILE_E); int* meta = WSP(int, MOE_META);
    for (int i = C.tid; i < 2048; i += NTHR) cin[i] = blk_cnt[i];
    __syncthreads();
    { const int e = C.wave, i = C.lane;
      const int s0 = cin[(4 * i) * 8 + e], s1 = cin[(4 * i + 1) * 8 + e], s2 = cin[(4 * i + 2) * 8 + e], s3 = cin[(4 * i + 3) * 8 + e];
      const int t = s0 + s1 + s2 + s3; int inc = t;
#pragma unroll
      for (int o = 1; o < 64; o <<= 1) { const int y = __shfl_up(inc, o); if (i >= o) inc += y; }
      const int ex = inc - t;
      off[(4 * i) * 8 + e] = ex; off[(4 * i + 1) * 8 + e] = ex + s0; off[(4 * i + 2) * 8 + e] = ex + s0 + s1; off[(4 * i + 3) * 8 + e] = ex + s0 + s1 + s2;
      if (i == 63) tot[e] = inc; }
    __syncthreads();
    if (C.tid == 0) { int bs = 0;
        for (int e = 0; e < 8; ++e) { base[e] = bs; bs += ((tot[e] + 255) >> 8) << 8; }
        base[8] = bs;
        if (C.bid == 0) meta[0] = bs >> 8; }
    __syncthreads();
    if (C.bid == 0) { const int nt = base[8] >> 8;
        for (int rt = C.tid; rt < nt; rt += NTHR) { int e = 0;
#pragma unroll
            for (int k = 1; k < 8; ++k) e += (rt >= (base[k] >> 8)) ? 1 : 0;
            tile_e[rt] = e; } }
    const int gw = C.bid * NWAVES + C.wave, NGW = C.G * NWAVES;
    const bf16* XB = WSP(bf16, WS_XB); unsigned char* HS = WSP(unsigned char, WS_R3);
    v4u n0 = {0u, 0u, 0u, 0u}, n1 = {0u, 0u, 0u, 0u}; v2u ne = {0u, 0u}, np = {0u, 0u};
    if (gw < M) { n0 = *(const v4u*)(XB + (size_t)gw * D + 16 * C.lane); n1 = *(const v4u*)(XB + (size_t)gw * D + 16 * C.lane + 8); ne = *(const v2u*)(tok_e + (size_t)gw * 2); np = *(const v2u*)(tok_pos + (size_t)gw * 2); }
    for (int m = gw; m < M; m += NGW) {
        const int rg = m >> 7;
        const v4u r0 = n0, r1 = n1; const v2u ee = ne, pp = np;
        if (m + NGW < M) { const size_t mn = (size_t)(m + NGW); n0 = *(const v4u*)(XB + mn * D + 16 * C.lane); n1 = *(const v4u*)(XB + mn * D + 16 * C.lane + 8); ne = *(const v2u*)(tok_e + mn * 2); np = *(const v2u*)(tok_pos + mn * 2); }
        v4u o;
        o.x = f8x4(bflo(r0.x) * F8_HSC, bfhi(r0.x) * F8_HSC, bflo(r0.y) * F8_HSC, bfhi(r0.y) * F8_HSC); o.y = f8x4(bflo(r0.z) * F8_HSC, bfhi(r0.z) * F8_HSC, bflo(r0.w) * F8_HSC, bfhi(r0.w) * F8_HSC);
        o.z = f8x4(bflo(r1.x) * F8_HSC, bfhi(r1.x) * F8_HSC, bflo(r1.y) * F8_HSC, bfhi(r1.y) * F8_HSC); o.w = f8x4(bflo(r1.z) * F8_HSC, bfhi(r1.z) * F8_HSC, bflo(r1.w) * F8_HSC, bfhi(r1.w) * F8_HSC);
#pragma unroll
        for (int k = 0; k < 2; ++k) {
            const int e = (int)(k ? ee.y : ee.x), pos = (int)(k ? pp.y : pp.x);
            const int slot = base[e] + off[rg * 8 + e] + pos;
            *(v4u*)(HS + (size_t)slot * D + 16 * C.lane) = o;
            if (C.lane == 0) tok_slot[(size_t)m * 2 + k] = slot;
        }
    }
}

template <bool MOE> __device__ __forceinline__ void phase_ln2(Ctx& C, int l, size_t dummy_off = 0) {
    const bf16* T = WSP(bf16, WS_T); bf16* XB = WSP(bf16, WS_XB); bf16* XBo = dummy_off ? (bf16*)(C.Ap->ws + dummy_off) : XB;
    float* outf = dummy_off ? (float*)(C.Ap->ws + dummy_off) : C.Ap->out;
    LAS float* wl = (LAS float*)C.lds;
    if (l + 1 < DEPTH) { load_w8(C, wl, C.Ap->in[I_WIN] + (size_t)(l + 1) * D * DIN, DIN, NZ); }
    __syncthreads();
    f32x4 g[4], b[4]; load_vec_f32(C.Ap->in[I_L2G] + (size_t)l * D, g, C.lane); load_vec_f32(C.Ap->in[I_L2B] + (size_t)l * D, b, C.lane);
    const int gw = C.bid * NWAVES + C.wave, NGW = C.G * NWAVES;
    const bf16* Y2 = WSP(bf16, WS_R4); const int* tok_slot = WSP(int, MOE_TOK_SLOT); const float* tok_w = WSP(float, MOE_TOK_W);
    struct Raw { v4u a[2], b[2], c[2]; };
    struct Idx { int s0, s1; float w0, w1; };
    auto ld_idx = [&](int m, Idx& I) { if constexpr (MOE) { const v2u s = *(const v2u*)(tok_slot + (size_t)m * 2); const f32x2_hw w = *(const f32x2_hw*)(tok_w + (size_t)m * 2); I.s0 = (int)s.x; I.s1 = (int)s.y; I.w0 = w[0]; I.w1 = w[1]; } };
    auto ld_raw = [&](int m, const Idx& I, Raw& R) {
        const bf16* xr = XB + (size_t)m * D; R.a[0] = *(const v4u*)(xr + 8 * C.lane); R.a[1] = *(const v4u*)(xr + 512 + 8 * C.lane);
        if constexpr (MOE) { const bf16* p0 = Y2 + (size_t)I.s0 * D; const bf16* p1 = Y2 + (size_t)I.s1 * D;
            R.b[0] = *(const v4u*)(p0 + 8 * C.lane); R.b[1] = *(const v4u*)(p0 + 512 + 8 * C.lane); R.c[0] = *(const v4u*)(p1 + 8 * C.lane); R.c[1] = *(const v4u*)(p1 + 512 + 8 * C.lane); }
        else { const bf16* tr = T + (size_t)m * D; R.b[0] = *(const v4u*)(tr + 8 * C.lane); R.b[1] = *(const v4u*)(tr + 512 + 8 * C.lane); } };
    auto unp = [&](const v4u (&r)[2], f32x4 (&o)[4]) { o[0] = (f32x4){bflo(r[0].x), bfhi(r[0].x), bflo(r[0].y), bfhi(r[0].y)}; o[1] = (f32x4){bflo(r[0].z), bfhi(r[0].z), bflo(r[0].w), bfhi(r[0].w)};
        o[2] = (f32x4){bflo(r[1].x), bfhi(r[1].x), bflo(r[1].y), bfhi(r[1].y)}; o[3] = (f32x4){bflo(r[1].z), bfhi(r[1].z), bflo(r[1].w), bfhi(r[1].w)}; };
    Idx I0{}, I1{}, I2{}; Raw R1{};
    if (gw < M) { ld_idx(gw, I0); ld_raw(gw, I0, R1); I1 = I0; }
    if (gw + NGW < M) ld_idx(gw + NGW, I2);
    for (int m = gw; m < M; m += NGW) {
        const Raw R0 = R1; const Idx Ic = I1;
        I1 = I2;
        if (m + NGW < M) ld_raw(m + NGW, I1, R1);
        if (m + 2 * NGW < M) ld_idx(m + 2 * NGW, I2);
        f32x4 v[4], x[4], ya[4]; unp(R0.a, x); unp(R0.b, ya);
        if constexpr (MOE) { f32x4 yb[4]; unp(R0.c, yb);
#pragma unroll
            for (int j = 0; j < 4; ++j) v[j] = x[j] * ALPHA + (ya[j] * Ic.w0 + yb[j] * Ic.w1);
        } else {
#pragma unroll
            for (int j = 0; j < 4; ++j) v[j] = x[j] * ALPHA + ya[j];
        }
        ln_apply(v, g, b);
        if (l + 1 < DEPTH) { store_row_bf16(XBo + (size_t)m * D, v, C.lane); write_gates(C, l + 1, m, v, wl); }
        else store_row_f32(outf + (size_t)m * D, v, C.lane);
    }
}


typedef short bf16x8 __attribute__((ext_vector_type(8)));
typedef short s16x4 __attribute__((ext_vector_type(4)));
#define MFMA16(X, Y, ACC) __builtin_amdgcn_mfma_f32_16x16x32_bf16((X), (Y), (ACC), 0, 0, 0)
#define LBAR() do { asm volatile("s_waitcnt lgkmcnt(0)" ::: "memory"); __builtin_amdgcn_s_barrier(); asm volatile("" ::: "memory"); } while (0)
__device__ __forceinline__ unsigned off_b(unsigned row, unsigned ch) { return 256u * row + 16u * (ch ^ (((row & 3u) << 2) | ((row >> 2) & 3u))); }
__device__ __forceinline__ unsigned row_addr16(unsigned lane, unsigned rb, unsigned s) { return off_b((lane & 15u) + 16u * rb, 4u * s + (lane >> 4)); }
__device__ __forceinline__ unsigned tr_addr16(unsigned lane, unsigned c, unsigned ks, unsigned t) {
    const unsigned g = lane >> 4, q = (lane & 15u) >> 2, p = lane & 3u;
    return off_b(32u * ks + 8u * g + 4u * t + q, 2u * c + (p >> 1)) + 8u * (p & 1u);
}
__device__ __forceinline__ s16x4 ds_tr16(const LAS unsigned char* p) { return __builtin_bit_cast(s16x4, __builtin_amdgcn_ds_read_tr16_b64_v4i16((LAS s16x4*)p)); }
__device__ __forceinline__ float logsigmoid_f(float x) { return fminf(x, 0.f) - log1pf(__expf(-fabsf(x))); }
#include <type_traits>

namespace m2 {
constexpr int QI = 0, KI0 = 16384, VI0 = 49152, WI = 81920, WROW = 144, TBL = WI + 64 * WROW;
constexpr int T_R = TBL, T_B = TBL + 2048, T_PM = TBL + 4096, T_M = TBL + 6144, T_EM = TBL + 8192, T_SI = TBL + 10240, T_WL = TBL + 12288, T_GC = TBL + 14336, T_PC = T_GC + 64, T_SOLD = T_GC + 128,
              STAT = T_GC + 256, STATP = 26 * 64 * 4, NV = STAT + 2 * STATP, END = NV + 512;
static_assert(END <= MISC_OFF, "mLSTM LDS map");
constexpr size_t SEG_STATE = WS_R4 + 64 * MiB;
constexpr size_t SEG_ITEM_BYTES = 65536 + 8192;
constexpr size_t SEG_SCAL = SEG_STATE + 256 * SEG_ITEM_BYTES;
}
__device__ __forceinline__ void m2_tables(Ctx& C, const float* GT, size_t m0, int h) {
    using namespace m2;
    LAS float* tr = (LAS float*)(C.lds + T_R); LAS float* tb = (LAS float*)(C.lds + T_B); LAS float* tpm = (LAS float*)(C.lds + T_PM);
    LAS float* gc = (LAS float*)(C.lds + T_GC); LAS float* pc = (LAS float*)(C.lds + T_PC);
    const int w = C.wave, lane = C.lane; const size_t m = m0 + (size_t)w * 64 + lane;
    const float ip = GT[m * 8 + h], fp = GT[m * 8 + 4 + h];
    float bt = logsigmoid_f(fp);
#pragma unroll
    for (int o = 1; o < 64; o <<= 1) { const float y = __shfl_up(bt, o); if (lane >= o) bt += y; }
    const float r = ip - bt; float pm = r;
#pragma unroll
    for (int o = 1; o < 64; o <<= 1) { const float y = __shfl_up(pm, o); if (lane >= o) pm = fmaxf(pm, y); }
    tr[w * 64 + lane] = r; tb[w * 64 + lane] = bt; tpm[w * 64 + lane] = pm;
    if (lane == 63) { gc[w] = bt; pc[w] = pm; }
}
__device__ __forceinline__ float m2_chain(Ctx& C, float m_in) {
    using namespace m2;
    LAS float* gc = (LAS float*)(C.lds + T_GC); LAS float* pc = (LAS float*)(C.lds + T_PC); LAS float* so = (LAS float*)(C.lds + T_SOLD);
    const int w = C.wave, lane = C.lane;
    float m = m_in, mprev = m_in, m63 = 0.f;
#pragma unroll
    for (int c = 0; c < 8; ++c) { const float g = gc[c], P = pc[c]; const float M63 = fmaxf(P, m); if (c == w) { mprev = m; m63 = M63; } m = g + M63; }
    unsigned a0 = (unsigned)(T_R + 4 * (w * 64 + lane)); asm volatile("" : "+v"(a0)); LAS float* t0 = (LAS float*)(C.lds + a0);
#define M2T(T) t0[((T) - T_R) / 4]
    const float Mt = fmaxf(M2T(T_PM), mprev);
    M2T(T_M) = Mt; M2T(T_EM) = __expf(-(M2T(T_B) + Mt)); M2T(T_SI) = __expf(mprev - Mt); M2T(T_WL) = __expf(M2T(T_R) - m63);
#undef M2T
    if (lane == 0) so[w] = __expf(mprev - m63);
    return m;
}
struct M2Lane { unsigned trA0[2], trK[2], rowB, rowK, qlB, qhB; };
__device__ __forceinline__ M2Lane m2_lane(unsigned lane) {
    const unsigned lr = lane & 15u, g = lane >> 4, q = lr >> 2, p = lane & 3u; M2Lane K;
#pragma unroll
    for (unsigned t = 0; t < 2; ++t) { const unsigned F = (q << 2) | ((2u * g + t) & 3u), b = p >> 1;
        K.trA0[t] = 256u * (8u * g + 4u * t + q) + 16u * (b ^ (F & 1u)) + 8u * (p & 1u); K.trK[t] = F >> 1; }
    const unsigned Fr = ((lr & 3u) << 2) | ((lr >> 2) & 3u);
    K.rowB = 256u * lr + 16u * (g ^ (Fr & 3u)); K.rowK = Fr >> 2;
    K.qlB = 256u * lr + 16u * ((g >> 1) ^ (Fr & 3u)) + 8u * (g & 1u);
    K.qhB = 256u * lr + 16u * ((2u | (g >> 1)) ^ (Fr & 3u)) + 8u * (g & 1u);
    return K;
}
#define M2_LAUNDER(K) asm volatile("" : "+v"((K).trA0[0]), "+v"((K).trA0[1]), "+v"((K).trK[0]), "+v"((K).trK[1]), "+v"((K).rowB), "+v"((K).rowK), "+v"((K).qlB), "+v"((K).qhB))
__device__ __forceinline__ unsigned tr_addr_f(const M2Lane& K, unsigned c, unsigned ks, unsigned t) { return K.trA0[t] + 8192u * ks + 32u * (c ^ K.trK[t]); }
__device__ __forceinline__ unsigned row_addr_f(const M2Lane& K, unsigned rb, unsigned s) { return K.rowB + 4096u * rb + 64u * (s ^ K.rowK); }
__device__ __forceinline__ unsigned qlo_addr_f(const M2Lane& K, unsigned tq, unsigned ks) { return K.qlB + 4096u * tq + 64u * (ks ^ K.rowK); }
__device__ __forceinline__ unsigned qhi_addr_f(const M2Lane& K, unsigned tq, unsigned ks) { return K.qhB + 4096u * tq + 64u * (ks ^ K.rowK); }
struct M2Stage { v4u q[2], k[2], v[2]; };
__device__ __forceinline__ v4u ldg16(const void* ubase, unsigned toff) { return *(const v4u*)((const char*)ubase + toff); }
template <bool WITH_Q> __device__ __forceinline__ void m2_load(M2Stage& S, const bf16* QK, const bf16* Z, size_t m0c, int h, int tid) {
    const unsigned tq = (unsigned)(((tid >> 4) * 1024 + (tid & 15) * 8) * 2), tz = (unsigned)(((tid >> 4) * NZ + (tid & 15) * 8) * 2);
    const bf16* qb = QK + m0c * 1024 + h * DH; const bf16* zb = Z + m0c * NZ + ZV + h * DH;
#pragma unroll
    for (int i = 0; i < 2; ++i) {
        if (WITH_Q) S.q[i] = ldg16(qb + (size_t)i * 32 * 1024, tq);
        S.k[i] = ldg16(qb + 512 + (size_t)i * 32 * 1024, tq);
        S.v[i] = ldg16(zb + (size_t)i * 32 * NZ, tz); }
}
template <bool WITH_Q> __device__ __forceinline__ void m2_store(const M2Stage& S, LAS unsigned char* L, int buf, int tid) {
    using namespace m2;
    const unsigned o = off_b((unsigned)(tid >> 4), (unsigned)(tid & 15));
#pragma unroll
    for (int i = 0; i < 2; ++i) {
        if (WITH_Q) *(LAS v4u*)(L + QI + i * 8192 + o) = S.q[i];
        *(LAS v4u*)(L + KI0 + buf * 16384 + i * 8192 + o) = S.k[i]; *(LAS v4u*)(L + VI0 + buf * 16384 + i * 8192 + o) = S.v[i]; }
}
__device__ __forceinline__ void m2_update(LAS unsigned char* L, int buf, int c, unsigned lane, const M2Lane& LK, int w, f32x4 (&Dst)[8], f32x4& Dn) {
    using namespace m2;
    const int lr = lane & 15, lg = lane >> 4;
    LAS float* twl = (LAS float*)(L + T_WL); LAS float* so = (LAS float*)(L + T_SOLD);
    bf16x8 yv[2], ya[2];
#pragma unroll
    for (int ks = 0; ks < 2; ++ks) {
        const s16x4 a0 = ds_tr16(L + VI0 + buf * 16384 + tr_addr_f(LK, (unsigned)w, ks, 0)), a1 = ds_tr16(L + VI0 + buf * 16384 + tr_addr_f(LK, (unsigned)w, ks, 1));
        const f32x4 w0 = *(const LAS f32x4*)(twl + c * 64 + 32 * ks + 8 * lg), w1 = *(const LAS f32x4*)(twl + c * 64 + 32 * ks + 8 * lg + 4);
        v4u pv, pa;
        pv.x = pk2(bf2f((unsigned short)a0[0]) * w0[0], bf2f((unsigned short)a0[1]) * w0[1]); pv.y = pk2(bf2f((unsigned short)a0[2]) * w0[2], bf2f((unsigned short)a0[3]) * w0[3]);
        pv.z = pk2(bf2f((unsigned short)a1[0]) * w1[0], bf2f((unsigned short)a1[1]) * w1[1]); pv.w = pk2(bf2f((unsigned short)a1[2]) * w1[2], bf2f((unsigned short)a1[3]) * w1[3]);
        pa.x = pk2(w0[0], w0[1]); pa.y = pk2(w0[2], w0[3]); pa.z = pk2(w1[0], w1[1]); pa.w = pk2(w1[2], w1[3]);
        if (lr != 0) pa = (v4u){0u, 0u, 0u, 0u};
        yv[ks] = __builtin_bit_cast(bf16x8, pv); ya[ks] = __builtin_bit_cast(bf16x8, pa); }
    const float sold = so[c];
#pragma unroll
    for (int j = 0; j < 8; ++j) Dst[j] = Dst[j] * sold;
    Dn = Dn * sold;
#pragma unroll
    for (int jh = 0; jh < 2; ++jh) {
        s16x4 a0[4][2], a1[4][2];
#pragma unroll
        for (int jj = 0; jj < 4; ++jj)
#pragma unroll
            for (int ks = 0; ks < 2; ++ks) { a0[jj][ks] = ds_tr16(L + KI0 + buf * 16384 + tr_addr_f(LK, (unsigned)(4 * jh + jj), ks, 0)); a1[jj][ks] = ds_tr16(L + KI0 + buf * 16384 + tr_addr_f(LK, (unsigned)(4 * jh + jj), ks, 1)); }
        __builtin_amdgcn_sched_barrier(0);
#pragma unroll
        for (int jj = 0; jj < 4; ++jj)
#pragma unroll
            for (int ks = 0; ks < 2; ++ks) { const bf16x8 x = __builtin_shufflevector(a0[jj][ks], a1[jj][ks], 0, 1, 2, 3, 4, 5, 6, 7);
                Dst[4 * jh + jj] = MFMA16(x, yv[ks], Dst[4 * jh + jj]);
                if (4 * jh + jj == w) Dn = MFMA16(x, ya[ks], Dn); }
    }
}

__device__ __forceinline__ void phase_mlstm_x(Ctx& C, int l) {
    using namespace m2;
    const bf16* Z = WSP(bf16, WS_R2); const bf16* QK = WSP(bf16, WS_R4); const float* GT = WSP(float, WS_GATE);
    LAS unsigned char* L = C.lds; const unsigned lane = (unsigned)C.lane; const int w = C.wave, tid = C.tid; (void)l;
    for (int item = C.bid; item < BATCH * NH * 8; item += C.G) {
        const int bh = item >> 3, sg = item & 7, b = bh >> 2, h = bh & 3; const size_t m0 = (size_t)b * SEQ + (size_t)sg * 512;
        __syncthreads();
        m2_tables(C, GT, m0, h);
        M2Stage S; m2_load<false>(S, QK, Z, m0, h, tid);
        __syncthreads();
        const float mfin = m2_chain(C, -1.0e30f);
        m2_store<false>(S, L, 0, tid);
        f32x4 Dst[8], Dn = {0.f, 0.f, 0.f, 0.f};
#pragma unroll
        for (int j = 0; j < 8; ++j) Dst[j] = (f32x4){0.f, 0.f, 0.f, 0.f};
        M2Lane LK = m2_lane(lane);
        __syncthreads();
        for (int c = 0; c < 8; ++c) {
            const int buf = c & 1;
            M2_LAUNDER(LK);
            if (c + 1 < 8) m2_load<false>(S, QK, Z, m0 + (size_t)(c + 1) * 64, h, tid);
            m2_update(L, buf, c, lane, LK, w, Dst, Dn);
            if (c + 1 < 8) m2_store<false>(S, L, buf ^ 1, tid);
            LBAR();
        }
        float* st = (float*)(C.Ap->ws + SEG_STATE + (size_t)item * SEG_ITEM_BYTES);
#pragma unroll
        for (int j = 0; j < 8; ++j) *(f32x4*)((char*)(st + (size_t)(w * 8 + j) * 256) + lane * 16u) = Dst[j];
        *(f32x4*)((char*)(st + 16384 + (size_t)w * 256) + lane * 16u) = Dn;
        if (tid == 0) { LAS float* gc = (LAS float*)(L + T_GC); float G = 0.f;
#pragma unroll
            for (int c = 0; c < 8; ++c) G += gc[c];
            float* sc = (float*)(C.Ap->ws + SEG_SCAL) + (size_t)item * 32; sc[0] = mfin; sc[1] = G; }
    }
}

__device__ __forceinline__ void phase_mlstm_y(Ctx& C, int l) {
    using namespace m2;
    const bf16* Z = WSP(bf16, WS_R2); const bf16* QK = WSP(bf16, WS_R4); const float* GT = WSP(float, WS_GATE); bf16* YC = WSP(bf16, WS_R3);
    LAS unsigned char* L = C.lds; const int w = C.wave, tid0 = C.tid;
    LAS float* tm = (LAS float*)(L + T_M); LAS float* tem = (LAS float*)(L + T_EM); LAS float* tsi = (LAS float*)(L + T_SI); LAS float* trr = (LAS float*)(L + T_R);
    LAS float* stat = (LAS float*)(L + STAT); LAS float* nv = (LAS float*)(L + NV);
    for (int item = C.bid; item < BATCH * NH * 8; item += C.G) {
        const int bh = item >> 3, sg = item & 7, b = bh >> 2, h = bh & 3; const size_t m0 = (size_t)b * SEQ + (size_t)sg * 512;
        __syncthreads();
        m2_tables(C, GT, m0, h);
        float coef[7]; float m_in = 0.f;
        { const float* sc = (const float*)(C.Ap->ws + SEG_SCAL) + (size_t)(bh * 8) * 32;
#pragma unroll
          for (int s2 = 0; s2 < 7; ++s2) { coef[s2] = 0.f;
              if (s2 < sg) { const float ms = sc[s2 * 32], G = sc[s2 * 32 + 1]; const float mn = fmaxf(G + m_in, ms), dec = __expf(G + m_in - mn);
#pragma unroll
                  for (int s3 = 0; s3 < 7; ++s3) if (s3 < s2) coef[s3] *= dec;
                  coef[s2] = __expf(ms - mn); m_in = mn; } } }
        f32x4 Dst[8], Dn = {0.f, 0.f, 0.f, 0.f};
#pragma unroll
        for (int j = 0; j < 8; ++j) Dst[j] = (f32x4){0.f, 0.f, 0.f, 0.f};
        { f32x4 ld[9]; const unsigned lane_c = (unsigned)(tid0 & 63);
#define M2_SEGLOAD(s2_) do { const float* st_ = (const float*)(C.Ap->ws + SEG_STATE + (size_t)(bh * 8 + (s2_)) * SEG_ITEM_BYTES); \
              _Pragma("unroll") for (int j = 0; j < 8; ++j) ld[j] = *(const f32x4*)((const char*)(st_ + (size_t)(w * 8 + j) * 256) + lane_c * 16u); \
              ld[8] = *(const f32x4*)((const char*)(st_ + 16384 + (size_t)w * 256) + lane_c * 16u); } while (0)
          if (sg > 0) M2_SEGLOAD(0);
          for (int s2 = 0; s2 < sg; ++s2) { float cf = coef[0];
#pragma unroll
              for (int s3 = 1; s3 < 7; ++s3) cf = (s2 == s3) ? coef[s3] : cf;
              f32x4 cur[9];
#pragma unroll
              for (int j = 0; j < 9; ++j) cur[j] = ld[j];
              if (s2 + 1 < sg) M2_SEGLOAD(s2 + 1);
#pragma unroll
              for (int j = 0; j < 8; ++j) Dst[j] = Dst[j] + cur[j] * cf;
              Dn = Dn + cur[8] * cf; }
#undef M2_SEGLOAD
        }
        int tid = tid0; asm volatile("" : "+v"(tid));
        const unsigned lane_i = (unsigned)(tid & 63); const int lr_i = (int)(lane_i & 15u), lg_i = (int)(lane_i >> 4);
        const f32x4 gn = *(const f32x4*)(C.Ap->in[I_MG] + (size_t)l * DML + h * DH + 16 * w + 4 * lg_i);
        const unsigned tog = (unsigned)((lr_i * NZ + 4 * lg_i) * 2), tyc = (unsigned)((lr_i * D + 4 * lg_i) * 2);
        const unsigned lane_y = lane_i; M2Lane LK = m2_lane(lane_y);
        unsigned qa0 = off_b(lane_y, 2u * (unsigned)w), qa1 = off_b(lane_y, 2u * (unsigned)w + 1u);
        M2Stage S; m2_load<true>(S, QK, Z, m0, h, tid);
        __syncthreads();
        (void)m2_chain(C, m_in);
        m2_store<true>(S, L, 0, tid);
        if (lr_i == 0) *(LAS f32x4*)(nv + 16 * w + 4 * lg_i) = Dn;
        bf16x8 xin[4];
#pragma unroll
        for (int ks = 0; ks < 4; ++ks) { v4u p; p.x = pk2(Dst[2 * ks][0], Dst[2 * ks][1]); p.y = pk2(Dst[2 * ks][2], Dst[2 * ks][3]); p.z = pk2(Dst[2 * ks + 1][0], Dst[2 * ks + 1][1]); p.w = pk2(Dst[2 * ks + 1][2], Dst[2 * ks + 1][3]); xin[ks] = __builtin_bit_cast(bf16x8, p); }
        __syncthreads();
        const int tt = w >> 1, jt = w & 1;
        for (int c = 0; c < 8; ++c) {
            const int buf = c & 1, par = c & 1; const size_t mc = m0 + (size_t)c * 64;
            M2_LAUNDER(LK);
            unsigned lane = lane_y; asm volatile("" : "+v"(lane), "+v"(qa0), "+v"(qa1));
            const int lr = (int)(lane & 15u), lg = (int)(lane >> 4);
            LAS float* dens = stat + par * (26 * 64); LAS float* nqs = dens + 2 * 64; LAS float* lns = dens + 10 * 64; LAS float* lnq = dens + 18 * 64;
            if (c + 1 < 8) m2_load<true>(S, QK, Z, mc + 64, h, tid);
            v2u og[4];
#pragma unroll
            for (int tq = 0; tq < 4; ++tq) og[tq] = *(const v2u*)((const char*)(Z + (mc + 16 * tq) * NZ + ZO + h * DH + 16 * w) + tog);
            { bf16x8 yq[4], xa[4], xb[4];
#pragma unroll
              for (int s4 = 0; s4 < 4; ++s4) { yq[s4] = *(const LAS bf16x8*)(L + QI + row_addr_f(LK, tt, s4));
                  xa[s4] = *(const LAS bf16x8*)(L + KI0 + buf * 16384 + row_addr_f(LK, 2 * jt, s4)); xb[s4] = *(const LAS bf16x8*)(L + KI0 + buf * 16384 + row_addr_f(LK, 2 * jt + 1, s4)); }
              const int t = 16 * tt + lr, s0a = 32 * jt + 4 * lg, s0b = s0a + 16; const float Mt = tm[c * 64 + t];
              const f32x4 rsa = *(const LAS f32x4*)(trr + c * 64 + s0a), rsb = *(const LAS f32x4*)(trr + c * 64 + s0b);
              const v4u q0 = *(const LAS v4u*)(L + QI + qa0), q1 = *(const LAS v4u*)(L + QI + qa1);
              const f32x4 n0 = *(const LAS f32x4*)(nv + 16 * w), n1 = *(const LAS f32x4*)(nv + 16 * w + 4), n2 = *(const LAS f32x4*)(nv + 16 * w + 8), n3 = *(const LAS f32x4*)(nv + 16 * w + 12);
              __builtin_amdgcn_sched_barrier(0);
              f32x4 acca = {0.f, 0.f, 0.f, 0.f}, accb = {0.f, 0.f, 0.f, 0.f};
#pragma unroll
              for (int s4 = 0; s4 < 4; ++s4) { acca = MFMA16(xa[s4], yq[s4], acca); accb = MFMA16(xb[s4], yq[s4], accb); }
              const float nqp = (bflo(q0.x) * n0[0] + bfhi(q0.x) * n0[1] + bflo(q0.y) * n0[2] + bfhi(q0.y) * n0[3]) + (bflo(q0.z) * n1[0] + bfhi(q0.z) * n1[1] + bflo(q0.w) * n1[2] + bfhi(q0.w) * n1[3])
                              + (bflo(q1.x) * n2[0] + bfhi(q1.x) * n2[1] + bflo(q1.y) * n2[2] + bfhi(q1.y) * n2[3]) + (bflo(q1.z) * n3[0] + bfhi(q1.z) * n3[1] + bflo(q1.w) * n3[2] + bfhi(q1.w) * n3[3]);
              nqs[w * 64 + lane] = nqp;
              float wa[4], wb[4]; float rsum = 0.f;
#pragma unroll
              for (int r = 0; r < 4; ++r) { wa[r] = (s0a + r <= t) ? acca[r] * __expf(fminf(rsa[r] - Mt, 0.f)) : 0.f; wb[r] = (s0b + r <= t) ? accb[r] * __expf(fminf(rsb[r] - Mt, 0.f)) : 0.f; }
              v2u oa, ob; oa.x = pk2(wa[0], wa[1]); oa.y = pk2(wa[2], wa[3]); ob.x = pk2(wb[0], wb[1]); ob.y = pk2(wb[2], wb[3]);
              rsum = (bflo(oa.x) + bfhi(oa.x)) + (bflo(oa.y) + bfhi(oa.y)) + (bflo(ob.x) + bfhi(ob.x)) + (bflo(ob.y) + bfhi(ob.y));
              rsum += __shfl_xor(rsum, 16); rsum += __shfl_xor(rsum, 32);
              if (lg == 0) dens[jt * 64 + t] = rsum;
              *(LAS v2u*)(L + WI + t * WROW + s0a * 2) = oa; *(LAS v2u*)(L + WI + t * WROW + s0b * 2) = ob; }
            LBAR();
            f32x4 hv[4];
            { bf16x8 xv[2];
#pragma unroll
              for (int ks = 0; ks < 2; ++ks) { const s16x4 a0 = ds_tr16(L + VI0 + buf * 16384 + tr_addr_f(LK, (unsigned)w, ks, 0)), a1 = ds_tr16(L + VI0 + buf * 16384 + tr_addr_f(LK, (unsigned)w, ks, 1));
                  xv[ks] = __builtin_shufflevector(a0, a1, 0, 1, 2, 3, 4, 5, 6, 7); }
#pragma unroll
              for (int th = 0; th < 2; ++th) {
                  bf16x8 yw[2][2]; s16x4 ql[2][4], qh[2][4];
#pragma unroll
                  for (int u = 0; u < 2; ++u) { const int tq = 2 * th + u;
#pragma unroll
                      for (int ks = 0; ks < 2; ++ks) yw[u][ks] = *(const LAS bf16x8*)(L + WI + (16 * tq + lr) * WROW + (32 * ks + 8 * lg) * 2);
#pragma unroll
                      for (int ks = 0; ks < 4; ++ks) { ql[u][ks] = *(const LAS s16x4*)(L + QI + qlo_addr_f(LK, tq, ks));
                          qh[u][ks] = *(const LAS s16x4*)(L + QI + qhi_addr_f(LK, tq, ks)); } }
                  __builtin_amdgcn_sched_barrier(0);
#pragma unroll
                  for (int u = 0; u < 2; ++u) { const int tq = 2 * th + u, t = 16 * tq + lr; f32x4 accI = {0.f, 0.f, 0.f, 0.f}, accE = {0.f, 0.f, 0.f, 0.f};
#pragma unroll
                      for (int ks = 0; ks < 2; ++ks) accI = MFMA16(xv[ks], yw[u][ks], accI);
#pragma unroll
                      for (int ks = 0; ks < 4; ++ks) { const bf16x8 y = __builtin_shufflevector(ql[u][ks], qh[u][ks], 0, 1, 2, 3, 4, 5, 6, 7); accE = MFMA16(xin[ks], y, accE); }
                      const float sI = tsi[c * 64 + t]; const float nqt = ((nqs[t] + nqs[64 + t]) + (nqs[128 + t] + nqs[192 + t])) + ((nqs[256 + t] + nqs[320 + t]) + (nqs[384 + t] + nqs[448 + t]));
                      const float den = (dens[t] + dens[64 + t]) + sI * nqt; const float inv = 1.0f / fmaxf(fabsf(den), tem[c * 64 + t]);
                      hv[tq] = (accI + accE * sI) * inv;
                      float s1 = (hv[tq][0] + hv[tq][1]) + (hv[tq][2] + hv[tq][3]), s2 = (hv[tq][0] * hv[tq][0] + hv[tq][1] * hv[tq][1]) + (hv[tq][2] * hv[tq][2] + hv[tq][3] * hv[tq][3]);
                      s1 += __shfl_xor(s1, 16); s1 += __shfl_xor(s1, 32); s2 += __shfl_xor(s2, 16); s2 += __shfl_xor(s2, 32);
                      if (lg == 0) { lns[w * 64 + t] = s1; lnq[w * 64 + t] = s2; } }
              } }
            LBAR();
#pragma unroll
            for (int tq = 0; tq < 4; ++tq) { const int t = 16 * tq + lr;
                const float ls = ((lns[t] + lns[64 + t]) + (lns[128 + t] + lns[192 + t])) + ((lns[256 + t] + lns[320 + t]) + (lns[384 + t] + lns[448 + t]));
                const float lq = ((lnq[t] + lnq[64 + t]) + (lnq[128 + t] + lnq[192 + t])) + ((lnq[256 + t] + lnq[320 + t]) + (lnq[384 + t] + lnq[448 + t]));
                const float mean = ls * (1.0f / DH); const float var = fmaxf(lq * (1.0f / DH) - mean * mean, 0.f); const float rstd = 1.0f / sqrtf(var + LN_EPS);
                const float o0 = bflo(og[tq].x), o1 = bfhi(og[tq].x), o2 = bflo(og[tq].y), o3 = bfhi(og[tq].y);
                const float y0 = sigmoid_f(o0) * ((hv[tq][0] - mean) * rstd * gn[0]), y1 = sigmoid_f(o1) * ((hv[tq][1] - mean) * rstd * gn[1]);
                const float y2 = sigmoid_f(o2) * ((hv[tq][2] - mean) * rstd * gn[2]), y3 = sigmoid_f(o3) * ((hv[tq][3] - mean) * rstd * gn[3]);
                v2u o; o.x = pk2(y0, y1); o.y = pk2(y2, y3);
                *(v2u*)((char*)(YC + (mc + 16 * tq) * D + DPOOL + h * DH + 16 * w) + tyc) = o; }
            LBAR();
            if (c + 1 < 8) {
                m2_update(L, buf, c, lane, LK, w, Dst, Dn);
#pragma unroll
                for (int ks = 0; ks < 4; ++ks) { v4u p; p.x = pk2(Dst[2 * ks][0], Dst[2 * ks][1]); p.y = pk2(Dst[2 * ks][2], Dst[2 * ks][3]); p.z = pk2(Dst[2 * ks + 1][0], Dst[2 * ks + 1][1]); p.w = pk2(Dst[2 * ks + 1][2], Dst[2 * ks + 1][3]); xin[ks] = __builtin_bit_cast(bf16x8, p); }
                if (lr == 0) *(LAS f32x4*)(nv + 16 * w + 4 * lg) = Dn;
                m2_store<true>(S, L, buf ^ 1, tid);
            }
            LBAR();
        }
    }
}

enum { PH_INPROJ = 0, PH_CONV = 1, PH_MLSTM = 2, PH_POOLFIN = 3, PH_OUTPROJ = 4, PH_LN1 = 5, PH_F0 = 6, PH_F1 = 7, PH_F2 = 8, PH_LN2M = 17 };
__global__ void __launch_bounds__(NTHR, 2) fwd(Args args) {
    extern __shared__ __attribute__((aligned(16))) unsigned char lds_raw[];
    const int wave_s = __builtin_amdgcn_readfirstlane((int)(threadIdx.x >> 6));
    { Ctx C = make_ctx(lds_raw, wave_s);
      for (int u = C.tid; u < (LDS_BYTES - MISC_OFF) / 4; u += NTHR) ((LAS unsigned*)(C.lds + MISC_OFF))[u] = 0u;
      __syncthreads();
      (void)xcd_barrier_post((unsigned*)(C.Ap->ws + WS_CTL) + CW_BAR + C.Ap->li * XCD_BAR_WORDS, (volatile LAS unsigned*)(C.lds + MISC_OFF) + 8); }
    const int lo = args.ph_lo, hi = args.ph_hi; (void)args;
#ifndef DUP_MASK
#define DUP_MASK 0
#endif
#define DUPB(bit) ((((DUP_MASK) >> (bit)) & 1) != 0)
#ifndef DUP_N
#define DUP_N 1
#endif
#define REP(bit) for (int rep_ = 0; rep_ < (((DUP_MASK) >> (bit)) & 1) * (DUP_N) + 1; ++rep_)
#define IN(k) (lo <= (k) && (k) < hi)
#define SEAM(k) do { if (hi > (k) + 1) { Ctx Cb = make_ctx(lds_raw, wave_s); XcdBarrier bar; bar.bar = (unsigned*)(Cb.Ap->ws + WS_CTL) + CW_BAR + Cb.Ap->li * XCD_BAR_WORDS; bar.x = xb_xcc_id(); \
        bar.st = (volatile LAS unsigned*)(Cb.lds + MISC_OFF) + 8; xcd_barrier(bar); if (DUPB(15)) xcd_barrier(bar); } } while (0)
#define PHASE(k, body) do { if (IN(k)) { Ctx C = make_ctx(lds_raw, wave_s); { Ctx C = make_ctx(lds_raw, wave_s); body } SEAM(k); } } while (0)

    if (IN(0)) { Ctx C = make_ctx(lds_raw, wave_s); REP(13) phase_prologue(C); SEAM(0); }
#pragma nounroll
    for (int l = 0; l < DEPTH; ++l) {
        const int pb = 1 + l * NPH; const int jj = l >> 1; const bool moe = (l & 1) != 0;
        if (IN(pb + PH_INPROJ)) { Ctx C = make_ctx(lds_raw, wave_s);
            pg8::Gemm g{WSP(bf16, WS_XB), WSP(bf16, WS_WIN) + (size_t)l * NZ * D, M, NZ, D}; pg8::StaticOrder S; S.init(M, NZ, C.G, C.bid);
            REP(0) { pg8::EpiBf16 E{WSP(bf16, WS_R2), NZ, (DUPB(16) && rep_ == 0) ? 1 : 0};
            pg8::gemm_phase<pg8::EpiBf16, pg8::StaticOrder, true, true>(C.lds, g, S, E, C.wave); }
            SEAM(pb + PH_INPROJ);
        }
        if (IN(pb + PH_CONV)) { Ctx C = make_ctx(lds_raw, wave_s); REP(1) { phase_conv(C, l); phase_pool(C, l); } SEAM(pb + PH_CONV); }
        if (IN(pb + PH_MLSTM)) { Ctx C = make_ctx(lds_raw, wave_s); REP(2) phase_mlstm_x(C, l); SEAM(pb + PH_MLSTM); }
        if (IN(pb + PH_POOLFIN)) { Ctx C = make_ctx(lds_raw, wave_s); REP(3) phase_mlstm_y(C, l); if (l == 2) { __syncthreads(); Ctx C2 = make_ctx(lds_raw, wave_s); REP(14) convert_experts(C2, 1); } SEAM(pb + PH_POOLFIN); }
        if (IN(pb + PH_OUTPROJ)) { Ctx C = make_ctx(lds_raw, wave_s);
            pg8::Gemm g{WSP(bf16, WS_R3), WSP(bf16, WS_WOUT) + (size_t)l * D * D, M, D, D}; pg8::StaticOrder S; S.init(M, D, C.G, C.bid);
            pg8::EpiBf16 E{WSP(bf16, WS_T), D};
            REP(4) pg8::gemm_phase<pg8::EpiBf16, pg8::StaticOrder, true, true>(C.lds, g, S, E, C.wave);
            SEAM(pb + PH_OUTPROJ);
        }
        if (!moe) {
            if (IN(pb + PH_LN1)) { Ctx C = make_ctx(lds_raw, wave_s); REP(5) phase_ln1<false>(C, l); SEAM(pb + PH_LN1); }
            if (IN(pb + PH_F0)) { Ctx C = make_ctx(lds_raw, wave_s);
                pg8::Gemm g{WSP(bf16, WS_XB), WSP(bf16, WS_WGU) + (size_t)jj * 2 * FFD * D, M, 2 * FFD, D}; pg8::StaticOrder S; S.init(M, 2 * FFD, C.G, C.bid);
                pg8::EpiSwiGLU8 E{WSP(bf16, WS_R2), FFD, 1.0f, F8_ASC};
                REP(6) pg8::gemm_phase<pg8::EpiSwiGLU8, pg8::StaticOrder, true, true>(C.lds, g, S, E, C.wave);
                SEAM(pb + PH_F0);
            }
            if (IN(pb + PH_F1)) { Ctx C = make_ctx(lds_raw, wave_s);
                pg8::Gemm g{WSP(bf16, WS_R2), (const bf16*)(WSP(unsigned char, WS_WD) + (size_t)jj * D * FFD), M, D, FFD / 2}; pg8::StaticOrder S; S.init(M, D, C.G, C.bid);
                pg8::EpiBf16S E{WSP(bf16, WS_T), D, 1.0f / (F8_DSC * F8_ASC)};
                REP(7) pg8::gemm_phase<pg8::EpiBf16S, pg8::StaticOrder, true, true, 1>(C.lds, g, S, E, C.wave);
                SEAM(pb + PH_F1);
            }
            if (IN(pb + PH_F2)) { Ctx C = make_ctx(lds_raw, wave_s); REP(8) phase_ln2<false>(C, l); SEAM(pb + PH_F2); }
        } else {
            if (IN(pb + PH_LN1)) { Ctx C = make_ctx(lds_raw, wave_s); REP(5) phase_ln1<true>(C, l); SEAM(pb + PH_LN1); }
            if (IN(pb + PH_F0)) { Ctx C = make_ctx(lds_raw, wave_s); REP(9) phase_moe_prep(C); SEAM(pb + PH_F0); }
#pragma nounroll
            for (int p = 0; p < NPASS; ++p) {
                const int rt0 = p * PASS_TILES;
                if (IN(pb + PH_F1 + 2 * p)) { Ctx C = make_ctx(lds_raw, wave_s);
                    const int NT = __builtin_amdgcn_readfirstlane(WSP(int, MOE_META)[0]); int ntp = NT - rt0; if (p + 1 < NPASS) ntp = ntp > PASS_TILES ? PASS_TILES : ntp;
                    if (ntp > 0) {
                        pg8::Gemm g{(const bf16*)(WSP(unsigned char, WS_R3) + (size_t)rt0 * 256 * D), WSP(bf16, WS_EGU), ntp * 256, 2 * FFE, D / 2};
                        pg8::GroupedOrder S; S.init(ntp, 2 * FFE, C.G, C.bid, rt0, WSP(int, MOE_TILE_E));
                        pg8::EpiSwiGLU8 E{WSP(bf16, WS_R2), FFE, 1.0f / (F8_WSC * F8_HSC), F8_ASC};
                        REP(10) pg8::gemm_phase<pg8::EpiSwiGLU8, pg8::GroupedOrder, true, true, 1>(C.lds, g, S, E, C.wave);
                    }
                    SEAM(pb + PH_F1 + 2 * p);
                }
                if (IN(pb + PH_F2 + 2 * p)) { Ctx C = make_ctx(lds_raw, wave_s);
                    const int NT = __builtin_amdgcn_readfirstlane(WSP(int, MOE_META)[0]); int ntp = NT - rt0; if (p + 1 < NPASS) ntp = ntp > PASS_TILES ? PASS_TILES : ntp;
                    if (ntp > 0) {
                        pg8::Gemm g{WSP(bf16, WS_R2), WSP(bf16, WS_ED), ntp * 256, D, FFE / 2}; pg8::GroupedOrder S; S.init(ntp, D, C.G, C.bid, rt0, WSP(int, MOE_TILE_E));
                        pg8::EpiBf16S E{WSP(bf16, WS_R4) + (size_t)rt0 * 256 * D, D, 1.0f / (F8_DSC * F8_ASC)};
                        REP(11) pg8::gemm_phase<pg8::EpiBf16S, pg8::GroupedOrder, true, true, 1>(C.lds, g, S, E, C.wave);
                    }
                    SEAM(pb + PH_F2 + 2 * p);
                }
            }
            if (IN(pb + PH_LN2M)) { Ctx C = make_ctx(lds_raw, wave_s); REP(12) phase_ln2<true>(C, l, (DUPB(12) && rep_ == 0) ? WS_R2 : 0); SEAM(pb + PH_LN2M); }
        }
    }
#undef IN
#undef SEAM
}

static bool phase_exists(int id) { if (id == 0) return true; const int l = (id - 1) / NPH, k = (id - 1) % NPH; return (l & 1) ? true : (k <= PH_F2); }
extern "C" void kernel_launch(void* const* d_in, const int* in_sizes, int n_in, void* d_out, int out_size, void* d_ws, size_t ws_size, hipStream_t stream) {
    static int grid = 0;
    if (grid == 0) {
        if (n_in != 21 || out_size != M * D || ws_size < WS_END) { fprintf(stderr, "kernel_launch: unexpected shapes (n_in %d, out %d, ws %zu)\n", n_in, out_size, ws_size); grid = -1; return; }
        int dev = 0, cus = 0, per_cu = 0;
        if (hipGetDevice(&dev) != hipSuccess || hipDeviceGetAttribute(&cus, hipDeviceAttributeMultiprocessorCount, dev) != hipSuccess) { grid = -1; return; }
        if (hipFuncSetAttribute((const void*)fwd, hipFuncAttributeMaxDynamicSharedMemorySize, LDS_BYTES) != hipSuccess) { fprintf(stderr, "kernel_launch: hipFuncSetAttribute failed\n"); grid = -1; return; }
        if (hipOccupancyMaxActiveBlocksPerMultiprocessor(&per_cu, (const void*)fwd, NTHR, LDS_BYTES) != hipSuccess || per_cu < 1) { fprintf(stderr, "kernel_launch: occupancy query says %d blocks per CU\n", per_cu); (void)hipGetLastError(); if (per_cu < 1) { grid = -1; return; } }
        grid = cus;
    }
    if (grid < 0) return;
    (void)in_sizes;
    if (hipMemsetAsync((char*)d_ws + WS_CTL, 0, CTL_ZERO_BYTES, stream) != hipSuccess) return;
    Args a{};
    for (int i = 0; i < 21; ++i) a.in[i] = (const float*)d_in[i];
    a.out = (float*)d_out; a.ws = (unsigned char*)d_ws; a.pad = 0;
#if MK_ONE_LAUNCH
    a.ph_lo = 0; a.ph_hi = NPHASES; a.li = 0;
    hipLaunchKernelGGL(fwd, dim3(grid), dim3(NTHR), LDS_BYTES, stream, a);
#else
    for (int id = 0; id < NPHASES; ++id) { if (!phase_exists(id)) continue;
        a.ph_lo = id; a.ph_hi = id + 1; a.li = id;
        hipLaunchKernelGGL(fwd, dim3(grid), dim3(NTHR), LDS_BYTES, stream, a); }
#endif
}
```
